# Optimizing an MI355X kernel written in HIP

```python
import math
import jax
import jax.numpy as jnp
from jax import lax
import numpy as np

D_MODEL = 4096
BATCH = 1
SEQ = 8192
DEPTH = 1

HEAD_DIM = 128
DIL_PAIRS = ((128, 1), (512, 4), (2048, 16))
N_GROUPS = len(DIL_PAIRS)
HEADS_PER_GROUP = 4
A_HEADS = N_GROUPS * HEADS_PER_GROUP
A_WIDTH = A_HEADS * HEAD_DIM
A_OUT = HEADS_PER_GROUP * HEAD_DIM
B_HEADS = 8
B_QK = B_HEADS * 2 * HEAD_DIM
B_V = B_HEADS * 2 * HEAD_DIM
SPLIT_SIZES = (A_WIDTH, A_WIDTH, A_WIDTH, B_QK, B_QK, B_V, D_MODEL, D_MODEL)
IN_COLS = sum(SPLIT_SIZES)
SPLITS = tuple(int(v) for v in np.cumsum(SPLIT_SIZES)[:-1])
D_FF = 4 * D_MODEL
ROPE_THETA = 500000.0
ROT_DIM = HEAD_DIM // 4
Q_BLOCK = 128
EPS = 1e-6

kernel_name = 'hybrid_dilated_diff_attn_gated_block'


def rmsnorm(x, g):
    xf = x.astype(jnp.float32)
    y = xf * lax.rsqrt(jnp.mean(xf * xf, axis=-1, keepdims=True) + EPS)
    return (y * g.astype(jnp.float32)).astype(x.dtype)


def rope_tables(seq):
    pos = jnp.arange(seq, dtype=jnp.float32)
    inv = ROPE_THETA ** (-jnp.arange(0, ROT_DIM, 2, dtype=jnp.float32) / ROT_DIM)
    ang = pos[:, None] * inv[None, :]
    return jnp.cos(ang), jnp.sin(ang)


def apply_rope(x, cos, sin):
    half = ROT_DIM // 2
    shp = (1, x.shape[1]) + (1,) * (x.ndim - 3) + (half,)
    c = cos.reshape(shp).astype(x.dtype)
    s = sin.reshape(shp).astype(x.dtype)
    x1, x2, rest = x[..., :half], x[..., half:ROT_DIM], x[..., ROT_DIM:]
    return jnp.concatenate([x1 * c - x2 * s, x2 * c + x1 * s, rest], axis=-1)


def dilated_window_attn(q, k, v, window, dilation):
    B, S, H, d = q.shape
    W = window // dilation
    L = S // dilation
    nb = -(-L // W)
    Lp = nb * W

    def to_sub(t):
        t = t.reshape(B, L, dilation, H, d).transpose(0, 3, 2, 1, 4)
        t = jnp.pad(t, ((0, 0), (0, 0), (0, 0), (0, Lp - L), (0, 0)))
        return t.reshape(B, H, dilation, nb, W, d)

    qb, kb, vb = to_sub(q), to_sub(k), to_sub(v)
    k_prev = jnp.concatenate([jnp.zeros_like(kb[:, :, :, :1]), kb[:, :, :, :-1]], axis=3)
    v_prev = jnp.concatenate([jnp.zeros_like(vb[:, :, :, :1]), vb[:, :, :, :-1]], axis=3)
    kk = jnp.concatenate([k_prev, kb], axis=4)
    vv = jnp.concatenate([v_prev, vb], axis=4)
    s = jnp.einsum('bhrnqd,bhrnkd->bhrnqk', qb, kk,
                   preferred_element_type=jnp.float32) * (1.0 / math.sqrt(d))
    qp = jnp.arange(W)[:, None]
    kp = jnp.arange(2 * W)[None, :]
    band = (kp >= qp) & (kp <= qp + W)
    has_prev = (jnp.arange(nb) > 0)[:, None, None]
    mask = band[None] & (has_prev | (kp >= W)[None])
    s = jnp.where(mask, s, -jnp.inf)
    lse = jax.nn.logsumexp(s, axis=-1, keepdims=True)
    p = jnp.exp(s - lse)
    out = jnp.einsum('bhrnqk,bhrnkd->bhrnqd', p, vv.astype(jnp.float32))
    out = out.reshape(B, H, dilation, Lp, d)[:, :, :, :L]
    out = out.transpose(0, 3, 2, 1, 4).reshape(B, S, H, d)
    lse = lse[..., 0].reshape(B, H, dilation, Lp)[:, :, :, :L]
    lse = lse.transpose(0, 3, 2, 1).reshape(B, S, H)
    return out, lse


def dilated_mixture(qa, ka, va):
    B, S, _, d = qa.shape
    outs, lses = [], []
    for g, (window, dilation) in enumerate(DIL_PAIRS):
        sl = slice(g * HEADS_PER_GROUP, (g + 1) * HEADS_PER_GROUP)
        o, l = dilated_window_attn(qa[:, :, sl], ka[:, :, sl], va[:, :, sl], window, dilation)
        outs.append(o)
        lses.append(l)
    alpha = jax.nn.softmax(jnp.stack(lses, axis=0), axis=0)
    mixed = jnp.sum(alpha[..., None] * jnp.stack(outs, axis=0), axis=0)
    return mixed.reshape(B, S, A_OUT).astype(qa.dtype)


def lambda_init(layer_idx):
    return 0.8 - 0.6 * math.exp(-0.3 * layer_idx)


def diff_attention(q, k, v, lam, lam_init, subln_g):
    B, S, H, _, d = q.shape
    nb = S // Q_BLOCK
    kT = k.transpose(0, 2, 3, 1, 4)
    vT = v.transpose(0, 2, 1, 3).astype(jnp.float32)
    qb = q.reshape(B, nb, Q_BLOCK, H, 2, d).transpose(1, 0, 3, 4, 2, 5)
    kpos = jnp.arange(S)
    scale = 1.0 / math.sqrt(d)

    def block(args):
        qblk, n = args
        s = jnp.einsum('bhiqd,bhikd->bhiqk', qblk, kT,
                       preferred_element_type=jnp.float32) * scale
        qpos = n * Q_BLOCK + jnp.arange(Q_BLOCK)
        s = jnp.where(kpos[None, :] <= qpos[:, None], s, -jnp.inf)
        p = jax.nn.softmax(s, axis=-1)
        a = p[:, :, 0] - lam * p[:, :, 1]
        return jnp.einsum('bhqk,bhkv->bhqv', a, vT)

    o = lax.map(block, (qb, jnp.arange(nb)))
    o = o.transpose(1, 0, 3, 2, 4).reshape(B, S, H, 2 * d)
    o = rmsnorm(o, subln_g) * (1.0 - lam_init)
    return o.reshape(B, S, H * 2 * d).astype(q.dtype)


def setup_inputs(seed: int = 0) -> dict:
    key = jax.random.key(seed)
    ks = jax.random.split(key, 16)
    f32 = jnp.float32

    def nrm(k, shape, scale):
        return jax.random.normal(k, shape, f32) * scale

    return {
        'x': nrm(ks[0], (BATCH, SEQ, D_MODEL), 1.0),
        'norm_mix': 1.0 + nrm(ks[1], (DEPTH, D_MODEL), 0.01),
        'w_in': nrm(ks[2], (DEPTH, D_MODEL, IN_COLS), D_MODEL ** -0.5),
        'b_gate': nrm(ks[3], (DEPTH, 2 * D_MODEL), 0.01),
        'w_proj_a': nrm(ks[4], (DEPTH, A_OUT, D_MODEL), A_OUT ** -0.5),
        'w_proj_b': nrm(ks[5], (DEPTH, B_V, D_MODEL), B_V ** -0.5),
        'w_out': nrm(ks[6], (DEPTH, D_MODEL, D_MODEL), D_MODEL ** -0.5),
        'lambda_q1': nrm(ks[7], (DEPTH, HEAD_DIM), 0.1),
        'lambda_k1': nrm(ks[8], (DEPTH, HEAD_DIM), 0.1),
        'lambda_q2': nrm(ks[9], (DEPTH, HEAD_DIM), 0.1),
        'lambda_k2': nrm(ks[10], (DEPTH, HEAD_DIM), 0.1),
        'subln_g': 1.0 + nrm(ks[11], (DEPTH, 2 * HEAD_DIM), 0.01),
        'norm_mlp': 1.0 + nrm(ks[12], (DEPTH, D_MODEL), 0.01),
        'w_ff1': nrm(ks[13], (DEPTH, D_MODEL, D_FF), D_MODEL ** -0.5),
        'w_ff2': nrm(ks[14], (DEPTH, D_FF, D_MODEL), D_FF ** -0.5),
        'norm_final': 1.0 + nrm(ks[15], (D_MODEL,), 0.01),
    }


def reference(x, norm_mix, w_in, b_gate, w_proj_a, w_proj_b, w_out, lambda_q1, lambda_k1,
              lambda_q2, lambda_k2, subln_g, norm_mlp, w_ff1, w_ff2, norm_final):
    B, S, _ = x.shape
    cos, sin = rope_tables(S)
    for l in range(DEPTH):
        h = rmsnorm(x, norm_mix[l])
        proj = jnp.einsum('bsd,de->bse', h, w_in[l])
        qa, ka, va, qb, kb, vb, ga, gb = jnp.split(proj, SPLITS, axis=-1)
        qa = apply_rope(qa.reshape(B, S, A_HEADS, HEAD_DIM), cos, sin)
        ka = apply_rope(ka.reshape(B, S, A_HEADS, HEAD_DIM), cos, sin)
        va = va.reshape(B, S, A_HEADS, HEAD_DIM)
        ya = dilated_mixture(qa, ka, va)
        qb = apply_rope(qb.reshape(B, S, B_HEADS, 2, HEAD_DIM), cos, sin)
        kb = apply_rope(kb.reshape(B, S, B_HEADS, 2, HEAD_DIM), cos, sin)
        vb = vb.reshape(B, S, B_HEADS, 2 * HEAD_DIM)
        lam_init = lambda_init(l)
        lam = (jnp.exp(jnp.sum(lambda_q1[l].astype(jnp.float32) * lambda_k1[l].astype(jnp.float32)))
               - jnp.exp(jnp.sum(lambda_q2[l].astype(jnp.float32) * lambda_k2[l].astype(jnp.float32)))
               + lam_init)
        yb = diff_attention(qb, kb, vb, lam, lam_init, subln_g[l])
        gate_a = jax.nn.sigmoid(ga + b_gate[l, :D_MODEL])
        gate_b = jax.nn.sigmoid(gb + b_gate[l, D_MODEL:])
        merged = (gate_a * jnp.einsum('bsc,cd->bsd', ya, w_proj_a[l])
                  + gate_b * jnp.einsum('bsc,cd->bsd', yb, w_proj_b[l]))
        x = x + jnp.einsum('bsd,de->bse', merged, w_out[l])
        h = rmsnorm(x, norm_mlp[l])
        u = jax.nn.relu(jnp.einsum('bsd,df->bsf', h, w_ff1[l]))
        x = x + jnp.einsum('bsf,fd->bsd', jnp.square(u), w_ff2[l])
    return rmsnorm(x, norm_final)
```

```cpp
#include <hip/hip_runtime.h>
#include <cstdio>
#include <cstdint>
constexpr int SEQ = 8192, DM = 4096, NIN = 18944, DFF = 16384;
constexpr int NWAVES = 8;
constexpr float RMS_EPS = 1e-6f;
constexpr float ATT_SCALE = 0.08838834764831845f;
constexpr int N_PHASES = 9;
#ifndef MK_N_LAUNCHES
#define MK_N_LAUNCHES 1
#endif
constexpr size_t MiB = 1u << 20;
constexpr size_t WS_CTL = 0, CTL_ZERO_BYTES = 1 * MiB;
constexpr size_t WS_WIN = 1 * MiB;
constexpr size_t WS_WA = 149 * MiB;
constexpr size_t WS_WB = 153 * MiB;
constexpr size_t WS_WOUT = 169 * MiB;
constexpr size_t WS_WFF1 = 201 * MiB;
constexpr size_t WS_WFF2 = 329 * MiB;
constexpr size_t WS_H = 457 * MiB;
constexpr size_t WS_YA = 521 * MiB;
constexpr size_t WS_YB = 529 * MiB;
constexpr size_t WS_T = 561 * MiB;
constexpr size_t WS_MG = 625 * MiB;
constexpr size_t WS_RSS = 689 * MiB;
constexpr size_t WS_LSE = 691 * MiB;
constexpr size_t WS_R1 = 692 * MiB;
constexpr size_t WS_QA = WS_R1, WS_KA = WS_R1 + 24 * MiB, WS_VA = WS_R1 + 48 * MiB;
constexpr size_t WS_QB = WS_R1 + 72 * MiB, WS_KB = WS_R1 + 104 * MiB, WS_VB = WS_R1 + 136 * MiB;
constexpr size_t WS_GA = WS_R1 + 168 * MiB, WS_GB = WS_R1 + 232 * MiB;
constexpr size_t WS_OA = WS_R1 + 296 * MiB;
constexpr size_t WS_OB = WS_R1 + 344 * MiB;
constexpr size_t WS_U2 = WS_R1;
constexpr size_t WS_END = WS_R1 + 472 * MiB;
constexpr int CW_BAR = 4096;
constexpr int RING_BYTES = 131072, LDSCTL_OFF = RING_BYTES, MISC_OFF = LDSCTL_OFF + 320, LDS_BYTES = 147456;
namespace pg8 {
#define PG8_LAS __attribute__((address_space(3)))
typedef unsigned short bf16_t;
typedef short bf16x8 __attribute__((ext_vector_type(8)));
typedef float f32x4 __attribute__((ext_vector_type(4)));
typedef unsigned u32x4 __attribute__((ext_vector_type(4)));
constexpr int BM = 256, BK = 64, HALF = 128, HTB = HALF * BK * 2  , STAGE_BYTES = 8 * HTB, NXCD = 8, WGM = 8;

__host__ __device__ __forceinline__ int lds_byte(int r, int c) { const int st = (r >> 4) * 2 + (c >> 5), rr = r & 15, cc = c & 31, ob = rr * 64 + cc * 2; return st * 1024 + (ob ^ (((ob >> 9) & 1) << 5)); }
__host__ __device__ __forceinline__ void stage_rc(int b, int& R, int& C) { const int st = b / 1024, sb = b % 1024, swz = sb ^ (((sb >> 9) & 1) << 5); R = (st >> 1) * 16 + swz / 64; C = (st & 1) * 32 + (swz % 64) / 2; }
__host__ __device__ __forceinline__ int perm32(int rho) { const int n = rho >> 4, i = rho & 15; return 8 * (i >> 2) + 4 * n + (i & 3); }

struct Unit { int pm, pn; };
struct Gemm { const bf16_t* A; const bf16_t* Bt; int M, N, K; };

struct StaticOrder {
    int nM, nN, nwg, G, c;
    __host__ __device__ void init(int M, int N, int G_, int c_) { nM = M / BM; nN = N / BM; nwg = nM * nN; G = G_; c = c_; }
    __host__ __device__ bool next(int i, Unit& u) const {
        const long L = (long)i * G + c; if (L >= nwg) return false;
        int wgid = (int)L; { const int q = nwg / NXCD, r = nwg % NXCD, xcd = wgid % NXCD, off = wgid / NXCD; wgid = (xcd < r ? xcd * (q + 1) : r * (q + 1) + (xcd - r) * q) + off; }
        const int nig = WGM * nN, gid = wgid / nig, fm = gid * WGM, gsz = (nM - fm) < WGM ? (nM - fm) : WGM;
        u.pm = fm + ((wgid % nig) % gsz); u.pn = (wgid % nig) / gsz; return true;
    }
    __device__ __forceinline__ void a_ready(const Unit&) const {}
    __device__ __forceinline__ void done(const Unit&) const {}
};

typedef float f32x2c_t __attribute__((ext_vector_type(2))); typedef __bf16 bf16x2c_t __attribute__((ext_vector_type(2)));
__device__ __forceinline__ unsigned cvt_pk_bf16(float lo, float hi) { const f32x2c_t v = {lo, hi}; const bf16x2c_t b = __builtin_convertvector(v, bf16x2c_t); return __builtin_bit_cast(unsigned, b); }
typedef float f32x2 __attribute__((ext_vector_type(2)));
template <class Epi, class Sched, bool ALIGN_EPI = false, bool SP2 = false>
__device__ __forceinline__ void gemm_phase(PG8_LAS unsigned char* lds, const Gemm g, const Sched& S, const Epi& E) {
    const int tid = threadIdx.x, wid = __builtin_amdgcn_readfirstlane(tid >> 6), lane = tid & 63, wr = wid >> 2, wc = wid & 3, fr = lane & 15, fq = lane >> 4;
    const int K = g.K, nt = K / BK;
    unsigned voffA[2], voffB[2];
#pragma unroll
    for (int i = 0; i < 2; ++i) { int R, C; stage_rc(tid * 16 + i * 8192, R, C); const int Rb = Epi::PERM ? ((R & ~31) + perm32(R & 31)) : R;
        voffA[i] = (unsigned)(R * K + C) * 2u; voffB[i] = (unsigned)(Rb * K + C) * 2u; }
    const size_t kstep = (size_t)(BK * 2);
    const size_t hstep = (size_t)HALF * K * 2;
    const size_t tstep = 2 * hstep;
    const unsigned ldsw = (unsigned)wid * 1024u;
    const int aoff = lds_byte(wr * 64 + fr, fq * 8), boff = lds_byte(wc * 32 + fr, fq * 8);
#define PG8_SA(b, h) (((b) * 2 + (h)) * HTB)
#define PG8_SB(b, h) ((4 + (b) * 2 + (h)) * HTB)
#define PG8_STAGE(bufoff, gbase, voff) do { _Pragma("unroll") for (int _i = 0; _i < 2; ++_i) \
        __builtin_amdgcn_global_load_lds((const unsigned*)((const char*)(gbase) + (voff)[_i]), (PG8_LAS unsigned*)(lds + (bufoff) + ldsw + _i * 8192), 16, 0, 0); } while (0)
#define PG8_LDA(dst, b, h) do { _Pragma("unroll") for (int m = 0; m < 4; ++m) _Pragma("unroll") for (int k = 0; k < 2; ++k) dst[m][k] = *(const PG8_LAS bf16x8*)(lds + PG8_SA(b, h) + aoff + m * 2048 + k * 1024); } while (0)
#define PG8_LDB(dst, b, h) do { _Pragma("unroll") for (int n = 0; n < 2; ++n) _Pragma("unroll") for (int k = 0; k < 2; ++k) dst[n][k] = *(const PG8_LAS bf16x8*)(lds + PG8_SB(b, h) + boff + n * 2048 + k * 1024); } while (0)
#define PG8_MMA(ai, bj, At, Bt) do { __builtin_amdgcn_s_setprio(1); _Pragma("unroll") for (int m = 0; m < 4; ++m) _Pragma("unroll") for (int n = 0; n < 2; ++n) _Pragma("unroll") for (int k = 0; k < 2; ++k) \
        acc[ai][bj][m][n] = __builtin_amdgcn_mfma_f32_16x16x32_bf16(Bt[n][k], At[m][k], acc[ai][bj][m][n], 0, 0, 0); __builtin_amdgcn_s_setprio(0); } while (0)
#define PG8_WAIT_V(n) asm volatile("s_waitcnt vmcnt(" #n ")" ::: "memory")
#define PG8_WAIT_L(n) asm volatile("s_waitcnt lgkmcnt(" #n ")" ::: "memory")
#define PG8_BAR __builtin_amdgcn_s_barrier()
#define PG8_SCHED __builtin_amdgcn_sched_barrier(0)
    Unit cur, nxt; int ui = 0;
    if (!S.next(0, cur)) return;
    f32x4 acc[2][2][4][2];
#pragma unroll
    for (int a = 0; a < 2; ++a)
#pragma unroll
        for (int b = 0; b < 2; ++b)
#pragma unroll
            for (int m = 0; m < 4; ++m)
#pragma unroll
                for (int n = 0; n < 2; ++n) acc[a][b][m][n] = (f32x4){0.f, 0.f, 0.f, 0.f};
    bf16x8 At[4][2], B0[2][2], B1[2][2];
    const char* cA = (const char*)g.A + (size_t)cur.pm * tstep; const char* cB = (const char*)g.Bt + (size_t)cur.pn * tstep;
    S.a_ready(cur);
    if constexpr (SP2) {
        PG8_STAGE(PG8_SB(0, 0), cB, voffB); PG8_STAGE(PG8_SB(0, 1), cB + hstep, voffB); PG8_STAGE(PG8_SA(0, 0), cA, voffA); PG8_STAGE(PG8_SA(0, 1), cA + hstep, voffA);
        if (wr == 1) PG8_BAR;
        PG8_WAIT_V(2); PG8_BAR;
        PG8_STAGE(PG8_SB(1, 0), cB + kstep, voffB); PG8_STAGE(PG8_SA(1, 0), cA + kstep, voffA); PG8_STAGE(PG8_SB(1, 1), cB + hstep + kstep, voffB);
        PG8_WAIT_V(6); PG8_BAR;
    } else {
        PG8_STAGE(PG8_SB(0, 0), cB, voffB); PG8_STAGE(PG8_SA(0, 0), cA, voffA); PG8_STAGE(PG8_SB(0, 1), cB + hstep, voffB); PG8_STAGE(PG8_SA(0, 1), cA + hstep, voffA);
        if (wr == 1) PG8_BAR;
        PG8_WAIT_V(4); PG8_BAR;
        PG8_STAGE(PG8_SB(1, 0), cB + kstep, voffB); PG8_STAGE(PG8_SA(1, 0), cA + kstep, voffA); PG8_STAGE(PG8_SB(1, 1), cB + hstep + kstep, voffB);
        PG8_WAIT_V(6); PG8_BAR;
    }
    for (;;) {
        const bool has_next = S.next(ui + 1, nxt);
        const char* nA = has_next ? (const char*)g.A + (size_t)nxt.pm * tstep : cA; const char* nB = has_next ? (const char*)g.Bt + (size_t)nxt.pn * tstep : cB;
        for (int t = 0; t < nt; t += 2) {
            const bool last = (t == nt - 2);
            const char* a1 = cA + (size_t)(t + 1) * kstep;
            const char* a2 = last ? nA : cA + (size_t)(t + 2) * kstep; const char* b2 = last ? nB : cB + (size_t)(t + 2) * kstep;
            const char* a3 = a2 + kstep; const char* b3 = b2 + kstep;
            if (last && has_next) S.a_ready(nxt);
            if constexpr (SP2) {
            PG8_LDB(B0, 0, 0); PG8_LDB(B1, 0, 1); PG8_SCHED; PG8_LDA(At, 0, 0); PG8_STAGE(PG8_SA(1, 1), a1 + hstep, voffA);
            PG8_WAIT_V(8); PG8_WAIT_L(0); PG8_BAR; PG8_MMA(0, 0, At, B0); PG8_MMA(0, 1, At, B1); PG8_BAR; PG8_SCHED;
            PG8_LDA(At, 0, 1); PG8_STAGE(PG8_SB(0, 0), b2, voffB); PG8_STAGE(PG8_SB(0, 1), b2 + hstep, voffB); PG8_STAGE(PG8_SA(0, 0), a2, voffA);
            PG8_WAIT_V(8); PG8_WAIT_L(0); PG8_BAR; PG8_MMA(1, 0, At, B0); PG8_MMA(1, 1, At, B1); PG8_BAR; PG8_SCHED;
            PG8_LDB(B0, 1, 0); PG8_LDB(B1, 1, 1); PG8_SCHED; PG8_LDA(At, 1, 0); PG8_STAGE(PG8_SA(0, 1), a2 + hstep, voffA);
            PG8_WAIT_V(8); PG8_WAIT_L(0); PG8_BAR; PG8_MMA(0, 0, At, B0); PG8_MMA(0, 1, At, B1); PG8_BAR; PG8_SCHED;
            PG8_LDA(At, 1, 1); PG8_STAGE(PG8_SB(1, 0), b3, voffB); PG8_STAGE(PG8_SB(1, 1), b3 + hstep, voffB); PG8_STAGE(PG8_SA(1, 0), a3, voffA);
            PG8_WAIT_V(8); PG8_WAIT_L(0); PG8_BAR; PG8_MMA(1, 0, At, B0); PG8_MMA(1, 1, At, B1); PG8_BAR; PG8_SCHED;
            } else {
            PG8_LDB(B0, 0, 0); PG8_SCHED; PG8_LDA(At, 0, 0); PG8_STAGE(PG8_SA(1, 1), a1 + hstep, voffA);
            PG8_WAIT_L(8); PG8_BAR; PG8_WAIT_L(0); PG8_MMA(0, 0, At, B0); PG8_BAR; PG8_SCHED;
            PG8_LDB(B1, 0, 1); PG8_STAGE(PG8_SB(0, 0), b2, voffB);
            PG8_BAR; PG8_WAIT_L(0); PG8_MMA(0, 1, At, B1); PG8_BAR;
            PG8_LDA(At, 0, 1); PG8_STAGE(PG8_SA(0, 0), a2, voffA);
            PG8_BAR; PG8_WAIT_L(0); PG8_MMA(1, 0, At, B0); PG8_BAR; PG8_SCHED;
            PG8_STAGE(PG8_SB(0, 1), b2 + hstep, voffB);
            PG8_WAIT_V(6); PG8_BAR; PG8_MMA(1, 1, At, B1); PG8_BAR;
            PG8_LDB(B0, 1, 0); PG8_SCHED; PG8_LDA(At, 1, 0); PG8_STAGE(PG8_SA(0, 1), a2 + hstep, voffA);
            PG8_WAIT_L(8); PG8_BAR; PG8_WAIT_L(0); PG8_MMA(0, 0, At, B0); PG8_BAR; PG8_SCHED;
            PG8_LDB(B1, 1, 1); PG8_STAGE(PG8_SB(1, 0), b3, voffB);
            PG8_BAR; PG8_WAIT_L(0); PG8_MMA(0, 1, At, B1); PG8_BAR;
            PG8_LDA(At, 1, 1); PG8_STAGE(PG8_SA(1, 0), a3, voffA);
            PG8_BAR; PG8_WAIT_L(0); PG8_MMA(1, 0, At, B0); PG8_BAR; PG8_SCHED;
            PG8_STAGE(PG8_SB(1, 1), b3 + hstep, voffB);
            PG8_WAIT_V(6); PG8_BAR; PG8_MMA(1, 1, At, B1); PG8_BAR;
            }
        }
        if constexpr (ALIGN_EPI) { if (wr == 0) PG8_BAR; }
        if constexpr (!Epi::AFTER_DRAIN) { E(acc, cur, wr, wc, fr, fq); S.done(cur); }
        if (!has_next) break;
#pragma unroll
        for (int a = 0; a < 2; ++a)
#pragma unroll
            for (int b = 0; b < 2; ++b)
#pragma unroll
                for (int m = 0; m < 4; ++m)
#pragma unroll
                    for (int n = 0; n < 2; ++n) acc[a][b][m][n] = (f32x4){0.f, 0.f, 0.f, 0.f};
        cur = nxt; cA = nA; cB = nB; ++ui;
        if constexpr (ALIGN_EPI) { if (wr == 1) PG8_BAR; }
    }
    PG8_WAIT_V(0);
    if constexpr (!ALIGN_EPI) { if (wr == 0) PG8_BAR; }
    PG8_BAR;
    if constexpr (Epi::AFTER_DRAIN) { E.fused(acc, cur, wr, wc, fr, fq, lds, wid, lane); S.done(cur); }
#undef PG8_SA
#undef PG8_SB
#undef PG8_STAGE
#undef PG8_LDA
#undef PG8_LDB
#undef PG8_MMA
#undef PG8_WAIT_V
#undef PG8_WAIT_L
#undef PG8_BAR
#undef PG8_SCHED
}
}
namespace pg8 {
__device__ __forceinline__ float bf_lo(unsigned u) { return __uint_as_float(u << 16); }
__device__ __forceinline__ float bf_hi(unsigned u) { return __uint_as_float(u & 0xffff0000u); }
__device__ __forceinline__ u32x4 pack8bf(const f32x4 v0, const f32x4 v1) { u32x4 w; w.x = cvt_pk_bf16(v0[0], v0[1]); w.y = cvt_pk_bf16(v0[2], v0[3]); w.z = cvt_pk_bf16(v1[0], v1[1]); w.w = cvt_pk_bf16(v1[2], v1[3]); return w; }
__device__ __forceinline__ float sigmoidf_(float x) { return __builtin_amdgcn_rcpf(1.0f + __builtin_amdgcn_exp2f(-1.4426950408889634f * x)); }

struct EpiProj {
    static constexpr bool PERM = true, AFTER_DRAIN = false;
    unsigned char* ws; const float* bgate;
    __device__ __forceinline__ void operator()(const f32x4 (&acc)[2][2][4][2], const Unit& u, int wr, int wc, int fr, int fq) const {
        const int pn = u.pn;
        size_t off; int ld, ct, mode, boff = 0;
        if (pn < 6)       { off = WS_QA; ld = 1536; ct = pn;      mode = 1; }
        else if (pn < 12) { off = WS_KA; ld = 1536; ct = pn - 6;  mode = 1; }
        else if (pn < 18) { off = WS_VA; ld = 1536; ct = pn - 12; mode = 0; }
        else if (pn < 26) { off = WS_QB; ld = 2048; ct = pn - 18; mode = 1; }
        else if (pn < 34) { off = WS_KB; ld = 2048; ct = pn - 26; mode = 1; }
        else if (pn < 42) { off = WS_VB; ld = 2048; ct = pn - 34; mode = 0; }
        else if (pn < 58) { off = WS_GA; ld = 4096; ct = pn - 42; mode = 2; boff = (pn - 42) * 256; }
        else              { off = WS_GB; ld = 4096; ct = pn - 58; mode = 2; boff = 4096 + (pn - 58) * 256; }
        bf16_t* dst = (bf16_t*)(ws + off);
        const int row0 = u.pm * BM + wr * 64 + fr, col0 = ct * 256 + wc * 32 + 8 * fq;
        if (mode == 2) {
            f32x4 bv[2][2];
#pragma unroll
            for (int bj = 0; bj < 2; ++bj)
#pragma unroll
                for (int n = 0; n < 2; ++n) bv[bj][n] = *(const f32x4*)(bgate + boff + wc * 32 + 8 * fq + bj * HALF + 4 * n);
#pragma unroll
            for (int ai = 0; ai < 2; ++ai)
#pragma unroll
                for (int m = 0; m < 4; ++m) { bf16_t* rowp = dst + (size_t)(row0 + ai * HALF + m * 16) * ld + col0;
#pragma unroll
                    for (int bj = 0; bj < 2; ++bj) { f32x4 v0 = acc[ai][bj][m][0] + bv[bj][0], v1 = acc[ai][bj][m][1] + bv[bj][1];
#pragma unroll
                        for (int i = 0; i < 4; ++i) { v0[i] = sigmoidf_(v0[i]); v1[i] = sigmoidf_(v1[i]); }
                        *(u32x4*)(rowp + bj * HALF) = pack8bf(v0, v1); } }
        } else if (mode == 1 && wc == 0) {
            const bool odd = (fq & 1) != 0, lo = fq < 2;
            float invf[2][4];
            invf[0][0] = odd ? 0.00141421356f : 1.0f;            invf[0][1] = odd ? 0.000622772437f : 0.440366596f;
            invf[0][2] = odd ? 0.000274248188f : 0.193922743f;   invf[0][3] = odd ? 0.000120769735f : 0.0853971019f;
            invf[1][0] = odd ? 5.31829573e-05f : 0.0376060307f;  invf[1][1] = odd ? 2.34199997e-05f : 0.0165604409f;
            invf[1][2] = odd ? 1.03133852e-05f : 0.00729266461f; invf[1][3] = odd ? 4.54167048e-06f : 0.00321144611f;
#pragma unroll
            for (int ai = 0; ai < 2; ++ai)
#pragma unroll
                for (int m = 0; m < 4; ++m) { const int row = row0 + ai * HALF + m * 16; const float pos = (float)row; bf16_t* rowp = dst + (size_t)row * ld + col0;
                    float cs[2][4], sn[2][4];
#pragma unroll
                    for (int n = 0; n < 2; ++n)
#pragma unroll
                        for (int i = 0; i < 4; ++i) { const float ang = pos * invf[n][i]; const float k = rintf(ang * 0.15915494309189535f);
                            float r = fmaf(-k, 6.2831855f, ang); r = fmaf(-k, -1.7484555e-07f, r); const float rev = r * 0.15915494309189535f;
                            cs[n][i] = __builtin_amdgcn_cosf(rev); sn[n][i] = lo ? -__builtin_amdgcn_sinf(rev) : __builtin_amdgcn_sinf(rev); }
#pragma unroll
                    for (int bj = 0; bj < 2; ++bj) { f32x4 v0 = acc[ai][bj][m][0], v1 = acc[ai][bj][m][1], o0, o1;
#pragma unroll
                        for (int i = 0; i < 4; ++i) { const float p0 = __shfl_xor(v0[i], 32), p1 = __shfl_xor(v1[i], 32);
                            o0[i] = v0[i] * cs[0][i] + p0 * sn[0][i]; o1[i] = v1[i] * cs[1][i] + p1 * sn[1][i]; }
                        *(u32x4*)(rowp + bj * HALF) = pack8bf(o0, o1); } }
        } else {
#pragma unroll
            for (int ai = 0; ai < 2; ++ai)
#pragma unroll
                for (int m = 0; m < 4; ++m) { bf16_t* rowp = dst + (size_t)(row0 + ai * HALF + m * 16) * ld + col0;
#pragma unroll
                    for (int bj = 0; bj < 2; ++bj) *(u32x4*)(rowp + bj * HALF) = pack8bf(acc[ai][bj][m][0], acc[ai][bj][m][1]); }
        }
    }
};
template <bool ADD> struct EpiGate {
    static constexpr bool PERM = true, AFTER_DRAIN = false;
    const bf16_t* G; const bf16_t* Tin; bf16_t* O;
    __device__ __forceinline__ void operator()(const f32x4 (&acc)[2][2][4][2], const Unit& u, int wr, int wc, int fr, int fq) const {
        const int row0 = u.pm * BM + wr * 64 + fr, col0 = u.pn * BM + wc * 32 + 8 * fq;
#pragma unroll
        for (int ai = 0; ai < 2; ++ai)
#pragma unroll
            for (int m = 0; m < 4; ++m) {
#pragma unroll
                for (int bj = 0; bj < 2; ++bj) { const size_t idx = (size_t)(row0 + ai * HALF + m * 16) * DM + col0 + bj * HALF;
                    const u32x4 gw = *(const u32x4*)(G + idx);
                    f32x4 v0 = acc[ai][bj][m][0], v1 = acc[ai][bj][m][1];
                    v0[0] *= bf_lo(gw.x); v0[1] *= bf_hi(gw.x); v0[2] *= bf_lo(gw.y); v0[3] *= bf_hi(gw.y);
                    v1[0] *= bf_lo(gw.z); v1[1] *= bf_hi(gw.z); v1[2] *= bf_lo(gw.w); v1[3] *= bf_hi(gw.w);
                    if (ADD) { const u32x4 tw = *(const u32x4*)(Tin + idx);
                        v0[0] += bf_lo(tw.x); v0[1] += bf_hi(tw.x); v0[2] += bf_lo(tw.y); v0[3] += bf_hi(tw.y);
                        v1[0] += bf_lo(tw.z); v1[1] += bf_hi(tw.z); v1[2] += bf_lo(tw.w); v1[3] += bf_hi(tw.w); }
                    *(u32x4*)(O + idx) = pack8bf(v0, v1); }
                if (m & 1) asm volatile("" ::: "memory"); }
    }
};
template <bool STATS> struct EpiResid {
    static constexpr bool PERM = false, AFTER_DRAIN = false;
    const float* base; float* out; bf16_t* xb; float* rss;
    __device__ __forceinline__ void operator()(const f32x4 (&acc)[2][2][4][2], const Unit& u, int wr, int wc, int fr, int fq) const {
        typedef unsigned u32x2v __attribute__((ext_vector_type(2)));
        const int col0 = u.pn * BM + wc * 32 + 4 * fq;
#pragma unroll
        for (int ai = 0; ai < 2; ++ai)
#pragma unroll
            for (int m = 0; m < 4; ++m) { const int row = u.pm * BM + ai * HALF + wr * 64 + m * 16 + fr; const size_t off = (size_t)row * DM + col0; float ss = 0.f;
#pragma unroll
                for (int bj = 0; bj < 2; ++bj)
#pragma unroll
                    for (int n = 0; n < 2; ++n) { const f32x4 o = *(const f32x4*)(base + off + bj * HALF + n * 16) + acc[ai][bj][m][n];
                        *(f32x4*)(out + off + bj * HALF + n * 16) = o;
                        if (STATS) { ss += (o[0] * o[0] + o[1] * o[1]) + (o[2] * o[2] + o[3] * o[3]);
                            u32x2v w; w.x = cvt_pk_bf16(o[0], o[1]); w.y = cvt_pk_bf16(o[2], o[3]); *(u32x2v*)(xb + off + bj * HALF + n * 16) = w; } }
                if (STATS) { ss += __shfl_xor(ss, 16); ss += __shfl_xor(ss, 32); if (fq == 0) rss[(size_t)row * 64 + u.pn * 4 + wc] = ss; }
                if (m & 1) asm volatile("" ::: "memory"); }
    }
};
struct EpiRelu2 {
    static constexpr bool PERM = true, AFTER_DRAIN = false;
    bf16_t* O; const float* rss;
    __device__ __forceinline__ void operator()(const f32x4 (&acc)[2][2][4][2], const Unit& u, int wr, int wc, int fr, int fq) const {
        const int row0 = u.pm * BM + wr * 64 + fr, col0 = u.pn * BM + wc * 32 + 8 * fq;
#pragma unroll
        for (int ai = 0; ai < 2; ++ai)
#pragma unroll
            for (int m = 0; m < 4; ++m) { const int row = row0 + ai * HALF + m * 16; const f32x4* rp = (const f32x4*)(rss + (size_t)row * 64 + fq * 16);
                const f32x4 a = rp[0], b = rp[1], c = rp[2], d = rp[3];
                float t = ((a[0] + a[1]) + (a[2] + a[3])) + ((b[0] + b[1]) + (b[2] + b[3])) + ((c[0] + c[1]) + (c[2] + c[3])) + ((d[0] + d[1]) + (d[2] + d[3]));
                t += __shfl_xor(t, 16); t += __shfl_xor(t, 32);
                const float rstd = rsqrtf(t * (1.0f / DM) + RMS_EPS);
                bf16_t* rowp = O + (size_t)row * DFF + col0;
#pragma unroll
                for (int bj = 0; bj < 2; ++bj) { f32x4 v0 = acc[ai][bj][m][0] * rstd, v1 = acc[ai][bj][m][1] * rstd;
#pragma unroll
                    for (int i = 0; i < 4; ++i) { v0[i] = fmaxf(v0[i], 0.f); v0[i] *= v0[i]; v1[i] = fmaxf(v1[i], 0.f); v1[i] *= v1[i]; }
                    *(u32x4*)(rowp + bj * HALF) = pack8bf(v0, v1); } }
    }
};
}
#define GAS __attribute__((address_space(1)))
#define LAS __attribute__((address_space(3)))
typedef unsigned short bf16;
typedef unsigned v4u __attribute__((ext_vector_type(4)));
typedef unsigned v2u __attribute__((ext_vector_type(2)));
typedef float f32x4 __attribute__((ext_vector_type(4)));
typedef GAS unsigned gu32;
#define RLX_AGENT __ATOMIC_RELAXED, __HIP_MEMORY_SCOPE_AGENT
#define LDS_WAIT() asm volatile("s_waitcnt lgkmcnt(0)" ::: "memory")
#define VM_WAIT() asm volatile("s_waitcnt vmcnt(0)" ::: "memory")
__device__ __forceinline__ unsigned f2bf(float f) { unsigned u = __builtin_bit_cast(unsigned, f); return (u + 0x7fffu + ((u >> 16) & 1u)) >> 16; }
__device__ __forceinline__ unsigned pk2(float lo, float hi) { return f2bf(lo) | (f2bf(hi) << 16); }
__device__ __forceinline__ float bflo(unsigned u) { return __uint_as_float(u << 16); }
__device__ __forceinline__ float bfhi(unsigned u) { return __uint_as_float(u & 0xffff0000u); }
__device__ __forceinline__ float wave_sum(float v) {
#pragma unroll
    for (int o = 1; o < 64; o <<= 1) v += __shfl_xor(v, o);
    return v;
}
__device__ __forceinline__ float wave_max(float v) {
#pragma unroll
    for (int o = 1; o < 64; o <<= 1) v = fmaxf(v, __shfl_xor(v, o));
    return v;
}
#define XB_TMO      128
#define XB_XCNT(j)  (256  + 64 * (j))
#define XB_XSUB(j)  (1280 + 64 * (j))
#define XB_XGEN(j)  (2304 + 64 * (j))
#define XB_TOP      3328
#define XB_TOPGEN   3392
#define XCD_BAR_WORDS 3456
#define XB_SPIN_CAP (1u << 23)

__device__ __forceinline__ unsigned xb_ld(unsigned* p)              { return __hip_atomic_load(p, __ATOMIC_RELAXED, __HIP_MEMORY_SCOPE_AGENT); }
__device__ __forceinline__ unsigned xb_add(unsigned* p, unsigned v) { return __hip_atomic_fetch_add(p, v, __ATOMIC_RELAXED, __HIP_MEMORY_SCOPE_AGENT); }
__device__ __forceinline__ unsigned xb_xcc_id() { return (unsigned)__builtin_amdgcn_s_getreg((3 << 11) | 20) & 0xFu; }
#define XB_SPIN(cond, bar) do { unsigned _sp = 0; while (cond) { __builtin_amdgcn_s_sleep(1); \
    if ((++_sp & 255u) == 0u) { if (xb_ld(&(bar)[XB_TMO])) break; if (_sp > XB_SPIN_CAP) { atomicAdd(&(bar)[XB_TMO], 1u); break; } } } } while (0)

struct XcdBarrier {
    unsigned* bar; unsigned x;
    volatile LAS unsigned* st;
};

__device__ __forceinline__ XcdBarrier xcd_barrier_post(unsigned* bar, volatile LAS unsigned* st) {
    XcdBarrier b; b.bar = bar; b.x = xb_xcc_id(); b.st = st;
    if (threadIdx.x == 0) (void)xb_add(&bar[XB_XCNT(b.x)], 1u);
    return b;
}
__device__ __forceinline__ void xcd_barrier_complete(unsigned* bar, unsigned x, unsigned& nloc, unsigned& nx) {
    const unsigned G = gridDim.x * gridDim.y * gridDim.z;
    unsigned sum, cnt, mine, sp = 0u;
    for (;;) {
        sum = 0u; cnt = 0u; mine = 0u;
#pragma unroll
        for (unsigned j = 0; j < 16; ++j) { const unsigned c = xb_ld(&bar[XB_XCNT(j)]); sum += c; cnt += (c > 0u) ? 1u : 0u; mine = (j == x) ? c : mine; }
        if (sum == G) break;
        __builtin_amdgcn_s_sleep(1);
        if ((++sp & 255u) == 0u) { if (xb_ld(&bar[XB_TMO])) break; if (sp > XB_SPIN_CAP) { atomicAdd(&bar[XB_TMO], 1u); break; } }
    }
    nloc = mine > 0u ? mine : 1u; nx = cnt > 0u ? cnt : 1u;
}

__device__ __forceinline__ void xcd_barrier(const XcdBarrier& b) {
    asm volatile("s_waitcnt vmcnt(0)" ::: "memory");
    __syncthreads();
    if (threadIdx.x == 0) {
        unsigned* bar = b.bar;
        __builtin_amdgcn_s_waitcnt(0);
        unsigned nloc = b.st[0], nx = b.st[1];
        if (nloc == 0u) { xcd_barrier_complete(bar, b.x, nloc, nx); b.st[0] = nloc; b.st[1] = nx; }
        const unsigned old = xb_add(&bar[XB_XSUB(b.x)], 1u);
        const unsigned gen = old / nloc;
        if (old + 1u == (gen + 1u) * nloc) {
            __builtin_amdgcn_fence(__ATOMIC_RELEASE, "agent");
            asm volatile("s_waitcnt vmcnt(0)" ::: "memory");
            const unsigned og = xb_add(&bar[XB_TOP], 1u);
            const unsigned tg = og / nx;
            if (og + 1u == (tg + 1u) * nx) xb_add(&bar[XB_TOPGEN], 1u);
            else XB_SPIN(xb_ld(&bar[XB_TOPGEN]) == tg, bar);
            __builtin_amdgcn_fence(__ATOMIC_ACQUIRE, "agent");
            xb_add(&bar[XB_XGEN(b.x)], 1u);
            asm volatile("s_waitcnt vmcnt(0)" ::: "memory");
        } else {
            XB_SPIN(xb_ld(&bar[XB_XGEN(b.x)]) == gen, bar);
            __builtin_amdgcn_fence(__ATOMIC_ACQUIRE, "agent");
            asm volatile("s_waitcnt vmcnt(0)" ::: "memory");
        }
    }
    __syncthreads();
}
struct Args { const float* in[16]; float* out; unsigned char* ws; int ph_lo, ph_hi; };

#ifdef SELFTEST
constexpr int CW_FLAG = 64, CW_FLAG2 = 128;
__device__ __forceinline__ void st_flag2(gu32* ctl, unsigned bits) { atomicOr((unsigned*)ctl + CW_FLAG2, bits); }
__device__ __forceinline__ void st_flag(gu32* ctl, int code) { atomicOr((unsigned*)ctl + CW_FLAG, 1u << code); }
__device__ __forceinline__ bool st_close(float got, float want, float rel, float ab) { return fabsf(got - want) <= rel * fabsf(want) + ab; }
__device__ __forceinline__ void scan_poison(const void* p, size_t nbytes, int code, gu32* ctl, size_t gtid, size_t nthreads) {
    const v4u* q = (const v4u*)p; bool bad = false;
    for (size_t i = gtid; i < nbytes / 16; i += nthreads) { const v4u w = q[i]; bad |= (w.x == 0xAAAAAAAAu) | (w.y == 0xAAAAAAAAu) | (w.z == 0xAAAAAAAAu) | (w.w == 0xAAAAAAAAu); }
    if (bad) st_flag(ctl, code);
}
__device__ __forceinline__ float dot_bf16(const bf16* a, const bf16* b, int K, int lane) {
    float s = 0.f;
    for (int k = lane * 8; k < K; k += 512) { const v4u x = *(const v4u*)(a + k), y = *(const v4u*)(b + k);
        s += bflo(x.x) * bflo(y.x) + bfhi(x.x) * bfhi(y.x) + bflo(x.y) * bflo(y.y) + bfhi(x.y) * bfhi(y.y) + bflo(x.z) * bflo(y.z) + bfhi(x.z) * bfhi(y.z) + bflo(x.w) * bflo(y.w) + bfhi(x.w) * bfhi(y.w); }
    return wave_sum(s);
}
__device__ __forceinline__ unsigned hash_u(unsigned x) { x ^= x >> 16; x *= 0x7feb352dU; x ^= x >> 15; x *= 0x846ca68bU; x ^= x >> 16; return x; }
__device__ __forceinline__ float ldbf(const bf16* p) { return __uint_as_float((unsigned)(*p) << 16); }
__device__ __forceinline__ void sincos_d(double x, double& s, double& c) {
    const double TWO_PI = 6.283185307179586; const double k = rint(x / TWO_PI); const double r = x - k * TWO_PI, r2 = r * r;
    double ts = 1.0, tc = 1.0;
    for (int i = 14; i >= 1; --i) { ts = 1.0 - r2 / (double)((2 * i) * (2 * i + 1)) * ts; tc = 1.0 - r2 / (double)((2 * i - 1) * (2 * i)) * tc; }
    s = r * ts; c = tc;
}

template <int NC> __device__ __forceinline__ void brute_row(const bf16* q, const bf16* Kb, const bf16* Vb, size_t kstride, int nkeys, float (&o)[NC], float& lse, int lane) {
    const unsigned qw = *(const unsigned*)(q + 2 * lane); const float q0 = bflo(qw), q1 = bfhi(qw);
    float mx = -1e30f;
    for (int j = 0; j < nkeys; ++j) { const unsigned kw = *(const unsigned*)(Kb + (size_t)j * kstride + 2 * lane); const float sc = wave_sum(q0 * bflo(kw) + q1 * bfhi(kw)) * ATT_SCALE; mx = fmaxf(mx, sc); }
    float l = 0.f;
#pragma unroll
    for (int c = 0; c < NC; ++c) o[c] = 0.f;
    for (int j = 0; j < nkeys; ++j) { const unsigned kw = *(const unsigned*)(Kb + (size_t)j * kstride + 2 * lane); const float sc = wave_sum(q0 * bflo(kw) + q1 * bfhi(kw)) * ATT_SCALE;
        const float p = expf(sc - mx); l += p;
#pragma unroll
        for (int c = 0; c < NC; ++c) o[c] += p * ldbf(Vb + (size_t)j * kstride + lane * NC + c); }
#pragma unroll
    for (int c = 0; c < NC; ++c) o[c] /= l;
    lse = mx + logf(l);
}
__device__ __forceinline__ void selftest(int k, const Args& a, int gw, int NGW, int lane) {
    unsigned char* ws = a.ws; gu32* ctl = (gu32*)(ws + WS_CTL);
    const size_t gtid = (size_t)gw * 64 + lane, nth = (size_t)NGW * 64;
    const bf16* H = (const bf16*)(ws + WS_H);
    if (k == 0) {
        scan_poison(ws + WS_WIN, WS_H + 64 * MiB - WS_WIN, 1, ctl, gtid, nth);
        for (unsigned s = (unsigned)gtid; s < 1u << 20; s += (unsigned)nth) {
            const unsigned h1 = hash_u(s * 2u + 1u), h2 = hash_u(s * 2u + 2u); const int mat = s % 6;
            const float* W; const bf16* WT; int K, N; const float* sc = nullptr;
            if (mat == 0) { W = a.in[2]; WT = (const bf16*)(ws + WS_WIN); K = DM; N = NIN; }
            else if (mat == 1) { W = a.in[4]; WT = (const bf16*)(ws + WS_WA); K = 512; N = DM; }
            else if (mat == 2) { W = a.in[5]; WT = (const bf16*)(ws + WS_WB); K = 2048; N = DM; }
            else if (mat == 3) { W = a.in[6]; WT = (const bf16*)(ws + WS_WOUT); K = DM; N = DM; }
            else if (mat == 4) { W = a.in[13]; WT = (const bf16*)(ws + WS_WFF1); K = DM; N = DFF; sc = a.in[12]; }
            else { W = a.in[14]; WT = (const bf16*)(ws + WS_WFF2); K = DFF; N = DM; }
            const int kk = h1 % K, n = h2 % N; float w = W[(size_t)kk * N + n]; if (sc) w *= sc[kk];
            if (WT[(size_t)n * K + kk] != (bf16)f2bf(w)) st_flag(ctl, 1);
        }
        for (int s = gw; s < 256; s += NGW) {
            const int row = hash_u(s + 777u) % SEQ; const float* xr = a.in[0] + (size_t)row * DM; float ss = 0.f;
            for (int c = lane; c < DM; c += 64) ss += xr[c] * xr[c];
            const float rstd = rsqrtf(wave_sum(ss) * (1.f / DM) + RMS_EPS); bool bad = false;
            for (int c = lane; c < DM; c += 64) bad |= !st_close(ldbf(H + (size_t)row * DM + c), xr[c] * rstd * a.in[1][c], 0.01f, 1e-3f);
            if (bad) st_flag(ctl, 1);
        }
    } else if (k == 1) {
        { const v4u* q = (const v4u*)(ws + WS_QA); bool bad = false;
          for (size_t i = gtid; i < 296 * MiB / 16; i += nth) { const v4u w = q[i]; bad |= (w.x == 0xAAAAAAAAu) | (w.y == 0xAAAAAAAAu) | (w.z == 0xAAAAAAAAu) | (w.w == 0xAAAAAAAAu); }
          if (bad) { st_flag(ctl, 2); st_flag2(ctl, 1u); } }
        for (int s = gw; s < 16384; s += NGW) {
            const int row = (s < 64) ? (s * 131) % SEQ : hash_u(s * 2u + 1u) % SEQ, col = hash_u(s * 2u + 2u) % NIN;
            const float acc = dot_bf16(H + (size_t)row * DM, (const bf16*)(ws + WS_WIN) + (size_t)col * DM, DM, lane);
            size_t off; int ld, c0, mode;
            if (col < 1536) { off = WS_QA; ld = 1536; c0 = col; mode = 1; }
            else if (col < 3072) { off = WS_KA; ld = 1536; c0 = col - 1536; mode = 1; }
            else if (col < 4608) { off = WS_VA; ld = 1536; c0 = col - 3072; mode = 0; }
            else if (col < 6656) { off = WS_QB; ld = 2048; c0 = col - 4608; mode = 1; }
            else if (col < 8704) { off = WS_KB; ld = 2048; c0 = col - 6656; mode = 1; }
            else if (col < 10752) { off = WS_VB; ld = 2048; c0 = col - 8704; mode = 0; }
            else if (col < 14848) { off = WS_GA; ld = 4096; c0 = col - 10752; mode = 2; }
            else { off = WS_GB; ld = 4096; c0 = col - 14848; mode = 2; }
            const float got = ldbf((const bf16*)(ws + off) + (size_t)row * ld + c0);
            float want = acc; int code = 2;
            if (mode == 2) want = 1.f / (1.f + expf(-(acc + a.in[3][col - 10752])));
            else if (mode == 1 && (c0 & 127) < 32) { code = 3; const int d = c0 & 127, j = d & 15;
                const float acc2 = dot_bf16(H + (size_t)row * DM, (const bf16*)(ws + WS_WIN) + (size_t)(col ^ 16) * DM, DM, lane);
                const float inv = (float)exp2(-(double)j * (18.931568569324174 / 16.0)); const float ang = (float)row * inv;
                double sn, cs; sincos_d((double)ang, sn, cs);
                want = (d < 16) ? acc * (float)cs - acc2 * (float)sn : acc * (float)cs + acc2 * (float)sn; }
            if (mode == 2 && lane == 0) atomicAdd((unsigned*)ctl + CW_FLAG2 + 2, 1u);
            if (!st_close(got, want, 0.02f, 0.03f)) { st_flag(ctl, code);
                if (mode == 2) { const int pn = col / 256; st_flag2(ctl, (pn < 58 ? 1u : 0u) | ((pn >= 58 && pn != 73) ? 2u : 0u) | (pn == 73 ? 4u : 0u) | (((row & 255) < 128) ? 8u : 16u)); if (lane == 0) atomicAdd((unsigned*)ctl + CW_FLAG2 + 1, 1u); } }
        }
    } else if (k == 2) {
        scan_poison(ws + WS_OA, 176 * MiB, 4, ctl, gtid, nth); scan_poison(ws + WS_LSE, 3 * SEQ * 4 * 4, 4, ctl, gtid, nth);
        const float* OA = (const float*)(ws + WS_OA); const float* OB = (const float*)(ws + WS_OB); const float* LSE = (const float*)(ws + WS_LSE);
        for (int s = gw; s < 1024; s += NGW) {
            const int t = (s < 200) ? s * 3 : hash_u(s * 2u + 1u) % SEQ, ah = hash_u(s * 2u + 2u) % 12, g = ah >> 2, r = (g == 0) ? 1 : (g == 1) ? 4 : 16;
            const int i = t / r, rho = t % r, i0 = (i > 128) ? i - 128 : 0;
            const bf16* KA = (const bf16*)(ws + WS_KA) + (size_t)(rho + r * i0) * 1536 + ah * 128; const bf16* VA = (const bf16*)(ws + WS_VA) + (size_t)(rho + r * i0) * 1536 + ah * 128;
            float o[2]; float lse; brute_row<2>((const bf16*)(ws + WS_QA) + (size_t)t * 1536 + ah * 128, KA, VA, (size_t)r * 1536, i - i0 + 1, o, lse, lane);
            const float* got = OA + ((size_t)g * SEQ + t) * 512 + (ah & 3) * 128 + lane * 2;
            if (!st_close(got[0], o[0], 2e-3f, 2e-3f) || !st_close(got[1], o[1], 2e-3f, 2e-3f) || !st_close(LSE[((size_t)g * SEQ + t) * 4 + (ah & 3)], lse, 1e-3f, 2e-3f)) st_flag(ctl, 10);
        }
        for (int s = gw; s < 512; s += NGW) {
            const int t = (s < 100) ? s * 2 : hash_u(s * 2u + 1u) % SEQ, hi = hash_u(s * 2u + 2u) % 16;
            float o[4]; float lse; brute_row<4>((const bf16*)(ws + WS_QB) + (size_t)t * 2048 + hi * 128, (const bf16*)(ws + WS_KB) + hi * 128, (const bf16*)(ws + WS_VB) + (hi >> 1) * 256, (size_t)2048, t + 1, o, lse, lane);
            const float* got = OB + (size_t)t * 4096 + hi * 256 + lane * 4; bool bad = false;
#pragma unroll
            for (int c = 0; c < 4; ++c) bad |= !st_close(got[c], o[c], 2e-3f, 2e-3f);
            if (bad) st_flag(ctl, 11);
        }
    } else if (k == 3) {
        scan_poison(ws + WS_YA, 40 * MiB, 5, ctl, gtid, nth);
        const float* OA = (const float*)(ws + WS_OA); const float* OB = (const float*)(ws + WS_OB); const float* LSE = (const float*)(ws + WS_LSE);
        float d1 = 0.f, d2 = 0.f; for (int e = 0; e < 128; ++e) { d1 += a.in[7][e] * a.in[8][e]; d2 += a.in[9][e] * a.in[10][e]; }
        const float lam = expf(d1) - expf(d2) + 0.2f;
        for (int s = gw; s < 256; s += NGW) { const int t = hash_u(s + 99u) % SEQ; bool bad = false;
            for (int c = lane; c < 512; c += 64) { const int hg = c >> 7; float l[3], mx = -1e30f; for (int g = 0; g < 3; ++g) { l[g] = LSE[((size_t)g * SEQ + t) * 4 + hg]; mx = fmaxf(mx, l[g]); }
                float den = 0.f, num = 0.f; for (int g = 0; g < 3; ++g) { const float e = expf(l[g] - mx); den += e; num += e * OA[((size_t)g * SEQ + t) * 512 + c]; }
                bad |= !st_close(ldbf((const bf16*)(ws + WS_YA) + (size_t)t * 512 + c), num / den, 0.01f, 1e-3f); }
            for (int h = 0; h < 8; ++h) { float dd[4]; float ss = 0.f;
                for (int e = 0; e < 4; ++e) { const int c = lane + 64 * e; dd[e] = OB[(size_t)t * 4096 + (2 * h) * 256 + c] - lam * OB[(size_t)t * 4096 + (2 * h + 1) * 256 + c]; ss += dd[e] * dd[e]; }
                ss = wave_sum(ss); const float rstd = 0.8f / sqrtf(ss / 256.f + RMS_EPS);
                for (int e = 0; e < 4; ++e) { const int c = lane + 64 * e; bad |= !st_close(ldbf((const bf16*)(ws + WS_YB) + (size_t)t * 2048 + h * 256 + c), dd[e] * rstd * a.in[11][c], 0.01f, 2e-3f); } }
            if (bad) st_flag(ctl, 12);
        }
    } else if (k == 4) {
        scan_poison(ws + WS_T, 128 * MiB, 6, ctl, gtid, nth);
        for (int s = gw; s < 8192; s += NGW) {
            const int row = (s < 64) ? (s * 131) % SEQ : hash_u(s * 2u + 1u) % SEQ, col = hash_u(s * 2u + 2u) % DM;
            const float pa = dot_bf16((const bf16*)(ws + WS_YA) + (size_t)row * 512, (const bf16*)(ws + WS_WA) + (size_t)col * 512, 512, lane);
            const float pb = dot_bf16((const bf16*)(ws + WS_YB) + (size_t)row * 2048, (const bf16*)(ws + WS_WB) + (size_t)col * 2048, 2048, lane);
            const size_t idx = (size_t)row * DM + col;
            const float want = ldbf((const bf16*)(ws + WS_GA) + idx) * pa + ldbf((const bf16*)(ws + WS_GB) + idx) * pb;
            if (!st_close(ldbf((const bf16*)(ws + WS_MG) + idx), want, 0.02f, 0.02f)) st_flag(ctl, 6);
        }
    } else if (k == 5) {
        scan_poison(ws + WS_H, 64 * MiB, 7, ctl, gtid, nth); scan_poison(ws + WS_RSS, 2 * MiB, 7, ctl, gtid, nth);
        for (int s = gw; s < 8192; s += NGW) {
            const int row = (s < 64) ? (s * 131) % SEQ : hash_u(s * 2u + 1u) % SEQ, col = hash_u(s * 2u + 2u) % DM; const size_t idx = (size_t)row * DM + col;
            const float acc = dot_bf16((const bf16*)(ws + WS_MG) + (size_t)row * DM, (const bf16*)(ws + WS_WOUT) + (size_t)col * DM, DM, lane);
            const float want = a.in[0][idx] + acc;
            if (!st_close(ldbf(H + idx), want, 0.01f, 0.005f)) st_flag(ctl, 7);
            if (s < 512) { float ss = 0.f; for (int c = lane; c < DM; c += 64) { const float v = ldbf(H + (size_t)row * DM + c); ss += v * v; }
                ss = wave_sum(ss); const float part = wave_sum(((const float*)(ws + WS_RSS))[(size_t)row * 64 + lane]);
                if (!st_close(part, ss, 5e-3f, 1e-3f)) st_flag(ctl, 13); }
        }
    } else if (k == 6) {
        scan_poison(ws + WS_U2, 256 * MiB, 8, ctl, gtid, nth);
        for (int s = gw; s < 8192; s += NGW) {
            const int row = (s < 64) ? (s * 131) % SEQ : hash_u(s * 2u + 1u) % SEQ, col = hash_u(s * 2u + 2u) % DFF;
            const float part = wave_sum(((const float*)(ws + WS_RSS))[(size_t)row * 64 + lane]);
            const float rstd = rsqrtf(part * (1.f / DM) + RMS_EPS);
            const float acc = dot_bf16(H + (size_t)row * DM, (const bf16*)(ws + WS_WFF1) + (size_t)col * DM, DM, lane);
            float u = fmaxf(acc * rstd, 0.f); u *= u;
            if (!st_close(ldbf((const bf16*)(ws + WS_U2) + (size_t)row * DFF + col), u, 0.02f, 0.01f)) st_flag(ctl, 8);
        }
    } else if (k == 7) {
        for (int s = gw; s < 8192; s += NGW) {
            const int row = (s < 64) ? (s * 131) % SEQ : hash_u(s * 2u + 1u) % SEQ, col = hash_u(s * 2u + 2u) % DM; const size_t idx = (size_t)row * DM + col;
            const float acc = dot_bf16((const bf16*)(ws + WS_U2) + (size_t)row * DFF, (const bf16*)(ws + WS_WFF2) + (size_t)col * DFF, DFF, lane);
            const float x1 = ldbf(H + idx);
            if (!st_close(a.out[idx], x1 + acc, 0.005f, 0.01f + 0.005f * fabsf(x1))) st_flag(ctl, 9);
        }
    }
}
#endif
__device__ __forceinline__ void p0_transpose_item(const float* W, int K, int N, bf16* WT, const float* kscale, LAS float* scr, int item, int lane) {
    const int nblk = N / 32, kb = item / nblk, nb = item % nblk, k0 = 64 * kb, n0 = 32 * nb;
#pragma unroll 8
    for (int i = 0; i < 32; ++i) { const int kk = 2 * i + (lane >> 5); float w = W[(size_t)(k0 + kk) * N + n0 + (lane & 31)]; if (kscale) w *= kscale[k0 + kk]; scr[kk * 33 + (lane & 31)] = w; }
    LDS_WAIT(); asm volatile("" ::: "memory");
    const int c = lane & 7;
#pragma unroll
    for (int j = 0; j < 4; ++j) { const int n = (lane >> 3) + 8 * j; const LAS float* s = scr + (8 * c) * 33 + n;
        v4u o; o.x = pk2(s[0 * 33], s[1 * 33]); o.y = pk2(s[2 * 33], s[3 * 33]); o.z = pk2(s[4 * 33], s[5 * 33]); o.w = pk2(s[6 * 33], s[7 * 33]);
        *(GAS v4u*)(WT + (size_t)(n0 + n) * K + k0 + 8 * c) = o; }
    LDS_WAIT(); asm volatile("" ::: "memory");
}
template <bool OUT_BF16> __device__ __forceinline__ void rms_row(const float* xrow, const float* g, void* orow, int lane, float oscale = 1.f) {
    const GAS f32x4* xr = (const GAS f32x4*)xrow + lane; const GAS f32x4* gr = (const GAS f32x4*)g + lane;
    f32x4 v[16]; float s = 0.f;
#pragma unroll
    for (int j = 0; j < 16; ++j) { v[j] = xr[64 * j]; s += (v[j].x * v[j].x + v[j].y * v[j].y) + (v[j].z * v[j].z + v[j].w * v[j].w); }
    const float rstd = rsqrtf(wave_sum(s) * (1.f / DM) + RMS_EPS) * oscale;
#pragma unroll
    for (int j = 0; j < 16; ++j) { const f32x4 gv = gr[64 * j]; const f32x4 o = v[j] * rstd * gv;
        if (OUT_BF16) { v2u w; w.x = pk2(o.x, o.y); w.y = pk2(o.z, o.w); ((GAS v2u*)orow)[lane + 64 * j] = w; }
        else ((GAS f32x4*)orow)[lane + 64 * j] = o; }
}
__device__ __forceinline__ void p0_prologue(const Args& a, LAS unsigned char* L, int gw, int NGW, int wave, int lane) {
    LAS float* scr = (LAS float*)(L + wave * 16384);
    unsigned char* ws = a.ws;
    constexpr int I_IN = (DM / 64) * (NIN / 32), I_A = (512 / 64) * (DM / 32), I_B = (2048 / 64) * (DM / 32), I_O = (DM / 64) * (DM / 32), I_1 = (DM / 64) * (DFF / 32), I_2 = (DFF / 64) * (DM / 32);
    constexpr int NITEMS = I_IN + I_A + I_B + I_O + I_1 + I_2;
    for (int it = gw; it < NITEMS; it += NGW) {
        int r = it;
        if (r < I_IN) { p0_transpose_item(a.in[2], DM, NIN, (bf16*)(ws + WS_WIN), nullptr, scr, r, lane); continue; } r -= I_IN;
        if (r < I_A) { p0_transpose_item(a.in[4], 512, DM, (bf16*)(ws + WS_WA), nullptr, scr, r, lane); continue; } r -= I_A;
        if (r < I_B) { p0_transpose_item(a.in[5], 2048, DM, (bf16*)(ws + WS_WB), nullptr, scr, r, lane); continue; } r -= I_B;
        if (r < I_O) { p0_transpose_item(a.in[6], DM, DM, (bf16*)(ws + WS_WOUT), nullptr, scr, r, lane); continue; } r -= I_O;
        if (r < I_1) { p0_transpose_item(a.in[13], DM, DFF, (bf16*)(ws + WS_WFF1), a.in[12], scr, r, lane); continue; } r -= I_1;
        p0_transpose_item(a.in[14], DFF, DM, (bf16*)(ws + WS_WFF2), nullptr, scr, r, lane);
    }
    for (int m = gw; m < SEQ; m += NGW) rms_row<true>(a.in[0] + (size_t)m * DM, a.in[1], (bf16*)(ws + WS_H) + (size_t)m * DM, lane);
}

template <int DV> __device__ __forceinline__ void naive_row(const bf16* q, const bf16* Kb, const bf16* Vb, size_t kstride, int nkeys, LAS float* qs, LAS float* ps, float (&o)[DV / 64], float& lse, int lane) {
    constexpr int NC = DV / 64;
    { const unsigned w = *(const unsigned*)(q + 2 * lane); qs[2 * lane] = bflo(w); qs[2 * lane + 1] = bfhi(w); }
    LDS_WAIT(); asm volatile("" ::: "memory");
    float m = -1e30f, l = 0.f;
#pragma unroll
    for (int c = 0; c < NC; ++c) o[c] = 0.f;
    for (int c0 = 0; c0 < nkeys; c0 += 64) {
        const int j = c0 + lane; const bool valid = j < nkeys;
        float s = -__builtin_inff();
        if (valid) { const v4u* kp = (const v4u*)(Kb + (size_t)j * kstride); float acc = 0.f;
#pragma unroll 4
            for (int d = 0; d < 16; ++d) { const v4u kv = kp[d]; const LAS float* qq = qs + 8 * d;
                acc += bflo(kv.x) * qq[0] + bfhi(kv.x) * qq[1] + bflo(kv.y) * qq[2] + bfhi(kv.y) * qq[3] + bflo(kv.z) * qq[4] + bfhi(kv.z) * qq[5] + bflo(kv.w) * qq[6] + bfhi(kv.w) * qq[7]; }
            s = acc * ATT_SCALE; }
        const float mn = fmaxf(m, wave_max(s));
        const float p = valid ? __expf(s - mn) : 0.f;
        const float alpha = __expf(m - mn);
        l = l * alpha + wave_sum(p); m = mn;
#pragma unroll
        for (int c = 0; c < NC; ++c) o[c] *= alpha;
        ps[lane] = p; LDS_WAIT(); asm volatile("" ::: "memory");
        const int cnt = (nkeys - c0) < 64 ? (nkeys - c0) : 64;
        const bf16* vp = Vb + (size_t)c0 * kstride + lane * NC;
#pragma unroll 4
        for (int kk = 0; kk < cnt; ++kk) { const float pj = ps[kk];
            if constexpr (NC == 2) { const unsigned w = *(const unsigned*)(vp + (size_t)kk * kstride); o[0] += pj * bflo(w); o[1] += pj * bfhi(w); }
            else { const v2u w = *(const v2u*)(vp + (size_t)kk * kstride); o[0] += pj * bflo(w.x); o[1] += pj * bfhi(w.x); o[NC - 2] += pj * bflo(w.y); o[NC - 1] += pj * bfhi(w.y); } }
        LDS_WAIT(); asm volatile("" ::: "memory");
    }
    const float inv = 1.f / l;
#pragma unroll
    for (int c = 0; c < NC; ++c) o[c] *= inv;
    lse = m + __logf(l);
}
__device__ __forceinline__ void p2_attention_naive(const Args& a, LAS unsigned char* L, int gw, int NGW, int wave, int lane) {
    unsigned char* ws = a.ws;
    LAS float* qs = (LAS float*)(L + wave * 1024); LAS float* ps = qs + 128;
    const bf16* QA = (const bf16*)(ws + WS_QA); const bf16* KA = (const bf16*)(ws + WS_KA); const bf16* VA = (const bf16*)(ws + WS_VA);
    const bf16* QB = (const bf16*)(ws + WS_QB); const bf16* KB = (const bf16*)(ws + WS_KB); const bf16* VB = (const bf16*)(ws + WS_VB);
    float* OA = (float*)(ws + WS_OA); float* OB = (float*)(ws + WS_OB); float* LSE = (float*)(ws + WS_LSE);
    for (int it = gw; it < SEQ * 12; it += NGW) {
        const int t = it / 12, ah = it - t * 12, g = ah >> 2, r = (g == 0) ? 1 : (g == 1) ? 4 : 16;
        const int i = t / r, rho = t - i * r, i0 = (i - 128) > 0 ? (i - 128) : 0, nkeys = i - i0 + 1;
        const size_t first = (size_t)(rho + r * i0) * 1536 + ah * 128;
        float o[2]; float lse;
        naive_row<128>(QA + (size_t)t * 1536 + ah * 128, KA + first, VA + first, (size_t)r * 1536, nkeys, qs, ps, o, lse, lane);
        float* op = OA + ((size_t)g * SEQ + t) * 512 + (ah & 3) * 128 + lane * 2; op[0] = o[0]; op[1] = o[1];
        if (lane == 0) LSE[((size_t)g * SEQ + t) * 4 + (ah & 3)] = lse;
    }
    for (int it = gw; it < SEQ * 16; it += NGW) {
        const int t = it >> 4, hi = it & 15;
        float o[4]; float lse;
        naive_row<256>(QB + (size_t)t * 2048 + hi * 128, KB + hi * 128, VB + (hi >> 1) * 256, (size_t)2048, t + 1, qs, ps, o, lse, lane);
        *(f32x4*)(OB + (size_t)t * 4096 + hi * 256 + lane * 4) = (f32x4){o[0], o[1], o[2], o[3]};
    }
}
__device__ __forceinline__ void p3_combine(const Args& a, int gw, int NGW, int lane) {
    unsigned char* ws = a.ws;
    const float* OA = (const float*)(ws + WS_OA); const float* OB = (const float*)(ws + WS_OB); const float* LSE = (const float*)(ws + WS_LSE);
    bf16* YA = (bf16*)(ws + WS_YA); bf16* YB = (bf16*)(ws + WS_YB);
    float d1 = a.in[7][lane] * a.in[8][lane] + a.in[7][lane + 64] * a.in[8][lane + 64];
    float d2 = a.in[9][lane] * a.in[10][lane] + a.in[9][lane + 64] * a.in[10][lane + 64];
    d1 = wave_sum(d1); d2 = wave_sum(d2);
    const float lam_init = 0.2f;
    const float lam = expf(d1) - expf(d2) + lam_init;
    const f32x4 sg = *(const f32x4*)(a.in[11] + lane * 4);
    for (int t = gw; t < SEQ; t += NGW) {
        { const int hg = lane >> 4;
          const float l0 = LSE[((size_t)0 * SEQ + t) * 4 + hg], l1 = LSE[((size_t)1 * SEQ + t) * 4 + hg], l2 = LSE[((size_t)2 * SEQ + t) * 4 + hg];
          const float mx = fmaxf(l0, fmaxf(l1, l2)); const float e0 = expf(l0 - mx), e1 = expf(l1 - mx), e2 = expf(l2 - mx); const float inv = 1.f / (e0 + e1 + e2);
          const float a0 = e0 * inv, a1 = e1 * inv, a2 = e2 * inv;
          const f32x4* p0 = (const f32x4*)(OA + ((size_t)0 * SEQ + t) * 512 + lane * 8); const f32x4* p1 = (const f32x4*)(OA + ((size_t)1 * SEQ + t) * 512 + lane * 8); const f32x4* p2 = (const f32x4*)(OA + ((size_t)2 * SEQ + t) * 512 + lane * 8);
          const f32x4 x0 = p0[0] * a0 + p1[0] * a1 + p2[0] * a2, x1 = p0[1] * a0 + p1[1] * a1 + p2[1] * a2;
          v4u w; w.x = pk2(x0.x, x0.y); w.y = pk2(x0.z, x0.w); w.z = pk2(x1.x, x1.y); w.w = pk2(x1.z, x1.w);
          *(v4u*)(YA + (size_t)t * 512 + lane * 8) = w; }
#pragma unroll 2
        for (int h = 0; h < 8; ++h) {
            const f32x4 o1 = *(const f32x4*)(OB + (size_t)t * 4096 + (2 * h) * 256 + lane * 4), o2 = *(const f32x4*)(OB + (size_t)t * 4096 + (2 * h + 1) * 256 + lane * 4);
            const f32x4 d = o1 - o2 * lam;
            const float ss = wave_sum((d.x * d.x + d.y * d.y) + (d.z * d.z + d.w * d.w));
            const float rstd = rsqrtf(ss * (1.f / 256.f) + RMS_EPS) * (1.f - lam_init);
            const f32x4 y = d * rstd * sg;
            v2u w; w.x = pk2(y.x, y.y); w.y = pk2(y.z, y.w);
            *(v2u*)(YB + (size_t)t * 2048 + h * 256 + lane * 4) = w;
        }
    }
}

__global__ void __launch_bounds__(NWAVES * 64, 2) fwd(Args args) {
    extern __shared__ __attribute__((aligned(16))) unsigned char lds[];
    LAS unsigned char* L = (LAS unsigned char*)lds;
    volatile LAS unsigned* MISC = (volatile LAS unsigned*)(L + MISC_OFF);
    const int tid = threadIdx.x, lane = tid & 63, wave = __builtin_amdgcn_readfirstlane(tid >> 6);
    const int G = gridDim.x, bx = blockIdx.x;
    const int vcu = (G % 8 == 0) ? (bx % 8) * (G / 8) + bx / 8 : bx;
    const int gw = vcu * NWAVES + wave, NGW = G * NWAVES;
    unsigned char* ws = args.ws;
    gu32* ctl = (gu32*)(ws + WS_CTL);
    for (int u = tid; u < (LDS_BYTES - LDSCTL_OFF) / 4; u += NWAVES * 64) ((LAS unsigned*)(L + LDSCTL_OFF))[u] = 0u;
    __syncthreads();
    const int lo = args.ph_lo, hi = args.ph_hi;
    const bool multi = (hi - lo) > 1;
    XcdBarrier bar; bar.bar = (unsigned*)(ctl + CW_BAR); bar.x = 0; bar.st = nullptr;
    if (multi) bar = xcd_barrier_post((unsigned*)(ctl + CW_BAR), MISC + 8);
#ifdef SELFTEST
    if (lo >= 16) { selftest(lo - 16, args, gw, NGW, lane); return; }
#endif
#define IN(k) (lo <= (k) && (k) < hi)
#ifdef SELFTEST
#define SEAM(k) do { if (IN(k) && IN((k) + 1)) { xcd_barrier(bar); selftest((k), args, gw, NGW, lane); xcd_barrier(bar); } } while (0)
#else
#define SEAM(k) do { if (IN(k) && IN((k) + 1)) xcd_barrier(bar); } while (0)
#endif

    if (IN(0)) { p0_prologue(args, L, gw, NGW, wave, lane); SEAM(0); }

    if (IN(1)) {
        pg8::Gemm g{(const bf16*)(ws + WS_H), (const bf16*)(ws + WS_WIN), SEQ, NIN, DM}; pg8::StaticOrder S; S.init(SEQ, NIN, G, bx);
        pg8::EpiProj E{ws, args.in[3]};
        pg8::gemm_phase<pg8::EpiProj, pg8::StaticOrder, true, true>(L, g, S, E);
        SEAM(1);
    }
    if (IN(2)) { p2_attention_naive(args, L, gw, NGW, wave, lane); SEAM(2); }
    if (IN(3)) { p3_combine(args, gw, NGW, lane); SEAM(3); }
    if (IN(4)) {
        { pg8::Gemm g{(const bf16*)(ws + WS_YA), (const bf16*)(ws + WS_WA), SEQ, DM, 512}; pg8::StaticOrder S; S.init(SEQ, DM, G, bx);
          pg8::EpiGate<false> E{(const bf16*)(ws + WS_GA), nullptr, (bf16*)(ws + WS_T)};
          pg8::gemm_phase<pg8::EpiGate<false>, pg8::StaticOrder, true, true>(L, g, S, E); }
        VM_WAIT(); __syncthreads();
        { pg8::Gemm g{(const bf16*)(ws + WS_YB), (const bf16*)(ws + WS_WB), SEQ, DM, 2048}; pg8::StaticOrder S; S.init(SEQ, DM, G, bx);
          pg8::EpiGate<true> E{(const bf16*)(ws + WS_GB), (const bf16*)(ws + WS_T), (bf16*)(ws + WS_MG)};
          pg8::gemm_phase<pg8::EpiGate<true>, pg8::StaticOrder, true, true>(L, g, S, E); }
        SEAM(4);
    }
    if (IN(5)) {
        pg8::Gemm g{(const bf16*)(ws + WS_MG), (const bf16*)(ws + WS_WOUT), SEQ, DM, DM}; pg8::StaticOrder S; S.init(SEQ, DM, G, bx);
        pg8::EpiResid<true> E{args.in[0], args.out, (bf16*)(ws + WS_H), (float*)(ws + WS_RSS)};
        pg8::gemm_phase<pg8::EpiResid<true>, pg8::StaticOrder, true, true>(L, g, S, E);
        SEAM(5);
    }
    if (IN(6)) {
        pg8::Gemm g{(const bf16*)(ws + WS_H), (const bf16*)(ws + WS_WFF1), SEQ, DFF, DM}; pg8::StaticOrder S; S.init(SEQ, DFF, G, bx);
        pg8::EpiRelu2 E{(bf16*)(ws + WS_U2), (const float*)(ws + WS_RSS)};
        pg8::gemm_phase<pg8::EpiRelu2, pg8::StaticOrder, true, true>(L, g, S, E);
        SEAM(6);
    }
    if (IN(7)) {
        pg8::Gemm g{(const bf16*)(ws + WS_U2), (const bf16*)(ws + WS_WFF2), SEQ, DM, DFF}; pg8::StaticOrder S; S.init(SEQ, DM, G, bx);
        pg8::EpiResid<false> E{args.out, args.out, nullptr, nullptr};
        pg8::gemm_phase<pg8::EpiResid<false>, pg8::StaticOrder, true, true>(L, g, S, E);
        SEAM(7);
    }
    if (IN(8)) {
#ifdef SELFTEST
        const unsigned f = __hip_atomic_load((unsigned*)ctl + CW_FLAG, RLX_AGENT) & ~(unsigned)(SELFTEST_IGNORE);
        if (f) { const unsigned f2 = __hip_atomic_load((unsigned*)ctl + CW_FLAG2, RLX_AGENT), nf = __hip_atomic_load((unsigned*)ctl + CW_FLAG2 + 1, RLX_AGENT), nt = __hip_atomic_load((unsigned*)ctl + CW_FLAG2 + 2, RLX_AGENT);
            const float cv1 = f2 ? (float)f2 : (float)__builtin_ctz(f), cv2 = nt ? 1.f + (float)((nf * 30u) / nt) : 0.f;
            for (int m = gw; m < SEQ; m += NGW) for (int c = lane; c < DM; c += 64) args.out[(size_t)m * DM + c] = (m < SEQ / 2) ? cv1 : cv2; }
        else
#endif
        for (int m = gw; m < SEQ; m += NGW) rms_row<false>(args.out + (size_t)m * DM, args.in[15], args.out + (size_t)m * DM, lane);
    }
#undef IN
#undef SEAM
}

extern "C" void kernel_launch(void* const* d_in, const int* in_sizes, int n_in, void* d_out, int out_size, void* d_ws, size_t ws_size, hipStream_t stream) {
    static int grid = 0;
    if (grid == 0) {
        if (n_in != 16 || in_sizes[0] != SEQ * DM || out_size != SEQ * DM || ws_size < WS_END) { fprintf(stderr, "kernel_launch: shape/workspace mismatch (n_in %d, in0 %d, out %d, ws %zu, need %zu); nothing launched\n", n_in, n_in > 0 ? in_sizes[0] : -1, out_size, ws_size, (size_t)WS_END); grid = -1; return; }
        int dev = 0, cus = 0;
        if (hipGetDevice(&dev) != hipSuccess || hipDeviceGetAttribute(&cus, hipDeviceAttributeMultiprocessorCount, dev) != hipSuccess) { grid = -1; return; }
        if (hipFuncSetAttribute((const void*)fwd, hipFuncAttributeMaxDynamicSharedMemorySize, LDS_BYTES) != hipSuccess) { fprintf(stderr, "kernel_launch: hipFuncSetAttribute failed\n"); grid = -1; return; }
        (void)hipGetLastError();
        grid = cus;
    }
    if (grid < 0) return;
    if (hipMemsetAsync((char*)d_ws + WS_CTL, 0, CTL_ZERO_BYTES, stream) != hipSuccess) return;
    Args a{};
    for (int i = 0; i < 16; ++i) a.in[i] = (const float*)d_in[i];
    a.out = (float*)d_out; a.ws = (unsigned char*)d_ws;
    constexpr int NL = MK_N_LAUNCHES;
    static_assert(NL == 1 || NL == N_PHASES, "MK_N_LAUNCHES is 1 or N_PHASES");
    for (int li = 0; li < NL; ++li) {
        a.ph_lo = (NL == 1) ? 0 : li; a.ph_hi = (NL == 1) ? N_PHASES : li + 1;
        hipLaunchKernelGGL(fwd, dim3(grid), dim3(NWAVES * 64), LDS_BYTES, stream, a);
        const hipError_t le = hipPeekAtLastError();
        if (le != hipSuccess) { fprintf(stderr, "kernel_launch: launch %d failed: %s\n", li, hipGetErrorName(le)); break; }
#ifdef SELFTEST
        if (NL == N_PHASES && li < 8) { Args c = a; c.ph_lo = 16 + li; c.ph_hi = 17 + li; hipLaunchKernelGGL(fwd, dim3(grid), dim3(NWAVES * 64), LDS_BYTES, stream, c); }
#endif
    }
}
```

```cpp
#include <hip/hip_runtime.h>
#include <cstdio>
#include <cstdint>
constexpr int SEQ = 8192, DM = 4096, NIN = 18944, DFF = 16384;
constexpr int NWAVES = 8;
constexpr float RMS_EPS = 1e-6f;
constexpr float ATT_SCALE = 0.08838834764831845f;
constexpr int N_PHASES = 9;
#ifndef MK_N_LAUNCHES
#define MK_N_LAUNCHES 1
#endif
constexpr size_t MiB = 1u << 20;
constexpr size_t WS_CTL = 0, CTL_ZERO_BYTES = 1 * MiB;
constexpr size_t WS_WIN = 1 * MiB;
constexpr size_t WS_WA = 149 * MiB;
constexpr size_t WS_WB = 153 * MiB;
constexpr size_t WS_WOUT = 169 * MiB;
constexpr size_t WS_WFF1 = 201 * MiB;
constexpr size_t WS_WFF2 = 329 * MiB;
constexpr size_t WS_H = 457 * MiB;
constexpr size_t WS_YA = 521 * MiB;
constexpr size_t WS_YB = 529 * MiB;
constexpr size_t WS_T = 561 * MiB;
constexpr size_t WS_MG = 625 * MiB;
constexpr size_t WS_RSS = 689 * MiB;
constexpr size_t WS_LSE = 691 * MiB;
constexpr size_t WS_R1 = 692 * MiB;
constexpr size_t WS_QA = WS_R1, WS_KA = WS_R1 + 24 * MiB, WS_VA = WS_R1 + 48 * MiB;
constexpr size_t WS_QB = WS_R1 + 72 * MiB, WS_KB = WS_R1 + 104 * MiB, WS_VB = WS_R1 + 136 * MiB;
constexpr size_t WS_GA = WS_R1 + 168 * MiB, WS_GB = WS_R1 + 232 * MiB;
constexpr size_t WS_OA = WS_R1 + 296 * MiB;
constexpr size_t WS_OB = WS_R1 + 344 * MiB;
constexpr size_t WS_U2 = WS_R1;
constexpr size_t WS_END = WS_R1 + 472 * MiB;
constexpr int CW_BAR = 4096;
constexpr int RING_BYTES = 131072, LDSCTL_OFF = RING_BYTES, MISC_OFF = LDSCTL_OFF + 320, LDS_BYTES = 147456;
namespace pg8 {
#define PG8_LAS __attribute__((address_space(3)))
typedef unsigned short bf16_t;
typedef short bf16x8 __attribute__((ext_vector_type(8)));
typedef float f32x4 __attribute__((ext_vector_type(4)));
typedef unsigned u32x4 __attribute__((ext_vector_type(4)));
constexpr int BM = 256, BK = 64, HALF = 128, HTB = HALF * BK * 2  , STAGE_BYTES = 8 * HTB, NXCD = 8, WGM = 8;

__host__ __device__ __forceinline__ int lds_byte(int r, int c) { const int st = (r >> 4) * 2 + (c >> 5), rr = r & 15, cc = c & 31, ob = rr * 64 + cc * 2; return st * 1024 + (ob ^ (((ob >> 9) & 1) << 5)); }
__host__ __device__ __forceinline__ void stage_rc(int b, int& R, int& C) { const int st = b / 1024, sb = b % 1024, swz = sb ^ (((sb >> 9) & 1) << 5); R = (st >> 1) * 16 + swz / 64; C = (st & 1) * 32 + (swz % 64) / 2; }
__host__ __device__ __forceinline__ int perm32(int rho) { const int n = rho >> 4, i = rho & 15; return 8 * (i >> 2) + 4 * n + (i & 3); }

struct Unit { int pm, pn; };
struct Gemm { const bf16_t* A; const bf16_t* Bt; int M, N, K; };

struct StaticOrder {
    int nM, nN, nwg, G, c;
    __host__ __device__ void init(int M, int N, int G_, int c_) { nM = M / BM; nN = N / BM; nwg = nM * nN; G = G_; c = c_; }
    __host__ __device__ bool next(int i, Unit& u) const {
        const long L = (long)i * G + c; if (L >= nwg) return false;
        int wgid = (int)L; { const int q = nwg / NXCD, r = nwg % NXCD, xcd = wgid % NXCD, off = wgid / NXCD; wgid = (xcd < r ? xcd * (q + 1) : r * (q + 1) + (xcd - r) * q) + off; }
        const int nig = WGM * nN, gid = wgid / nig, fm = gid * WGM, gsz = (nM - fm) < WGM ? (nM - fm) : WGM;
        u.pm = fm + ((wgid % nig) % gsz); u.pn = (wgid % nig) / gsz; return true;
    }
    __device__ __forceinline__ void a_ready(const Unit&) const {}
    __device__ __forceinline__ void done(const Unit&) const {}
};

typedef float f32x2c_t __attribute__((ext_vector_type(2))); typedef __bf16 bf16x2c_t __attribute__((ext_vector_type(2)));
__device__ __forceinline__ unsigned cvt_pk_bf16(float lo, float hi) { const f32x2c_t v = {lo, hi}; const bf16x2c_t b = __builtin_convertvector(v, bf16x2c_t); return __builtin_bit_cast(unsigned, b); }
typedef float f32x2 __attribute__((ext_vector_type(2)));
template <class Epi, class Sched, bool ALIGN_EPI = false, bool SP2 = false>
__device__ __forceinline__ void gemm_phase(PG8_LAS unsigned char* lds, const Gemm g, const Sched& S, const Epi& E) {
    const int tid = threadIdx.x, wid = __builtin_amdgcn_readfirstlane(tid >> 6), lane = tid & 63, wr = wid >> 2, wc = wid & 3, fr = lane & 15, fq = lane >> 4;
    const int K = g.K, nt = K / BK;
    unsigned voffA[2], voffB[2];
#pragma unroll
    for (int i = 0; i < 2; ++i) { int R, C; stage_rc(tid * 16 + i * 8192, R, C); const int Rb = Epi::PERM ? ((R & ~31) + perm32(R & 31)) : R;
        voffA[i] = (unsigned)(R * K + C) * 2u; voffB[i] = (unsigned)(Rb * K + C) * 2u; }
    const size_t kstep = (size_t)(BK * 2);
    const size_t hstep = (size_t)HALF * K * 2;
    const size_t tstep = 2 * hstep;
    const unsigned ldsw = (unsigned)wid * 1024u;
    const int aoff = lds_byte(wr * 64 + fr, fq * 8), boff = lds_byte(wc * 32 + fr, fq * 8);
#define PG8_SA(b, h) (((b) * 2 + (h)) * HTB)
#define PG8_SB(b, h) ((4 + (b) * 2 + (h)) * HTB)
#define PG8_STAGE(bufoff, gbase, voff) do { _Pragma("unroll") for (int _i = 0; _i < 2; ++_i) \
        __builtin_amdgcn_global_load_lds((const unsigned*)((const char*)(gbase) + (voff)[_i]), (PG8_LAS unsigned*)(lds + (bufoff) + ldsw + _i * 8192), 16, 0, 0); } while (0)
#define PG8_LDA(dst, b, h) do { _Pragma("unroll") for (int m = 0; m < 4; ++m) _Pragma("unroll") for (int k = 0; k < 2; ++k) dst[m][k] = *(const PG8_LAS bf16x8*)(lds + PG8_SA(b, h) + aoff + m * 2048 + k * 1024); } while (0)
#define PG8_LDB(dst, b, h) do { _Pragma("unroll") for (int n = 0; n < 2; ++n) _Pragma("unroll") for (int k = 0; k < 2; ++k) dst[n][k] = *(const PG8_LAS bf16x8*)(lds + PG8_SB(b, h) + boff + n * 2048 + k * 1024); } while (0)
#define PG8_MMA(ai, bj, At, Bt) do { __builtin_amdgcn_s_setprio(1); _Pragma("unroll") for (int m = 0; m < 4; ++m) _Pragma("unroll") for (int n = 0; n < 2; ++n) _Pragma("unroll") for (int k = 0; k < 2; ++k) \
        acc[ai][bj][m][n] = __builtin_amdgcn_mfma_f32_16x16x32_bf16(Bt[n][k], At[m][k], acc[ai][bj][m][n], 0, 0, 0); __builtin_amdgcn_s_setprio(0); } while (0)
#define PG8_WAIT_V(n) asm volatile("s_waitcnt vmcnt(" #n ")" ::: "memory")
#define PG8_WAIT_L(n) asm volatile("s_waitcnt lgkmcnt(" #n ")" ::: "memory")
#define PG8_BAR __builtin_amdgcn_s_barrier()
#define PG8_SCHED __builtin_amdgcn_sched_barrier(0)
    Unit cur, nxt; int ui = 0;
    if (!S.next(0, cur)) return;
    f32x4 acc[2][2][4][2];
#pragma unroll
    for (int a = 0; a < 2; ++a)
#pragma unroll
        for (int b = 0; b < 2; ++b)
#pragma unroll
            for (int m = 0; m < 4; ++m)
#pragma unroll
                for (int n = 0; n < 2; ++n) acc[a][b][m][n] = (f32x4){0.f, 0.f, 0.f, 0.f};
    bf16x8 At[4][2], B0[2][2], B1[2][2];
    const char* cA = (const char*)g.A + (size_t)cur.pm * tstep; const char* cB = (const char*)g.Bt + (size_t)cur.pn * tstep;
    S.a_ready(cur);
    if constexpr (SP2) {
        PG8_STAGE(PG8_SB(0, 0), cB, voffB); PG8_STAGE(PG8_SB(0, 1), cB + hstep, voffB); PG8_STAGE(PG8_SA(0, 0), cA, voffA); PG8_STAGE(PG8_SA(0, 1), cA + hstep, voffA);
        if (wr == 1) PG8_BAR;
        PG8_WAIT_V(2); PG8_BAR;
        PG8_STAGE(PG8_SB(1, 0), cB + kstep, voffB); PG8_STAGE(PG8_SA(1, 0), cA + kstep, voffA); PG8_STAGE(PG8_SB(1, 1), cB + hstep + kstep, voffB);
        PG8_WAIT_V(6); PG8_BAR;
    } else {
        PG8_STAGE(PG8_SB(0, 0), cB, voffB); PG8_STAGE(PG8_SA(0, 0), cA, voffA); PG8_STAGE(PG8_SB(0, 1), cB + hstep, voffB); PG8_STAGE(PG8_SA(0, 1), cA + hstep, voffA);
        if (wr == 1) PG8_BAR;
        PG8_WAIT_V(4); PG8_BAR;
        PG8_STAGE(PG8_SB(1, 0), cB + kstep, voffB); PG8_STAGE(PG8_SA(1, 0), cA + kstep, voffA); PG8_STAGE(PG8_SB(1, 1), cB + hstep + kstep, voffB);
        PG8_WAIT_V(6); PG8_BAR;
    }
    for (;;) {
        const bool has_next = S.next(ui + 1, nxt);
        const char* nA = has_next ? (const char*)g.A + (size_t)nxt.pm * tstep : cA; const char* nB = has_next ? (const char*)g.Bt + (size_t)nxt.pn * tstep : cB;
        for (int t = 0; t < nt; t += 2) {
            const bool last = (t == nt - 2);
            const char* a1 = cA + (size_t)(t + 1) * kstep;
            const char* a2 = last ? nA : cA + (size_t)(t + 2) * kstep; const char* b2 = last ? nB : cB + (size_t)(t + 2) * kstep;
            const char* a3 = a2 + kstep; const char* b3 = b2 + kstep;
            if (last && has_next) S.a_ready(nxt);
            if constexpr (SP2) {
            PG8_LDB(B0, 0, 0); PG8_LDB(B1, 0, 1); PG8_SCHED; PG8_LDA(At, 0, 0); PG8_STAGE(PG8_SA(1, 1), a1 + hstep, voffA);
            PG8_WAIT_V(8); PG8_WAIT_L(0); PG8_BAR; PG8_MMA(0, 0, At, B0); PG8_MMA(0, 1, At, B1); PG8_BAR; PG8_SCHED;
            PG8_LDA(At, 0, 1); PG8_STAGE(PG8_SB(0, 0), b2, voffB); PG8_STAGE(PG8_SB(0, 1), b2 + hstep, voffB); PG8_STAGE(PG8_SA(0, 0), a2, voffA);
            PG8_WAIT_V(8); PG8_WAIT_L(0); PG8_BAR; PG8_MMA(1, 0, At, B0); PG8_MMA(1, 1, At, B1); PG8_BAR; PG8_SCHED;
            PG8_LDB(B0, 1, 0); PG8_LDB(B1, 1, 1); PG8_SCHED; PG8_LDA(At, 1, 0); PG8_STAGE(PG8_SA(0, 1), a2 + hstep, voffA);
            PG8_WAIT_V(8); PG8_WAIT_L(0); PG8_BAR; PG8_MMA(0, 0, At, B0); PG8_MMA(0, 1, At, B1); PG8_BAR; PG8_SCHED;
            PG8_LDA(At, 1, 1); PG8_STAGE(PG8_SB(1, 0), b3, voffB); PG8_STAGE(PG8_SB(1, 1), b3 + hstep, voffB); PG8_STAGE(PG8_SA(1, 0), a3, voffA);
            PG8_WAIT_V(8); PG8_WAIT_L(0); PG8_BAR; PG8_MMA(1, 0, At, B0); PG8_MMA(1, 1, At, B1); PG8_BAR; PG8_SCHED;
            } else {
            PG8_LDB(B0, 0, 0); PG8_SCHED; PG8_LDA(At, 0, 0); PG8_STAGE(PG8_SA(1, 1), a1 + hstep, voffA);
            PG8_WAIT_L(8); PG8_BAR; PG8_WAIT_L(0); PG8_MMA(0, 0, At, B0); PG8_BAR; PG8_SCHED;
            PG8_LDB(B1, 0, 1); PG8_STAGE(PG8_SB(0, 0), b2, voffB);
            PG8_BAR; PG8_WAIT_L(0); PG8_MMA(0, 1, At, B1); PG8_BAR;
            PG8_LDA(At, 0, 1); PG8_STAGE(PG8_SA(0, 0), a2, voffA);
            PG8_BAR; PG8_WAIT_L(0); PG8_MMA(1, 0, At, B0); PG8_BAR; PG8_SCHED;
            PG8_STAGE(PG8_SB(0, 1), b2 + hstep, voffB);
            PG8_WAIT_V(6); PG8_BAR; PG8_MMA(1, 1, At, B1); PG8_BAR;
            PG8_LDB(B0, 1, 0); PG8_SCHED; PG8_LDA(At, 1, 0); PG8_STAGE(PG8_SA(0, 1), a2 + hstep, voffA);
            PG8_WAIT_L(8); PG8_BAR; PG8_WAIT_L(0); PG8_MMA(0, 0, At, B0); PG8_BAR; PG8_SCHED;
            PG8_LDB(B1, 1, 1); PG8_STAGE(PG8_SB(1, 0), b3, voffB);
            PG8_BAR; PG8_WAIT_L(0); PG8_MMA(0, 1, At, B1); PG8_BAR;
            PG8_LDA(At, 1, 1); PG8_STAGE(PG8_SA(1, 0), a3, voffA);
            PG8_BAR; PG8_WAIT_L(0); PG8_MMA(1, 0, At, B0); PG8_BAR; PG8_SCHED;
            PG8_STAGE(PG8_SB(1, 1), b3 + hstep, voffB);
            PG8_WAIT_V(6); PG8_BAR; PG8_MMA(1, 1, At, B1); PG8_BAR;
            }
        }
        if constexpr (ALIGN_EPI) { if (wr == 0) PG8_BAR; }
        if constexpr (!Epi::AFTER_DRAIN) { E(acc, cur, wr, wc, fr, fq); S.done(cur); }
        if (!has_next) break;
#pragma unroll
        for (int a = 0; a < 2; ++a)
#pragma unroll
            for (int b = 0; b < 2; ++b)
#pragma unroll
                for (int m = 0; m < 4; ++m)
#pragma unroll
                    for (int n = 0; n < 2; ++n) acc[a][b][m][n] = (f32x4){0.f, 0.f, 0.f, 0.f};
        cur = nxt; cA = nA; cB = nB; ++ui;
        if constexpr (ALIGN_EPI) { if (wr == 1) PG8_BAR; }
    }
    PG8_WAIT_V(0);
    if constexpr (!ALIGN_EPI) { if (wr == 0) PG8_BAR; }
    PG8_BAR;
    if constexpr (Epi::AFTER_DRAIN) { E.fused(acc, cur, wr, wc, fr, fq, lds, wid, lane); S.done(cur); }
#undef PG8_SA
#undef PG8_SB
#undef PG8_STAGE
#undef PG8_LDA
#undef PG8_LDB
#undef PG8_MMA
#undef PG8_WAIT_V
#undef PG8_WAIT_L
#undef PG8_BAR
#undef PG8_SCHED
}
}
namespace pg8 {
__device__ __forceinline__ float bf_lo(unsigned u) { return __uint_as_float(u << 16); }
__device__ __forceinline__ float bf_hi(unsigned u) { return __uint_as_float(u & 0xffff0000u); }
__device__ __forceinline__ u32x4 pack8bf(const f32x4 v0, const f32x4 v1) { u32x4 w; w.x = cvt_pk_bf16(v0[0], v0[1]); w.y = cvt_pk_bf16(v0[2], v0[3]); w.z = cvt_pk_bf16(v1[0], v1[1]); w.w = cvt_pk_bf16(v1[2], v1[3]); return w; }
__device__ __forceinline__ float sigmoidf_(float x) { return __builtin_amdgcn_rcpf(1.0f + __builtin_amdgcn_exp2f(-1.4426950408889634f * x)); }

struct EpiProj {
    static constexpr bool PERM = true, AFTER_DRAIN = false;
    unsigned char* ws; const float* bgate;
    __device__ __forceinline__ void operator()(const f32x4 (&acc)[2][2][4][2], const Unit& u, int wr, int wc, int fr, int fq) const {
        const int pn = u.pn;
        size_t off; int ld, ct, mode, boff = 0;
        if (pn < 6)       { off = WS_QA; ld = 1536; ct = pn;      mode = 1; }
        else if (pn < 12) { off = WS_KA; ld = 1536; ct = pn - 6;  mode = 1; }
        else if (pn < 18) { off = WS_VA; ld = 1536; ct = pn - 12; mode = 0; }
        else if (pn < 26) { off = WS_QB; ld = 2048; ct = pn - 18; mode = 1; }
        else if (pn < 34) { off = WS_KB; ld = 2048; ct = pn - 26; mode = 1; }
        else if (pn < 42) { off = WS_VB; ld = 2048; ct = pn - 34; mode = 0; }
        else if (pn < 58) { off = WS_GA; ld = 4096; ct = pn - 42; mode = 2; boff = (pn - 42) * 256; }
        else              { off = WS_GB; ld = 4096; ct = pn - 58; mode = 2; boff = 4096 + (pn - 58) * 256; }
        bf16_t* dst = (bf16_t*)(ws + off);
        const int row0 = u.pm * BM + wr * 64 + fr, col0 = ct * 256 + wc * 32 + 8 * fq;
        if (mode == 2) {
            f32x4 bv[2][2];
#pragma unroll
            for (int bj = 0; bj < 2; ++bj)
#pragma unroll
                for (int n = 0; n < 2; ++n) bv[bj][n] = *(const f32x4*)(bgate + boff + wc * 32 + 8 * fq + bj * HALF + 4 * n);
#pragma unroll
            for (int ai = 0; ai < 2; ++ai)
#pragma unroll
                for (int m = 0; m < 4; ++m) { bf16_t* rowp = dst + (size_t)(row0 + ai * HALF + m * 16) * ld + col0;
#pragma unroll
                    for (int bj = 0; bj < 2; ++bj) { f32x4 v0 = acc[ai][bj][m][0] + bv[bj][0], v1 = acc[ai][bj][m][1] + bv[bj][1];
#pragma unroll
                        for (int i = 0; i < 4; ++i) { v0[i] = sigmoidf_(v0[i]); v1[i] = sigmoidf_(v1[i]); }
                        *(u32x4*)(rowp + bj * HALF) = pack8bf(v0, v1); } }
        } else if (mode == 1 && wc == 0) {
            const bool odd = (fq & 1) != 0, lo = fq < 2;
            float invf[2][4];
            invf[0][0] = odd ? 0.00141421356f : 1.0f;            invf[0][1] = odd ? 0.000622772437f : 0.440366596f;
            invf[0][2] = odd ? 0.000274248188f : 0.193922743f;   invf[0][3] = odd ? 0.000120769735f : 0.0853971019f;
            invf[1][0] = odd ? 5.31829573e-05f : 0.0376060307f;  invf[1][1] = odd ? 2.34199997e-05f : 0.0165604409f;
            invf[1][2] = odd ? 1.03133852e-05f : 0.00729266461f; invf[1][3] = odd ? 4.54167048e-06f : 0.00321144611f;
#pragma unroll
            for (int ai = 0; ai < 2; ++ai)
#pragma unroll
                for (int m = 0; m < 4; ++m) { const int row = row0 + ai * HALF + m * 16; const float pos = (float)row; bf16_t* rowp = dst + (size_t)row * ld + col0;
                    float cs[2][4], sn[2][4];
#pragma unroll
                    for (int n = 0; n < 2; ++n)
#pragma unroll
                        for (int i = 0; i < 4; ++i) { const float ang = pos * invf[n][i]; const float k = rintf(ang * 0.15915494309189535f);
                            float r = fmaf(-k, 6.2831855f, ang); r = fmaf(-k, -1.7484555e-07f, r); const float rev = r * 0.15915494309189535f;
                            cs[n][i] = __builtin_amdgcn_cosf(rev); sn[n][i] = lo ? -__builtin_amdgcn_sinf(rev) : __builtin_amdgcn_sinf(rev); }
#pragma unroll
                    for (int bj = 0; bj < 2; ++bj) { f32x4 v0 = acc[ai][bj][m][0], v1 = acc[ai][bj][m][1], o0, o1;
#pragma unroll
                        for (int i = 0; i < 4; ++i) { const float p0 = __shfl_xor(v0[i], 32), p1 = __shfl_xor(v1[i], 32);
                            o0[i] = v0[i] * cs[0][i] + p0 * sn[0][i]; o1[i] = v1[i] * cs[1][i] + p1 * sn[1][i]; }
                        *(u32x4*)(rowp + bj * HALF) = pack8bf(o0, o1); } }
        } else {
#pragma unroll
            for (int ai = 0; ai < 2; ++ai)
#pragma unroll
                for (int m = 0; m < 4; ++m) { bf16_t* rowp = dst + (size_t)(row0 + ai * HALF + m * 16) * ld + col0;
#pragma unroll
                    for (int bj = 0; bj < 2; ++bj) *(u32x4*)(rowp + bj * HALF) = pack8bf(acc[ai][bj][m][0], acc[ai][bj][m][1]); }
        }
    }
};
template <bool ADD> struct EpiGate {
    static constexpr bool PERM = true, AFTER_DRAIN = false;
    const bf16_t* G; const bf16_t* Tin; bf16_t* O;
    __device__ __forceinline__ void operator()(const f32x4 (&acc)[2][2][4][2], const Unit& u, int wr, int wc, int fr, int fq) const {
        const int row0 = u.pm * BM + wr * 64 + fr, col0 = u.pn * BM + wc * 32 + 8 * fq;
#pragma unroll
        for (int ai = 0; ai < 2; ++ai)
#pragma unroll
            for (int m = 0; m < 4; ++m) {
#pragma unroll
                for (int bj = 0; bj < 2; ++bj) { const size_t idx = (size_t)(row0 + ai * HALF + m * 16) * DM + col0 + bj * HALF;
                    const u32x4 gw = *(const u32x4*)(G + idx);
                    f32x4 v0 = acc[ai][bj][m][0], v1 = acc[ai][bj][m][1];
                    v0[0] *= bf_lo(gw.x); v0[1] *= bf_hi(gw.x); v0[2] *= bf_lo(gw.y); v0[3] *= bf_hi(gw.y);
                    v1[0] *= bf_lo(gw.z); v1[1] *= bf_hi(gw.z); v1[2] *= bf_lo(gw.w); v1[3] *= bf_hi(gw.w);
                    if (ADD) { const u32x4 tw = *(const u32x4*)(Tin + idx);
                        v0[0] += bf_lo(tw.x); v0[1] += bf_hi(tw.x); v0[2] += bf_lo(tw.y); v0[3] += bf_hi(tw.y);
                        v1[0] += bf_lo(tw.z); v1[1] += bf_hi(tw.z); v1[2] += bf_lo(tw.w); v1[3] += bf_hi(tw.w); }
                    *(u32x4*)(O + idx) = pack8bf(v0, v1); }
                if (m & 1) asm volatile("" ::: "memory"); }
    }
};
template <bool STATS> struct EpiResid {
    static constexpr bool PERM = false, AFTER_DRAIN = false;
    const float* base; float* out; bf16_t* xb; float* rss;
    __device__ __forceinline__ void operator()(const f32x4 (&acc)[2][2][4][2], const Unit& u, int wr, int wc, int fr, int fq) const {
        typedef unsigned u32x2v __attribute__((ext_vector_type(2)));
        const int col0 = u.pn * BM + wc * 32 + 4 * fq;
#pragma unroll
        for (int ai = 0; ai < 2; ++ai)
#pragma unroll
            for (int m = 0; m < 4; ++m) { const int row = u.pm * BM + ai * HALF + wr * 64 + m * 16 + fr; const size_t off = (size_t)row * DM + col0; float ss = 0.f;
#pragma unroll
                for (int bj = 0; bj < 2; ++bj)
#pragma unroll
                    for (int n = 0; n < 2; ++n) { const f32x4 o = *(const f32x4*)(base + off + bj * HALF + n * 16) + acc[ai][bj][m][n];
                        *(f32x4*)(out + off + bj * HALF + n * 16) = o;
                        if (STATS) { ss += (o[0] * o[0] + o[1] * o[1]) + (o[2] * o[2] + o[3] * o[3]);
                            u32x2v w; w.x = cvt_pk_bf16(o[0], o[1]); w.y = cvt_pk_bf16(o[2], o[3]); *(u32x2v*)(xb + off + bj * HALF + n * 16) = w; } }
                if (STATS) { ss += __shfl_xor(ss, 16); ss += __shfl_xor(ss, 32); if (fq == 0) rss[(size_t)row * 64 + u.pn * 4 + wc] = ss; }
                if (m & 1) asm volatile("" ::: "memory"); }
    }
};
struct EpiRelu2 {
    static constexpr bool PERM = true, AFTER_DRAIN = false;
    bf16_t* O; const float* rss;
    __device__ __forceinline__ void operator()(const f32x4 (&acc)[2][2][4][2], const Unit& u, int wr, int wc, int fr, int fq) const {
        const int row0 = u.pm * BM + wr * 64 + fr, col0 = u.pn * BM + wc * 32 + 8 * fq;
#pragma unroll
        for (int ai = 0; ai < 2; ++ai)
#pragma unroll
            for (int m = 0; m < 4; ++m) { const int row = row0 + ai * HALF + m * 16; const f32x4* rp = (const f32x4*)(rss + (size_t)row * 64 + fq * 16);
                const f32x4 a = rp[0], b = rp[1], c = rp[2], d = rp[3];
                float t = ((a[0] + a[1]) + (a[2] + a[3])) + ((b[0] + b[1]) + (b[2] + b[3])) + ((c[0] + c[1]) + (c[2] + c[3])) + ((d[0] + d[1]) + (d[2] + d[3]));
                t += __shfl_xor(t, 16); t += __shfl_xor(t, 32);
                const float rstd = rsqrtf(t * (1.0f / DM) + RMS_EPS);
                bf16_t* rowp = O + (size_t)row * DFF + col0;
#pragma unroll
                for (int bj = 0; bj < 2; ++bj) { f32x4 v0 = acc[ai][bj][m][0] * rstd, v1 = acc[ai][bj][m][1] * rstd;
#pragma unroll
                    for (int i = 0; i < 4; ++i) { v0[i] = fmaxf(v0[i], 0.f); v0[i] *= v0[i]; v1[i] = fmaxf(v1[i], 0.f); v1[i] *= v1[i]; }
                    *(u32x4*)(rowp + bj * HALF) = pack8bf(v0, v1); } }
    }
};
}
namespace swa {
typedef short bf16x8 __attribute__((ext_vector_type(8)));
typedef short s16x4 __attribute__((ext_vector_type(4)));
typedef float f32x16 __attribute__((ext_vector_type(16)));
typedef float f32x4 __attribute__((ext_vector_type(4)));
typedef unsigned u32x4 __attribute__((ext_vector_type(4)));
typedef unsigned short bf16;
constexpr int D = 128, NW = 8, QBLK = 32, KVBLK = 64, QB = NW * QBLK;
constexpr int SHM_V = KVBLK * D * 2, SHM_K = KVBLK * D * 2;
constexpr int LDS_BYTES = 2 * SHM_V + 2 * SHM_K + NW * 64 * 4;
constexpr float SCALE = 0.08838834764831845f, THR = 8.f;
#define KSWZ(row, colB) ((row) * 256 + ((colB) ^ (((row) & 7) << 4)))
#define SBAR() __builtin_amdgcn_sched_barrier(0)
__device__ __forceinline__ int v_st(int k, int c) { const int kk = (k & ~0xC) | ((k & 4) << 1) | ((k & 8) >> 1); return ((kk >> 3) * 4 + (c >> 5)) * 512 + ((kk & 7) * 32 + (c & 31)) * 2; }
__device__ __forceinline__ int v_rd_base(int lane) { return ((lane & 3) << 3) | (((lane >> 2) & 3) << 6) | (((lane >> 4) & 1) << 5) | (((lane >> 5) & 1) << 8); }
constexpr int v_rd_off(int d0, int ks, int half) { return d0 * 512 + ks * 4096 + half * 2048; }
__device__ __forceinline__ int crow(int r, int hi) { return (r & 3) + 8 * (r >> 2) + 4 * hi; }
typedef float f32x2_t __attribute__((ext_vector_type(2))); typedef __bf16 bf16x2_t __attribute__((ext_vector_type(2)));
__device__ __forceinline__ unsigned cvtpk(float lo, float hi) { const f32x2_t v = {lo, hi}; const bf16x2_t b = __builtin_convertvector(v, bf16x2_t); return __builtin_bit_cast(unsigned, b); }
__device__ __forceinline__ bf16x8 load8(const bf16* p) { return *reinterpret_cast<const bf16x8*>(p); }
__device__ __forceinline__ void mask_tile(f32x16& p0, f32x16& p1, int dq, unsigned W) {
    const float NEG = -__builtin_inff();
#pragma unroll
    for (int r = 0; r < 16; ++r) {
        const int c = (r & 3) + 8 * (r >> 2);
        if ((unsigned)(dq - c) >= W) p0[r] = NEG;
        if ((unsigned)(dq - c - 32) >= W) p1[r] = NEG;
    }
}
__device__ __forceinline__ void partialSM(f32x16& p0, f32x16& p1, float& m_reg, float& mn, float& alpha) {
    float pmax = p0[0]; for (int r = 1; r < 16; ++r) pmax = fmaxf(pmax, p0[r]); for (int r = 0; r < 16; ++r) pmax = fmaxf(pmax, p1[r]);
    { auto rr = __builtin_amdgcn_permlane32_swap(__float_as_uint(pmax), __float_as_uint(pmax), false, false);
      pmax = fmaxf(__uint_as_float(rr[0]), __uint_as_float(rr[1])); }
    constexpr float C2 = 1.4426950408889634f * SCALE;
    if (__builtin_expect(__all((pmax - m_reg) * SCALE <= THR), 1)) { mn = m_reg; alpha = 1.f; }
    else { mn = fmaxf(m_reg, pmax); alpha = __builtin_amdgcn_exp2f((m_reg - mn) * C2); m_reg = mn; }
    const float mnL = -mn * C2;
    for (int r = 0; r < 16; ++r) p0[r] = fmaf(p0[r], C2, mnL); for (int r = 0; r < 16; ++r) p1[r] = fmaf(p1[r], C2, mnL);
    for (int r = 0; r < 16; ++r) p0[r] = __builtin_amdgcn_exp2f(p0[r]);
}
__device__ __forceinline__ void finishSM(f32x16& p0, f32x16& p1, float alpha, float& l_reg, bf16x8& pa0, bf16x8& pa1, bf16x8& pa2, bf16x8& pa3) {
    for (int r = 0; r < 16; ++r) p1[r] = __builtin_amdgcn_exp2f(p1[r]);
    float ps = 0; for (int r = 0; r < 16; ++r) ps += p0[r]; for (int r = 0; r < 16; ++r) ps += p1[r];
    { auto rr = __builtin_amdgcn_permlane32_swap(__float_as_uint(ps), __float_as_uint(ps), false, false);
      ps = __uint_as_float(rr[0]) + __uint_as_float(rr[1]); }
    l_reg = l_reg * alpha + ps;
#define PK4(P, B_, OUT) do { unsigned a0 = cvtpk(P[B_+0], P[B_+1]), a1 = cvtpk(P[B_+2], P[B_+3]);                          \
        unsigned b0 = cvtpk(P[B_+4], P[B_+5]), b1 = cvtpk(P[B_+6], P[B_+7]);                                             \
        auto r0 = __builtin_amdgcn_permlane32_swap(a0, b0, false, false); auto r1 = __builtin_amdgcn_permlane32_swap(a1, b1, false, false); \
        u32x4 w = {r0[0], r1[0], r0[1], r1[1]}; OUT = *reinterpret_cast<bf16x8*>(&w); } while (0)
    PK4(p0, 0, pa0); PK4(p0, 8, pa1); PK4(p1, 0, pa2); PK4(p1, 8, pa3);
#undef PK4
}
template <int KB>
__device__ __forceinline__ void qkt(f32x16& p0, f32x16& p1, const char* K_lds, int r32, int hi, const bf16x8* qr) {
    p0 = f32x16{}; p1 = f32x16{};
    const char* kb[4];
#pragma unroll
    for (int dd = 0; dd < 4; ++dd) kb[dd] = K_lds + KB * SHM_K + KSWZ(r32, (dd * 16 + hi * 8) * 2);
#pragma unroll
    for (int d0 = 0; d0 < 8; ++d0) { const char* a = kb[d0 & 3] + (d0 >> 2) * 128;
        bf16x8 b0 = *reinterpret_cast<const bf16x8*>(a);
        bf16x8 b1 = *reinterpret_cast<const bf16x8*>(a + 32 * 256);
        p0 = __builtin_amdgcn_mfma_f32_32x32x16_bf16(b0, qr[d0], p0, 0, 0, 0);
        p1 = __builtin_amdgcn_mfma_f32_32x32x16_bf16(b1, qr[d0], p1, 0, 0, 0); }
}
template <int VB>
__device__ __forceinline__ void pv_tile(f32x16* o, int vb0, bf16x8 pa0, bf16x8 pa1, bf16x8 pa2, bf16x8 pa3) {
#define TRRD(dst, off) asm volatile("ds_read_b64_tr_b16 %0, %1 offset:%2" : "=&v"(dst) : "v"(vb0), "i"(off) : "memory")
#define PV_D0(d0) do { s16x4 l0, l1, l2, l3, h0, h1, h2, h3; constexpr int b_ = VB * SHM_V + v_rd_off(d0, 0, 0);     \
        TRRD(l0, b_); TRRD(h0, b_ + 2048); TRRD(l1, b_ + 4096); TRRD(h1, b_ + 6144); TRRD(l2, b_ + 8192); TRRD(h2, b_ + 10240); TRRD(l3, b_ + 12288); TRRD(h3, b_ + 14336); \
        asm volatile("s_waitcnt lgkmcnt(0)" ::: "memory"); SBAR();                                                             \
        o[d0] = __builtin_amdgcn_mfma_f32_32x32x16_bf16(pa0, (bf16x8){l0[0], l0[1], l0[2], l0[3], h0[0], h0[1], h0[2], h0[3]}, o[d0], 0, 0, 0);   \
        o[d0] = __builtin_amdgcn_mfma_f32_32x32x16_bf16(pa1, (bf16x8){l1[0], l1[1], l1[2], l1[3], h1[0], h1[1], h1[2], h1[3]}, o[d0], 0, 0, 0);   \
        o[d0] = __builtin_amdgcn_mfma_f32_32x32x16_bf16(pa2, (bf16x8){l2[0], l2[1], l2[2], l2[3], h2[0], h2[1], h2[2], h2[3]}, o[d0], 0, 0, 0);   \
        o[d0] = __builtin_amdgcn_mfma_f32_32x32x16_bf16(pa3, (bf16x8){l3[0], l3[1], l3[2], l3[3], h3[0], h3[1], h3[2], h3[3]}, o[d0], 0, 0, 0); } while (0)
    PV_D0(0); PV_D0(1); PV_D0(2); PV_D0(3);
#undef PV_D0
#undef TRRD
}
struct BlockRef { const bf16* Q; const bf16* K; const bf16* V; float* O; float* L; int P0, qp, kp, op, lp, skv, W; };
struct Seam { bf16x8 qr[8]; bf16x8 st_v0, st_v1, st_k0, st_k1; };
__device__ __forceinline__ int swa_jlo(int P0, int W) { const int lowk = P0 - W + 1; return lowk > 0 ? lowk / KVBLK : 0; }
#define ROW(p, k0, rr, pitch) ((p) + (size_t)((k0) + (rr)) * (pitch) + sc)
#define VMW() asm volatile("s_waitcnt vmcnt(0)" ::: "memory")
#define VMWN(n) asm volatile("s_waitcnt vmcnt(%0)" :: "i"(n) : "memory")
#define SLOAD_H(Kp, Vp, k0, pitch) do { S.st_v0 = load8(ROW(Vp, k0, sr, pitch)); S.st_v1 = load8(ROW(Vp, k0, 32 + sr, pitch));              \
                         S.st_k0 = load8(ROW(Kp, k0, sr, pitch)); S.st_k1 = load8(ROW(Kp, k0, 32 + sr, pitch)); } while (0)
#define SWRITE_HK(bf) do { *(bf16x8*)(K_lds + (bf) * SHM_K + kws) = S.st_k0; *(bf16x8*)(K_lds + (bf) * SHM_K + kws + 32 * 256) = S.st_k1; } while (0)
#define SWRITE_HV(bf) do { *(bf16x8*)(V_lds + (bf) * SHM_V + vst0) = S.st_v0; *(bf16x8*)(V_lds + (bf) * SHM_V + vst1) = S.st_v1; } while (0)
#define SWRITE_H(bf) do { SWRITE_HV(bf); SWRITE_HK(bf); } while (0)
__device__ __forceinline__ void causal_swa_prime(const BlockRef& cur, char* lds, Seam& S) {
    const int tid = threadIdx.x, wid = __builtin_amdgcn_readfirstlane(tid >> 6), lane = tid & 63, r32 = lane & 31, hi = lane >> 5;
    const int sr = tid >> 4, sc = (tid & 15) * 8, kws = KSWZ(sr, sc * 2); char* K_lds = lds + 2 * SHM_V;
    const int kb0 = swa_jlo(cur.P0, cur.W) * KVBLK;
#pragma unroll
    for (int d0 = 0; d0 < 8; ++d0) S.qr[d0] = load8(cur.Q + (size_t)(wid * QBLK + r32) * cur.qp + d0 * 16 + hi * 8);
    SLOAD_H(cur.K, cur.V, kb0, cur.kp); VMW(); SWRITE_HK(0);
    __syncthreads();
}
__device__ __forceinline__ void causal_swa_block(const BlockRef& cur, const BlockRef& nxt, char* lds, Seam& S) {
    const int tid = threadIdx.x, wid = __builtin_amdgcn_readfirstlane(tid >> 6), lane = tid & 63, r32 = lane & 31, hi = lane >> 5;
    const int W = cur.W, kp = cur.kp;
    const int j_lo = swa_jlo(cur.P0, W);
    int j_hi = (cur.P0 + QB - 1) / KVBLK + 1; if (j_hi > cur.skv / KVBLK) j_hi = cur.skv / KVBLK;
    const int NT = j_hi - j_lo;
    const int kbn = swa_jlo(nxt.P0, nxt.W) * KVBLK;
    const int qlo = cur.P0 + wid * QBLK, qm = qlo + r32 - 4 * hi;
    char* V_lds = lds; char* K_lds = lds + 2 * SHM_V;
    float* ws = (float*)(lds + 2 * SHM_V + 2 * SHM_K) + wid * 64; float* li_l = ws, * al_l = ws + 32;
    float m_reg = -1e30f, l_reg = 0; f32x16 o[4] = {};
    const int sr = tid >> 4, sc = (tid & 15) * 8, vst0 = v_st(sr, sc), vst1 = v_st(32 + sr, sc), kws = KSWZ(sr, sc * 2);
    const int vb0 = (int)(uintptr_t)V_lds + v_rd_base(lane);
    const bf16* Kh = cur.K; const bf16* Vh = cur.V;
#define RESC(a) do { if (__any((a) < 1.f)) { if (hi == 0) al_l[r32] = (a); asm volatile("s_waitcnt lgkmcnt(0)" ::: "memory");              \
                     for (int d_ = 0; d_ < 4; ++d_) for (int r = 0; r < 16; ++r) o[d_][r] *= al_l[crow(r, hi)]; } } while (0)
#define KBASE(t) ((j_lo + (t)) * KVBLK)
#define MASKT(P0_, P1_, t) do { const int kb_ = KBASE(t); if (kb_ + KVBLK - 1 > qlo || kb_ <= qlo + QBLK - 1 - W) mask_tile(P0_, P1_, qm - kb_, (unsigned)W); } while (0)
    constexpr int NQL = 8;
#define SEAM_K0() do { VMWN(NQL); SWRITE_HK(0); SBAR(); } while (0)
    f32x16 pA0, pA1, pB0, pB1; float mnA, mnB, alA, alB; bf16x8 pa0, pa1, pa2, pa3;
    SWRITE_HV(0); SBAR();
    if (NT > 1) SLOAD_H(Kh, Vh, KBASE(1), kp);
    SBAR(); qkt<0>(pA0, pA1, K_lds, r32, hi, S.qr);
    MASKT(pA0, pA1, 0); partialSM(pA0, pA1, m_reg, mnA, alA);
    if (NT > 1) { VMW(); SWRITE_H(1); }
    __syncthreads();
#define HALF_STEP(PX0, PX1, mnX, alX, PY0, PY1, alY, t, KB, VB, SB) do {                                                      \
        SBAR(); qkt<KB>(PX0, PX1, K_lds, r32, hi, S.qr);                                                                      \
        finishSM(PY0, PY1, alY, l_reg, pa0, pa1, pa2, pa3); SBAR();                                                           \
        if ((t) + 1 < NT) { SLOAD_H(Kh, Vh, KBASE((t) + 1), kp); SBAR(); }                                                    \
        pv_tile<VB>(o, vb0, pa0, pa1, pa2, pa3); MASKT(PX0, PX1, (t)); partialSM(PX0, PX1, m_reg, mnX, alX);                  \
        __syncthreads();                                                                                                      \
        if ((t) + 1 < NT) { VMW(); SWRITE_H(SB); }                                                                            \
        RESC(alX); __syncthreads(); } while (0)
    for (int t = 1; t + 1 < NT; t += 2) {
        HALF_STEP(pB0, pB1, mnB, alB, pA0, pA1, alA, t, 1, 0, 0);
        HALF_STEP(pA0, pA1, mnA, alA, pB0, pB1, alB, t + 1, 0, 1, 1);
    }
    const bool even = (NT & 1) == 0;
    if (even) { SBAR(); qkt<1>(pB0, pB1, K_lds, r32, hi, S.qr); SBAR(); }
    SLOAD_H(nxt.K, nxt.V, kbn, nxt.kp); SBAR();
#pragma unroll
    for (int d0 = 0; d0 < 8; ++d0) S.qr[d0] = load8(nxt.Q + (size_t)(wid * QBLK + r32) * nxt.qp + d0 * 16 + hi * 8);
    SBAR();
    finishSM(pA0, pA1, alA, l_reg, pa0, pa1, pa2, pa3); SBAR();
    pv_tile<0>(o, vb0, pa0, pa1, pa2, pa3);
    if (even) { MASKT(pB0, pB1, NT - 1); partialSM(pB0, pB1, m_reg, mnB, alB); __syncthreads(); RESC(alB);
        finishSM(pB0, pB1, alB, l_reg, pa0, pa1, pa2, pa3); SBAR(); pv_tile<1>(o, vb0, pa0, pa1, pa2, pa3); }
    SBAR(); SEAM_K0();
    if (hi == 0) li_l[r32] = l_reg; asm volatile("s_waitcnt lgkmcnt(0)" ::: "memory");
    float rli[16];
#pragma unroll
    for (int r = 0; r < 16; ++r) rli[r] = __builtin_amdgcn_rcpf(li_l[crow(r, hi)]);
    float* Ow = cur.O + (size_t)(wid * QBLK) * cur.op;
#pragma unroll
    for (int r = 0; r < 16; ++r) { const int orow = crow(r, hi);
#pragma unroll
        for (int d0 = 0; d0 < 4; ++d0) Ow[(size_t)orow * cur.op + d0 * 32 + r32] = o[d0][r] * rli[r]; }
    if (cur.L != nullptr && hi == 0) cur.L[(size_t)(wid * QBLK + r32) * cur.lp] = m_reg * SCALE + __logf(l_reg);
    __syncthreads();
#undef RESC
#undef KBASE
#undef MASKT
#undef SEAM_K0
#undef HALF_STEP
}
#undef ROW
#undef VMW
#undef VMWN
#undef SLOAD_H
#undef SWRITE_HK
#undef SWRITE_HV
#undef SWRITE_H
#undef KSWZ
#undef SBAR
}
#define GAS __attribute__((address_space(1)))
#define LAS __attribute__((address_space(3)))
typedef unsigned short bf16;
typedef unsigned v4u __attribute__((ext_vector_type(4)));
typedef unsigned v2u __attribute__((ext_vector_type(2)));
typedef float f32x4 __attribute__((ext_vector_type(4)));
typedef GAS unsigned gu32;
#define RLX_AGENT __ATOMIC_RELAXED, __HIP_MEMORY_SCOPE_AGENT
#define LDS_WAIT() asm volatile("s_waitcnt lgkmcnt(0)" ::: "memory")
#define VM_WAIT() asm volatile("s_waitcnt vmcnt(0)" ::: "memory")
__device__ __forceinline__ unsigned f2bf(float f) { unsigned u = __builtin_bit_cast(unsigned, f); return (u + 0x7fffu + ((u >> 16) & 1u)) >> 16; }
__device__ __forceinline__ unsigned pk2(float lo, float hi) { return f2bf(lo) | (f2bf(hi) << 16); }
__device__ __forceinline__ float bflo(unsigned u) { return __uint_as_float(u << 16); }
__device__ __forceinline__ float bfhi(unsigned u) { return __uint_as_float(u & 0xffff0000u); }
__device__ __forceinline__ float wave_sum(float v) {
#pragma unroll
    for (int o = 1; o < 64; o <<= 1) v += __shfl_xor(v, o);
    return v;
}
__device__ __forceinline__ float wave_max(float v) {
#pragma unroll
    for (int o = 1; o < 64; o <<= 1) v = fmaxf(v, __shfl_xor(v, o));
    return v;
}
#define XB_TMO      128
#define XB_XCNT(j)  (256  + 64 * (j))
#define XB_XSUB(j)  (1280 + 64 * (j))
#define XB_XGEN(j)  (2304 + 64 * (j))
#define XB_TOP      3328
#define XB_TOPGEN   3392
#define XCD_BAR_WORDS 3456
#define XB_SPIN_CAP (1u << 23)

__device__ __forceinline__ unsigned xb_ld(unsigned* p)              { return __hip_atomic_load(p, __ATOMIC_RELAXED, __HIP_MEMORY_SCOPE_AGENT); }
__device__ __forceinline__ unsigned xb_add(unsigned* p, unsigned v) { return __hip_atomic_fetch_add(p, v, __ATOMIC_RELAXED, __HIP_MEMORY_SCOPE_AGENT); }
__device__ __forceinline__ unsigned xb_xcc_id() { return (unsigned)__builtin_amdgcn_s_getreg((3 << 11) | 20) & 0xFu; }
#define XB_SPIN(cond, bar) do { unsigned _sp = 0; while (cond) { __builtin_amdgcn_s_sleep(1); \
    if ((++_sp & 255u) == 0u) { if (xb_ld(&(bar)[XB_TMO])) break; if (_sp > XB_SPIN_CAP) { atomicAdd(&(bar)[XB_TMO], 1u); break; } } } } while (0)

struct XcdBarrier {
    unsigned* bar; unsigned x;
    volatile LAS unsigned* st;
};

__device__ __forceinline__ XcdBarrier xcd_barrier_post(unsigned* bar, volatile LAS unsigned* st) {
    XcdBarrier b; b.bar = bar; b.x = xb_xcc_id(); b.st = st;
    if (threadIdx.x == 0) (void)xb_add(&bar[XB_XCNT(b.x)], 1u);
    return b;
}
__device__ __forceinline__ void xcd_barrier_complete(unsigned* bar, unsigned x, unsigned& nloc, unsigned& nx) {
    const unsigned G = gridDim.x * gridDim.y * gridDim.z;
    unsigned sum, cnt, mine, sp = 0u;
    for (;;) {
        sum = 0u; cnt = 0u; mine = 0u;
#pragma unroll
        for (unsigned j = 0; j < 16; ++j) { const unsigned c = xb_ld(&bar[XB_XCNT(j)]); sum += c; cnt += (c > 0u) ? 1u : 0u; mine = (j == x) ? c : mine; }
        if (sum == G) break;
        __builtin_amdgcn_s_sleep(1);
        if ((++sp & 255u) == 0u) { if (xb_ld(&bar[XB_TMO])) break; if (sp > XB_SPIN_CAP) { atomicAdd(&bar[XB_TMO], 1u); break; } }
    }
    nloc = mine > 0u ? mine : 1u; nx = cnt > 0u ? cnt : 1u;
}

__device__ __forceinline__ void xcd_barrier(const XcdBarrier& b) {
    asm volatile("s_waitcnt vmcnt(0)" ::: "memory");
    __syncthreads();
    if (threadIdx.x == 0) {
        unsigned* bar = b.bar;
        __builtin_amdgcn_s_waitcnt(0);
        unsigned nloc = b.st[0], nx = b.st[1];
        if (nloc == 0u) { xcd_barrier_complete(bar, b.x, nloc, nx); b.st[0] = nloc; b.st[1] = nx; }
        const unsigned old = xb_add(&bar[XB_XSUB(b.x)], 1u);
        const unsigned gen = old / nloc;
        if (old + 1u == (gen + 1u) * nloc) {
            __builtin_amdgcn_fence(__ATOMIC_RELEASE, "agent");
            asm volatile("s_waitcnt vmcnt(0)" ::: "memory");
            const unsigned og = xb_add(&bar[XB_TOP], 1u);
            const unsigned tg = og / nx;
            if (og + 1u == (tg + 1u) * nx) xb_add(&bar[XB_TOPGEN], 1u);
            else XB_SPIN(xb_ld(&bar[XB_TOPGEN]) == tg, bar);
            __builtin_amdgcn_fence(__ATOMIC_ACQUIRE, "agent");
            xb_add(&bar[XB_XGEN(b.x)], 1u);
            asm volatile("s_waitcnt vmcnt(0)" ::: "memory");
        } else {
            XB_SPIN(xb_ld(&bar[XB_XGEN(b.x)]) == gen, bar);
            __builtin_amdgcn_fence(__ATOMIC_ACQUIRE, "agent");
            asm volatile("s_waitcnt vmcnt(0)" ::: "memory");
        }
    }
    __syncthreads();
}
struct Args { const float* in[16]; float* out; unsigned char* ws; int ph_lo, ph_hi; };

#ifdef SELFTEST
constexpr int CW_FLAG = 64, CW_FLAG2 = 128;
__device__ __forceinline__ void st_flag2(gu32* ctl, unsigned bits) { atomicOr((unsigned*)ctl + CW_FLAG2, bits); }
__device__ __forceinline__ void st_flag(gu32* ctl, int code) { atomicOr((unsigned*)ctl + CW_FLAG, 1u << code); }
__device__ __forceinline__ bool st_close(float got, float want, float rel, float ab) { return fabsf(got - want) <= rel * fabsf(want) + ab; }
__device__ __forceinline__ void scan_poison(const void* p, size_t nbytes, int code, gu32* ctl, size_t gtid, size_t nthreads) {
    const v4u* q = (const v4u*)p; bool bad = false;
    for (size_t i = gtid; i < nbytes / 16; i += nthreads) { const v4u w = q[i]; bad |= (w.x == 0xAAAAAAAAu) | (w.y == 0xAAAAAAAAu) | (w.z == 0xAAAAAAAAu) | (w.w == 0xAAAAAAAAu); }
    if (bad) st_flag(ctl, code);
}
__device__ __forceinline__ float dot_bf16(const bf16* a, const bf16* b, int K, int lane) {
    float s = 0.f;
    for (int k = lane * 8; k < K; k += 512) { const v4u x = *(const v4u*)(a + k), y = *(const v4u*)(b + k);
        s += bflo(x.x) * bflo(y.x) + bfhi(x.x) * bfhi(y.x) + bflo(x.y) * bflo(y.y) + bfhi(x.y) * bfhi(y.y) + bflo(x.z) * bflo(y.z) + bfhi(x.z) * bfhi(y.z) + bflo(x.w) * bflo(y.w) + bfhi(x.w) * bfhi(y.w); }
    return wave_sum(s);
}
__device__ __forceinline__ unsigned hash_u(unsigned x) { x ^= x >> 16; x *= 0x7feb352dU; x ^= x >> 15; x *= 0x846ca68bU; x ^= x >> 16; return x; }
__device__ __forceinline__ float ldbf(const bf16* p) { return __uint_as_float((unsigned)(*p) << 16); }
__device__ __forceinline__ void sincos_d(double x, double& s, double& c) {
    const double TWO_PI = 6.283185307179586; const double k = rint(x / TWO_PI); const double r = x - k * TWO_PI, r2 = r * r;
    double ts = 1.0, tc = 1.0;
    for (int i = 14; i >= 1; --i) { ts = 1.0 - r2 / (double)((2 * i) * (2 * i + 1)) * ts; tc = 1.0 - r2 / (double)((2 * i - 1) * (2 * i)) * tc; }
    s = r * ts; c = tc;
}

template <int NC> __device__ __forceinline__ void brute_row(const bf16* q, const bf16* Kb, const bf16* Vb, size_t kstride, int nkeys, float (&o)[NC], float& lse, int lane) {
    const unsigned qw = *(const unsigned*)(q + 2 * lane); const float q0 = bflo(qw), q1 = bfhi(qw);
    float mx = -1e30f;
    for (int j = 0; j < nkeys; ++j) { const unsigned kw = *(const unsigned*)(Kb + (size_t)j * kstride + 2 * lane); const float sc = wave_sum(q0 * bflo(kw) + q1 * bfhi(kw)) * ATT_SCALE; mx = fmaxf(mx, sc); }
    float l = 0.f;
#pragma unroll
    for (int c = 0; c < NC; ++c) o[c] = 0.f;
    for (int j = 0; j < nkeys; ++j) { const unsigned kw = *(const unsigned*)(Kb + (size_t)j * kstride + 2 * lane); const float sc = wave_sum(q0 * bflo(kw) + q1 * bfhi(kw)) * ATT_SCALE;
        const float p = expf(sc - mx); l += p;
#pragma unroll
        for (int c = 0; c < NC; ++c) o[c] += p * ldbf(Vb + (size_t)j * kstride + lane * NC + c); }
#pragma unroll
    for (int c = 0; c < NC; ++c) o[c] /= l;
    lse = mx + logf(l);
}
__device__ __forceinline__ void selftest(int k, const Args& a, int gw, int NGW, int lane) {
    unsigned char* ws = a.ws; gu32* ctl = (gu32*)(ws + WS_CTL);
    const size_t gtid = (size_t)gw * 64 + lane, nth = (size_t)NGW * 64;
    const bf16* H = (const bf16*)(ws + WS_H);
    if (k == 0) {
        scan_poison(ws + WS_WIN, WS_H + 64 * MiB - WS_WIN, 1, ctl, gtid, nth);
        for (unsigned s = (unsigned)gtid; s < 1u << 20; s += (unsigned)nth) {
            const unsigned h1 = hash_u(s * 2u + 1u), h2 = hash_u(s * 2u + 2u); const int mat = s % 6;
            const float* W; const bf16* WT; int K, N; const float* sc = nullptr;
            if (mat == 0) { W = a.in[2]; WT = (const bf16*)(ws + WS_WIN); K = DM; N = NIN; }
            else if (mat == 1) { W = a.in[4]; WT = (const bf16*)(ws + WS_WA); K = 512; N = DM; }
            else if (mat == 2) { W = a.in[5]; WT = (const bf16*)(ws + WS_WB); K = 2048; N = DM; }
            else if (mat == 3) { W = a.in[6]; WT = (const bf16*)(ws + WS_WOUT); K = DM; N = DM; }
            else if (mat == 4) { W = a.in[13]; WT = (const bf16*)(ws + WS_WFF1); K = DM; N = DFF; sc = a.in[12]; }
            else { W = a.in[14]; WT = (const bf16*)(ws + WS_WFF2); K = DFF; N = DM; }
            const int kk = h1 % K, n = h2 % N; float w = W[(size_t)kk * N + n]; if (sc) w *= sc[kk];
            if (WT[(size_t)n * K + kk] != (bf16)f2bf(w)) st_flag(ctl, 1);
        }
        for (int s = gw; s < 256; s += NGW) {
            const int row = hash_u(s + 777u) % SEQ; const float* xr = a.in[0] + (size_t)row * DM; float ss = 0.f;
            for (int c = lane; c < DM; c += 64) ss += xr[c] * xr[c];
            const float rstd = rsqrtf(wave_sum(ss) * (1.f / DM) + RMS_EPS); bool bad = false;
            for (int c = lane; c < DM; c += 64) bad |= !st_close(ldbf(H + (size_t)row * DM + c), xr[c] * rstd * a.in[1][c], 0.01f, 1e-3f);
            if (bad) st_flag(ctl, 1);
        }
    } else if (k == 1) {
        { const v4u* q = (const v4u*)(ws + WS_QA); bool bad = false;
          for (size_t i = gtid; i < 296 * MiB / 16; i += nth) { const v4u w = q[i]; bad |= (w.x == 0xAAAAAAAAu) | (w.y == 0xAAAAAAAAu) | (w.z == 0xAAAAAAAAu) | (w.w == 0xAAAAAAAAu); }
          if (bad) { st_flag(ctl, 2); st_flag2(ctl, 1u); } }
        for (int s = gw; s < 16384; s += NGW) {
            const int row = (s < 64) ? (s * 131) % SEQ : hash_u(s * 2u + 1u) % SEQ, col = hash_u(s * 2u + 2u) % NIN;
            const float acc = dot_bf16(H + (size_t)row * DM, (const bf16*)(ws + WS_WIN) + (size_t)col * DM, DM, lane);
            size_t off; int ld, c0, mode;
            if (col < 1536) { off = WS_QA; ld = 1536; c0 = col; mode = 1; }
            else if (col < 3072) { off = WS_KA; ld = 1536; c0 = col - 1536; mode = 1; }
            else if (col < 4608) { off = WS_VA; ld = 1536; c0 = col - 3072; mode = 0; }
            else if (col < 6656) { off = WS_QB; ld = 2048; c0 = col - 4608; mode = 1; }
            else if (col < 8704) { off = WS_KB; ld = 2048; c0 = col - 6656; mode = 1; }
            else if (col < 10752) { off = WS_VB; ld = 2048; c0 = col - 8704; mode = 0; }
            else if (col < 14848) { off = WS_GA; ld = 4096; c0 = col - 10752; mode = 2; }
            else { off = WS_GB; ld = 4096; c0 = col - 14848; mode = 2; }
            const float got = ldbf((const bf16*)(ws + off) + (size_t)row * ld + c0);
            float want = acc; int code = 2;
            if (mode == 2) want = 1.f / (1.f + expf(-(acc + a.in[3][col - 10752])));
            else if (mode == 1 && (c0 & 127) < 32) { code = 3; const int d = c0 & 127, j = d & 15;
                const float acc2 = dot_bf16(H + (size_t)row * DM, (const bf16*)(ws + WS_WIN) + (size_t)(col ^ 16) * DM, DM, lane);
                const float inv = (float)exp2(-(double)j * (18.931568569324174 / 16.0)); const float ang = (float)row * inv;
                double sn, cs; sincos_d((double)ang, sn, cs);
                want = (d < 16) ? acc * (float)cs - acc2 * (float)sn : acc * (float)cs + acc2 * (float)sn; }
            if (mode == 2 && lane == 0) atomicAdd((unsigned*)ctl + CW_FLAG2 + 2, 1u);
            if (!st_close(got, want, 0.02f, 0.03f)) { st_flag(ctl, code);
                if (mode == 2) { const int pn = col / 256; st_flag2(ctl, (pn < 58 ? 1u : 0u) | ((pn >= 58 && pn != 73) ? 2u : 0u) | (pn == 73 ? 4u : 0u) | (((row & 255) < 128) ? 8u : 16u)); if (lane == 0) atomicAdd((unsigned*)ctl + CW_FLAG2 + 1, 1u); } }
        }
    } else if (k == 2) {
        scan_poison(ws + WS_OA, 176 * MiB, 4, ctl, gtid, nth); scan_poison(ws + WS_LSE, 3 * SEQ * 4 * 4, 4, ctl, gtid, nth);
        const float* OA = (const float*)(ws + WS_OA); const float* OB = (const float*)(ws + WS_OB); const float* LSE = (const float*)(ws + WS_LSE);
        for (int s = gw; s < 1024; s += NGW) {
            const int t = (s < 200) ? s * 3 : hash_u(s * 2u + 1u) % SEQ, ah = hash_u(s * 2u + 2u) % 12, g = ah >> 2, r = (g == 0) ? 1 : (g == 1) ? 4 : 16;
            const int i = t / r, rho = t % r, i0 = (i > 128) ? i - 128 : 0;
            const bf16* KA = (const bf16*)(ws + WS_KA) + (size_t)(rho + r * i0) * 1536 + ah * 128; const bf16* VA = (const bf16*)(ws + WS_VA) + (size_t)(rho + r * i0) * 1536 + ah * 128;
            float o[2]; float lse; brute_row<2>((const bf16*)(ws + WS_QA) + (size_t)t * 1536 + ah * 128, KA, VA, (size_t)r * 1536, i - i0 + 1, o, lse, lane);
            const float* got = OA + ((size_t)g * SEQ + t) * 512 + (ah & 3) * 128 + lane * 2;
            if (!st_close(got[0], o[0], 2e-3f, 2e-3f) || !st_close(got[1], o[1], 2e-3f, 2e-3f) || !st_close(LSE[((size_t)g * SEQ + t) * 4 + (ah & 3)], lse, 1e-3f, 2e-3f)) st_flag(ctl, 10);
        }
        for (int s = gw; s < 512; s += NGW) {
            const int t = (s < 100) ? s * 2 : hash_u(s * 2u + 1u) % SEQ, hi = hash_u(s * 2u + 2u) % 16;
            float o[4]; float lse; brute_row<4>((const bf16*)(ws + WS_QB) + (size_t)t * 2048 + hi * 128, (const bf16*)(ws + WS_KB) + hi * 128, (const bf16*)(ws + WS_VB) + (hi >> 1) * 256, (size_t)2048, t + 1, o, lse, lane);
            const float* got = OB + (size_t)t * 4096 + hi * 256 + lane * 4; bool bad = false;
#pragma unroll
            for (int c = 0; c < 4; ++c) bad |= !st_close(got[c], o[c], 2e-3f, 2e-3f);
            if (bad) st_flag(ctl, 11);
        }
    } else if (k == 3) {
        scan_poison(ws + WS_YA, 40 * MiB, 5, ctl, gtid, nth);
        const float* OA = (const float*)(ws + WS_OA); const float* OB = (const float*)(ws + WS_OB); const float* LSE = (const float*)(ws + WS_LSE);
        float d1 = 0.f, d2 = 0.f; for (int e = 0; e < 128; ++e) { d1 += a.in[7][e] * a.in[8][e]; d2 += a.in[9][e] * a.in[10][e]; }
        const float lam = expf(d1) - expf(d2) + 0.2f;
        for (int s = gw; s < 256; s += NGW) { const int t = hash_u(s + 99u) % SEQ; bool bad = false;
            for (int c = lane; c < 512; c += 64) { const int hg = c >> 7; float l[3], mx = -1e30f; for (int g = 0; g < 3; ++g) { l[g] = LSE[((size_t)g * SEQ + t) * 4 + hg]; mx = fmaxf(mx, l[g]); }
                float den = 0.f, num = 0.f; for (int g = 0; g < 3; ++g) { const float e = expf(l[g] - mx); den += e; num += e * OA[((size_t)g * SEQ + t) * 512 + c]; }
                bad |= !st_close(ldbf((const bf16*)(ws + WS_YA) + (size_t)t * 512 + c), num / den, 0.01f, 1e-3f); }
            for (int h = 0; h < 8; ++h) { float dd[4]; float ss = 0.f;
                for (int e = 0; e < 4; ++e) { const int c = lane + 64 * e; dd[e] = OB[(size_t)t * 4096 + (2 * h) * 256 + c] - lam * OB[(size_t)t * 4096 + (2 * h + 1) * 256 + c]; ss += dd[e] * dd[e]; }
                ss = wave_sum(ss); const float rstd = 0.8f / sqrtf(ss / 256.f + RMS_EPS);
                for (int e = 0; e < 4; ++e) { const int c = lane + 64 * e; bad |= !st_close(ldbf((const bf16*)(ws + WS_YB) + (size_t)t * 2048 + h * 256 + c), dd[e] * rstd * a.in[11][c], 0.01f, 2e-3f); } }
            if (bad) st_flag(ctl, 12);
        }
    } else if (k == 4) {
        scan_poison(ws + WS_T, 128 * MiB, 6, ctl, gtid, nth);
        for (int s = gw; s < 8192; s += NGW) {
            const int row = (s < 64) ? (s * 131) % SEQ : hash_u(s * 2u + 1u) % SEQ, col = hash_u(s * 2u + 2u) % DM;
            const float pa = dot_bf16((const bf16*)(ws + WS_YA) + (size_t)row * 512, (const bf16*)(ws + WS_WA) + (size_t)col * 512, 512, lane);
            const float pb = dot_bf16((const bf16*)(ws + WS_YB) + (size_t)row * 2048, (const bf16*)(ws + WS_WB) + (size_t)col * 2048, 2048, lane);
            const size_t idx = (size_t)row * DM + col;
            const float want = ldbf((const bf16*)(ws + WS_GA) + idx) * pa + ldbf((const bf16*)(ws + WS_GB) + idx) * pb;
            if (!st_close(ldbf((const bf16*)(ws + WS_MG) + idx), want, 0.02f, 0.02f)) st_flag(ctl, 6);
        }
    } else if (k == 5) {
        scan_poison(ws + WS_H, 64 * MiB, 7, ctl, gtid, nth); scan_poison(ws + WS_RSS, 2 * MiB, 7, ctl, gtid, nth);
        for (int s = gw; s < 8192; s += NGW) {
            const int row = (s < 64) ? (s * 131) % SEQ : hash_u(s * 2u + 1u) % SEQ, col = hash_u(s * 2u + 2u) % DM; const size_t idx = (size_t)row * DM + col;
            const float acc = dot_bf16((const bf16*)(ws + WS_MG) + (size_t)row * DM, (const bf16*)(ws + WS_WOUT) + (size_t)col * DM, DM, lane);
            const float want = a.in[0][idx] + acc;
            if (!st_close(ldbf(H + idx), want, 0.01f, 0.005f)) st_flag(ctl, 7);
            if (s < 512) { float ss = 0.f; for (int c = lane; c < DM; c += 64) { const float v = ldbf(H + (size_t)row * DM + c); ss += v * v; }
                ss = wave_sum(ss); const float part = wave_sum(((const float*)(ws + WS_RSS))[(size_t)row * 64 + lane]);
                if (!st_close(part, ss, 5e-3f, 1e-3f)) st_flag(ctl, 13); }
        }
    } else if (k == 6) {
        scan_poison(ws + WS_U2, 256 * MiB, 8, ctl, gtid, nth);
        for (int s = gw; s < 8192; s += NGW) {
            const int row = (s < 64) ? (s * 131) % SEQ : hash_u(s * 2u + 1u) % SEQ, col = hash_u(s * 2u + 2u) % DFF;
            const float part = wave_sum(((const float*)(ws + WS_RSS))[(size_t)row * 64 + lane]);
            const float rstd = rsqrtf(part * (1.f / DM) + RMS_EPS);
            const float acc = dot_bf16(H + (size_t)row * DM, (const bf16*)(ws + WS_WFF1) + (size_t)col * DM, DM, lane);
            float u = fmaxf(acc * rstd, 0.f); u *= u;
            if (!st_close(ldbf((const bf16*)(ws + WS_U2) + (size_t)row * DFF + col), u, 0.02f, 0.01f)) st_flag(ctl, 8);
        }
    } else if (k == 7) {
        for (int s = gw; s < 8192; s += NGW) {
            const int row = (s < 64) ? (s * 131) % SEQ : hash_u(s * 2u + 1u) % SEQ, col = hash_u(s * 2u + 2u) % DM; const size_t idx = (size_t)row * DM + col;
            const float acc = dot_bf16((const bf16*)(ws + WS_U2) + (size_t)row * DFF, (const bf16*)(ws + WS_WFF2) + (size_t)col * DFF, DFF, lane);
            const float x1 = ldbf(H + idx);
            if (!st_close(a.out[idx], x1 + acc, 0.005f, 0.01f + 0.005f * fabsf(x1))) st_flag(ctl, 9);
        }
    }
}
#endif
__device__ __forceinline__ void p0_transpose_item(const float* W, int K, int N, bf16* WT, const float* kscale, LAS float* scr, int item, int lane) {
    const int nblk = N / 32, kb = item / nblk, nb = item % nblk, k0 = 64 * kb, n0 = 32 * nb;
#pragma unroll 8
    for (int i = 0; i < 32; ++i) { const int kk = 2 * i + (lane >> 5); float w = W[(size_t)(k0 + kk) * N + n0 + (lane & 31)]; if (kscale) w *= kscale[k0 + kk]; scr[kk * 33 + (lane & 31)] = w; }
    LDS_WAIT(); asm volatile("" ::: "memory");
    const int c = lane & 7;
#pragma unroll
    for (int j = 0; j < 4; ++j) { const int n = (lane >> 3) + 8 * j; const LAS float* s = scr + (8 * c) * 33 + n;
        v4u o; o.x = pk2(s[0 * 33], s[1 * 33]); o.y = pk2(s[2 * 33], s[3 * 33]); o.z = pk2(s[4 * 33], s[5 * 33]); o.w = pk2(s[6 * 33], s[7 * 33]);
        *(GAS v4u*)(WT + (size_t)(n0 + n) * K + k0 + 8 * c) = o; }
    LDS_WAIT(); asm volatile("" ::: "memory");
}
template <bool OUT_BF16> __device__ __forceinline__ void rms_row(const float* xrow, const float* g, void* orow, int lane, float oscale = 1.f) {
    const GAS f32x4* xr = (const GAS f32x4*)xrow + lane; const GAS f32x4* gr = (const GAS f32x4*)g + lane;
    f32x4 v[16]; float s = 0.f;
#pragma unroll
    for (int j = 0; j < 16; ++j) { v[j] = xr[64 * j]; s += (v[j].x * v[j].x + v[j].y * v[j].y) + (v[j].z * v[j].z + v[j].w * v[j].w); }
    const float rstd = rsqrtf(wave_sum(s) * (1.f / DM) + RMS_EPS) * oscale;
#pragma unroll
    for (int j = 0; j < 16; ++j) { const f32x4 gv = gr[64 * j]; const f32x4 o = v[j] * rstd * gv;
        if (OUT_BF16) { v2u w; w.x = pk2(o.x, o.y); w.y = pk2(o.z, o.w); ((GAS v2u*)orow)[lane + 64 * j] = w; }
        else ((GAS f32x4*)orow)[lane + 64 * j] = o; }
}
__device__ __forceinline__ void p0_prologue(const Args& a, LAS unsigned char* L, int gw, int NGW, int wave, int lane) {
    LAS float* scr = (LAS float*)(L + wave * 16384);
    unsigned char* ws = a.ws;
    constexpr int I_IN = (DM / 64) * (NIN / 32), I_A = (512 / 64) * (DM / 32), I_B = (2048 / 64) * (DM / 32), I_O = (DM / 64) * (DM / 32), I_1 = (DM / 64) * (DFF / 32), I_2 = (DFF / 64) * (DM / 32);
    constexpr int NITEMS = I_IN + I_A + I_B + I_O + I_1 + I_2;
    for (int it = gw; it < NITEMS; it += NGW) {
        int r = it;
        if (r < I_IN) { p0_transpose_item(a.in[2], DM, NIN, (bf16*)(ws + WS_WIN), nullptr, scr, r, lane); continue; } r -= I_IN;
        if (r < I_A) { p0_transpose_item(a.in[4], 512, DM, (bf16*)(ws + WS_WA), nullptr, scr, r, lane); continue; } r -= I_A;
        if (r < I_B) { p0_transpose_item(a.in[5], 2048, DM, (bf16*)(ws + WS_WB), nullptr, scr, r, lane); continue; } r -= I_B;
        if (r < I_O) { p0_transpose_item(a.in[6], DM, DM, (bf16*)(ws + WS_WOUT), nullptr, scr, r, lane); continue; } r -= I_O;
        if (r < I_1) { p0_transpose_item(a.in[13], DM, DFF, (bf16*)(ws + WS_WFF1), a.in[12], scr, r, lane); continue; } r -= I_1;
        p0_transpose_item(a.in[14], DFF, DM, (bf16*)(ws + WS_WFF2), nullptr, scr, r, lane);
    }
    for (int m = gw; m < SEQ; m += NGW) rms_row<true>(a.in[0] + (size_t)m * DM, a.in[1], (bf16*)(ws + WS_H) + (size_t)m * DM, lane);
}

template <int DV> __device__ __forceinline__ void naive_row(const bf16* q, const bf16* Kb, const bf16* Vb, size_t kstride, int nkeys, LAS float* qs, LAS float* ps, float (&o)[DV / 64], float& lse, int lane) {
    constexpr int NC = DV / 64;
    { const unsigned w = *(const unsigned*)(q + 2 * lane); qs[2 * lane] = bflo(w); qs[2 * lane + 1] = bfhi(w); }
    LDS_WAIT(); asm volatile("" ::: "memory");
    float m = -1e30f, l = 0.f;
#pragma unroll
    for (int c = 0; c < NC; ++c) o[c] = 0.f;
    for (int c0 = 0; c0 < nkeys; c0 += 64) {
        const int j = c0 + lane; const bool valid = j < nkeys;
        float s = -__builtin_inff();
        if (valid) { const v4u* kp = (const v4u*)(Kb + (size_t)j * kstride); float acc = 0.f;
#pragma unroll 4
            for (int d = 0; d < 16; ++d) { const v4u kv = kp[d]; const LAS float* qq = qs + 8 * d;
                acc += bflo(kv.x) * qq[0] + bfhi(kv.x) * qq[1] + bflo(kv.y) * qq[2] + bfhi(kv.y) * qq[3] + bflo(kv.z) * qq[4] + bfhi(kv.z) * qq[5] + bflo(kv.w) * qq[6] + bfhi(kv.w) * qq[7]; }
            s = acc * ATT_SCALE; }
        const float mn = fmaxf(m, wave_max(s));
        const float p = valid ? __expf(s - mn) : 0.f;
        const float alpha = __expf(m - mn);
        l = l * alpha + wave_sum(p); m = mn;
#pragma unroll
        for (int c = 0; c < NC; ++c) o[c] *= alpha;
        ps[lane] = p; LDS_WAIT(); asm volatile("" ::: "memory");
        const int cnt = (nkeys - c0) < 64 ? (nkeys - c0) : 64;
        const bf16* vp = Vb + (size_t)c0 * kstride + lane * NC;
#pragma unroll 4
        for (int kk = 0; kk < cnt; ++kk) { const float pj = ps[kk];
            if constexpr (NC == 2) { const unsigned w = *(const unsigned*)(vp + (size_t)kk * kstride); o[0] += pj * bflo(w); o[1] += pj * bfhi(w); }
            else { const v2u w = *(const v2u*)(vp + (size_t)kk * kstride); o[0] += pj * bflo(w.x); o[1] += pj * bfhi(w.x); o[NC - 2] += pj * bflo(w.y); o[NC - 1] += pj * bfhi(w.y); } }
        LDS_WAIT(); asm volatile("" ::: "memory");
    }
    const float inv = 1.f / l;
#pragma unroll
    for (int c = 0; c < NC; ++c) o[c] *= inv;
    lse = m + __logf(l);
}
__device__ __forceinline__ void p2_attention_naive(const Args& a, LAS unsigned char* L, int gw, int NGW, int wave, int lane) {
    unsigned char* ws = a.ws;
    LAS float* qs = (LAS float*)(L + wave * 1024); LAS float* ps = qs + 128;
    const bf16* QA = (const bf16*)(ws + WS_QA); const bf16* KA = (const bf16*)(ws + WS_KA); const bf16* VA = (const bf16*)(ws + WS_VA);
    const bf16* QB = (const bf16*)(ws + WS_QB); const bf16* KB = (const bf16*)(ws + WS_KB); const bf16* VB = (const bf16*)(ws + WS_VB);
    float* OA = (float*)(ws + WS_OA); float* OB = (float*)(ws + WS_OB); float* LSE = (float*)(ws + WS_LSE);
    for (int it = gw; it < SEQ * 12; it += NGW) {
        const int t = it / 12, ah = it - t * 12, g = ah >> 2, r = (g == 0) ? 1 : (g == 1) ? 4 : 16;
        const int i = t / r, rho = t - i * r, i0 = (i - 128) > 0 ? (i - 128) : 0, nkeys = i - i0 + 1;
        const size_t first = (size_t)(rho + r * i0) * 1536 + ah * 128;
        float o[2]; float lse;
        naive_row<128>(QA + (size_t)t * 1536 + ah * 128, KA + first, VA + first, (size_t)r * 1536, nkeys, qs, ps, o, lse, lane);
        float* op = OA + ((size_t)g * SEQ + t) * 512 + (ah & 3) * 128 + lane * 2; op[0] = o[0]; op[1] = o[1];
        if (lane == 0) LSE[((size_t)g * SEQ + t) * 4 + (ah & 3)] = lse;
    }
    for (int it = gw; it < SEQ * 16; it += NGW) {
        const int t = it >> 4, hi = it & 15;
        float o[4]; float lse;
        naive_row<256>(QB + (size_t)t * 2048 + hi * 128, KB + hi * 128, VB + (hi >> 1) * 256, (size_t)2048, t + 1, qs, ps, o, lse, lane);
        *(f32x4*)(OB + (size_t)t * 4096 + hi * 256 + lane * 4) = (f32x4){o[0], o[1], o[2], o[3]};
    }
}
__device__ __forceinline__ void p2_make_block(unsigned char* ws, int vcu, int k, swa::BlockRef& b) {
    if (k < 4) {
        const int item = vcu + 256 * (k >> 1), vh = item >> 4, x = item & 15, hi = vh >> 1, vhalf = vh & 1, qb = (k & 1) ? 31 - x : x;
        b.Q = (const swa::bf16*)(ws + WS_QB) + (size_t)(qb * 256) * 2048 + hi * 128; b.K = (const swa::bf16*)(ws + WS_KB) + hi * 128; b.V = (const swa::bf16*)(ws + WS_VB) + (hi >> 1) * 256 + vhalf * 128;
        b.O = (float*)(ws + WS_OB) + (size_t)(qb * 256) * 4096 + hi * 256 + vhalf * 128; b.L = nullptr;
        b.P0 = qb * 256; b.qp = 2048; b.kp = 2048; b.op = 4096; b.lp = 0; b.skv = SEQ; b.W = 1 << 20;
    } else {
        const int ab = vcu + 256 * (k - 4), g = ab >> 7, idx = ab & 127, hg = idx >> 5, rem = idx & 31;
        const int r = (g == 0) ? 1 : (g == 1) ? 4 : 16, rho = (g == 0) ? 0 : (g == 1) ? (rem >> 3) : (rem >> 1), qb = (g == 0) ? rem : (g == 1) ? (rem & 7) : (rem & 1), ah = g * 4 + hg;
        const size_t row0 = (size_t)rho + (size_t)r * (qb * 256);
        b.Q = (const swa::bf16*)(ws + WS_QA) + row0 * 1536 + ah * 128; b.K = (const swa::bf16*)(ws + WS_KA) + (size_t)rho * 1536 + ah * 128; b.V = (const swa::bf16*)(ws + WS_VA) + (size_t)rho * 1536 + ah * 128;
        b.O = (float*)(ws + WS_OA) + ((size_t)g * SEQ + row0) * 512 + hg * 128; b.L = (float*)(ws + WS_LSE) + ((size_t)g * SEQ + row0) * 4 + hg;
        b.P0 = qb * 256; b.qp = r * 1536; b.kp = r * 1536; b.op = r * 512; b.lp = r * 4; b.skv = SEQ / r; b.W = 129;
    }
}
__device__ __forceinline__ void p2_attention_mfma(unsigned char* ws, char* lds, int vcu) {
    swa::Seam S; swa::BlockRef cur, nxt;
    const int nblk = (vcu < 128) ? 6 : 5;
    p2_make_block(ws, vcu, 0, cur);
    swa::causal_swa_prime(cur, lds, S);
    for (int k = 0; k < nblk; ++k) {
        if (k + 1 < nblk) p2_make_block(ws, vcu, k + 1, nxt); else nxt = cur;
        swa::causal_swa_block(cur, nxt, lds, S);
        cur = nxt;
    }
}
__device__ __forceinline__ void p3_combine(const Args& a, int gw, int NGW, int lane) {
    unsigned char* ws = a.ws;
    const float* OA = (const float*)(ws + WS_OA); const float* OB = (const float*)(ws + WS_OB); const float* LSE = (const float*)(ws + WS_LSE);
    bf16* YA = (bf16*)(ws + WS_YA); bf16* YB = (bf16*)(ws + WS_YB);
    float d1 = a.in[7][lane] * a.in[8][lane] + a.in[7][lane + 64] * a.in[8][lane + 64];
    float d2 = a.in[9][lane] * a.in[10][lane] + a.in[9][lane + 64] * a.in[10][lane + 64];
    d1 = wave_sum(d1); d2 = wave_sum(d2);
    const float lam_init = 0.2f;
    const float lam = expf(d1) - expf(d2) + lam_init;
    const f32x4 sg = *(const f32x4*)(a.in[11] + lane * 4);
    for (int t = gw; t < SEQ; t += NGW) {
        { const int hg = lane >> 4;
          const float l0 = LSE[((size_t)0 * SEQ + t) * 4 + hg], l1 = LSE[((size_t)1 * SEQ + t) * 4 + hg], l2 = LSE[((size_t)2 * SEQ + t) * 4 + hg];
          const float mx = fmaxf(l0, fmaxf(l1, l2)); const float e0 = expf(l0 - mx), e1 = expf(l1 - mx), e2 = expf(l2 - mx); const float inv = 1.f / (e0 + e1 + e2);
          const float a0 = e0 * inv, a1 = e1 * inv, a2 = e2 * inv;
          const f32x4* p0 = (const f32x4*)(OA + ((size_t)0 * SEQ + t) * 512 + lane * 8); const f32x4* p1 = (const f32x4*)(OA + ((size_t)1 * SEQ + t) * 512 + lane * 8); const f32x4* p2 = (const f32x4*)(OA + ((size_t)2 * SEQ + t) * 512 + lane * 8);
          const f32x4 x0 = p0[0] * a0 + p1[0] * a1 + p2[0] * a2, x1 = p0[1] * a0 + p1[1] * a1 + p2[1] * a2;
          v4u w; w.x = pk2(x0.x, x0.y); w.y = pk2(x0.z, x0.w); w.z = pk2(x1.x, x1.y); w.w = pk2(x1.z, x1.w);
          *(v4u*)(YA + (size_t)t * 512 + lane * 8) = w; }
#pragma unroll 2
        for (int h = 0; h < 8; ++h) {
            const f32x4 o1 = *(const f32x4*)(OB + (size_t)t * 4096 + (2 * h) * 256 + lane * 4), o2 = *(const f32x4*)(OB + (size_t)t * 4096 + (2 * h + 1) * 256 + lane * 4);
            const f32x4 d = o1 - o2 * lam;
            const float ss = wave_sum((d.x * d.x + d.y * d.y) + (d.z * d.z + d.w * d.w));
            const float rstd = rsqrtf(ss * (1.f / 256.f) + RMS_EPS) * (1.f - lam_init);
            const f32x4 y = d * rstd * sg;
            v2u w; w.x = pk2(y.x, y.y); w.y = pk2(y.z, y.w);
            *(v2u*)(YB + (size_t)t * 2048 + h * 256 + lane * 4) = w;
        }
    }
}

__global__ void __launch_bounds__(NWAVES * 64, 2) fwd(Args args) {
    extern __shared__ __attribute__((aligned(16))) unsigned char lds[];
    LAS unsigned char* L = (LAS unsigned char*)lds;
    volatile LAS unsigned* MISC = (volatile LAS unsigned*)(L + MISC_OFF);
    const int tid = threadIdx.x, lane = tid & 63, wave = __builtin_amdgcn_readfirstlane(tid >> 6);
    const int G = gridDim.x, bx = blockIdx.x;
    const int vcu = (G % 8 == 0) ? (bx % 8) * (G / 8) + bx / 8 : bx;
    const int gw = vcu * NWAVES + wave, NGW = G * NWAVES;
    unsigned char* ws = args.ws;
    gu32* ctl = (gu32*)(ws + WS_CTL);
    for (int u = tid; u < (LDS_BYTES - LDSCTL_OFF) / 4; u += NWAVES * 64) ((LAS unsigned*)(L + LDSCTL_OFF))[u] = 0u;
    __syncthreads();
    const int lo = args.ph_lo, hi = args.ph_hi;
    const bool multi = (hi - lo) > 1;
    XcdBarrier bar; bar.bar = (unsigned*)(ctl + CW_BAR); bar.x = 0; bar.st = nullptr;
    if (multi) bar = xcd_barrier_post((unsigned*)(ctl + CW_BAR), MISC + 8);
#ifdef SELFTEST
    if (lo >= 16) { selftest(lo - 16, args, gw, NGW, lane); return; }
#endif
#define IN(k) (lo <= (k) && (k) < hi)
#ifdef SELFTEST
#define SEAM(k) do { if (IN(k) && IN((k) + 1)) { xcd_barrier(bar); selftest((k), args, gw, NGW, lane); xcd_barrier(bar); } } while (0)
#else
#define SEAM(k) do { if (IN(k) && IN((k) + 1)) xcd_barrier(bar); } while (0)
#endif

    if (IN(0)) { p0_prologue(args, L, gw, NGW, wave, lane); SEAM(0); }

    if (IN(1)) {
        pg8::Gemm g{(const bf16*)(ws + WS_H), (const bf16*)(ws + WS_WIN), SEQ, NIN, DM}; pg8::StaticOrder S; S.init(SEQ, NIN, G, bx);
        pg8::EpiProj E{ws, args.in[3]};
        pg8::gemm_phase<pg8::EpiProj, pg8::StaticOrder, true, true>(L, g, S, E);
        SEAM(1);
    }
#ifdef NAIVE_ATTN
    if (IN(2)) { p2_attention_naive(args, L, gw, NGW, wave, lane); SEAM(2); }
#else
    if (IN(2)) { p2_attention_mfma(ws, (char*)lds, vcu); SEAM(2); }
#endif
    if (IN(3)) { p3_combine(args, gw, NGW, lane); SEAM(3); }
    if (IN(4)) {
        { pg8::Gemm g{(const bf16*)(ws + WS_YA), (const bf16*)(ws + WS_WA), SEQ, DM, 512}; pg8::StaticOrder S; S.init(SEQ, DM, G, bx);
          pg8::EpiGate<false> E{(const bf16*)(ws + WS_GA), nullptr, (bf16*)(ws + WS_T)};
          pg8::gemm_phase<pg8::EpiGate<false>, pg8::StaticOrder, true, true>(L, g, S, E); }
        VM_WAIT(); __syncthreads();
        { pg8::Gemm g{(const bf16*)(ws + WS_YB), (const bf16*)(ws + WS_WB), SEQ, DM, 2048}; pg8::StaticOrder S; S.init(SEQ, DM, G, bx);
          pg8::EpiGate<true> E{(const bf16*)(ws + WS_GB), (const bf16*)(ws + WS_T), (bf16*)(ws + WS_MG)};
          pg8::gemm_phase<pg8::EpiGate<true>, pg8::StaticOrder, true, true>(L, g, S, E); }
        SEAM(4);
    }
    if (IN(5)) {
        pg8::Gemm g{(const bf16*)(ws + WS_MG), (const bf16*)(ws + WS_WOUT), SEQ, DM, DM}; pg8::StaticOrder S; S.init(SEQ, DM, G, bx);
        pg8::EpiResid<true> E{args.in[0], args.out, (bf16*)(ws + WS_H), (float*)(ws + WS_RSS)};
        pg8::gemm_phase<pg8::EpiResid<true>, pg8::StaticOrder, true, true>(L, g, S, E);
        SEAM(5);
    }
    if (IN(6)) {
        pg8::Gemm g{(const bf16*)(ws + WS_H), (const bf16*)(ws + WS_WFF1), SEQ, DFF, DM}; pg8::StaticOrder S; S.init(SEQ, DFF, G, bx);
        pg8::EpiRelu2 E{(bf16*)(ws + WS_U2), (const float*)(ws + WS_RSS)};
        pg8::gemm_phase<pg8::EpiRelu2, pg8::StaticOrder, true, true>(L, g, S, E);
        SEAM(6);
    }
    if (IN(7)) {
        pg8::Gemm g{(const bf16*)(ws + WS_U2), (const bf16*)(ws + WS_WFF2), SEQ, DM, DFF}; pg8::StaticOrder S; S.init(SEQ, DM, G, bx);
        pg8::EpiResid<false> E{args.out, args.out, nullptr, nullptr};
        pg8::gemm_phase<pg8::EpiResid<false>, pg8::StaticOrder, true, true>(L, g, S, E);
        SEAM(7);
    }
    if (IN(8)) {
#ifdef SELFTEST
        const unsigned f = __hip_atomic_load((unsigned*)ctl + CW_FLAG, RLX_AGENT) & ~(unsigned)(SELFTEST_IGNORE);
        if (f) { const unsigned f2 = __hip_atomic_load((unsigned*)ctl + CW_FLAG2, RLX_AGENT), nf = __hip_atomic_load((unsigned*)ctl + CW_FLAG2 + 1, RLX_AGENT), nt = __hip_atomic_load((unsigned*)ctl + CW_FLAG2 + 2, RLX_AGENT);
            const float cv1 = f2 ? (float)f2 : (float)__builtin_ctz(f), cv2 = nt ? 1.f + (float)((nf * 30u) / nt) : 0.f;
            for (int m = gw; m < SEQ; m += NGW) for (int c = lane; c < DM; c += 64) args.out[(size_t)m * DM + c] = (m < SEQ / 2) ? cv1 : cv2; }
        else
#endif
        for (int m = gw; m < SEQ; m += NGW) rms_row<false>(args.out + (size_t)m * DM, args.in[15], args.out + (size_t)m * DM, lane);
    }
#undef IN
#undef SEAM
}

extern "C" void kernel_launch(void* const* d_in, const int* in_sizes, int n_in, void* d_out, int out_size, void* d_ws, size_t ws_size, hipStream_t stream) {
    static int grid = 0;
    if (grid == 0) {
        if (n_in != 16 || in_sizes[0] != SEQ * DM || out_size != SEQ * DM || ws_size < WS_END) { fprintf(stderr, "kernel_launch: shape/workspace mismatch (n_in %d, in0 %d, out %d, ws %zu, need %zu); nothing launched\n", n_in, n_in > 0 ? in_sizes[0] : -1, out_size, ws_size, (size_t)WS_END); grid = -1; return; }
        int dev = 0, cus = 0;
        if (hipGetDevice(&dev) != hipSuccess || hipDeviceGetAttribute(&cus, hipDeviceAttributeMultiprocessorCount, dev) != hipSuccess) { grid = -1; return; }
        if (hipFuncSetAttribute((const void*)fwd, hipFuncAttributeMaxDynamicSharedMemorySize, LDS_BYTES) != hipSuccess) { fprintf(stderr, "kernel_launch: hipFuncSetAttribute failed\n"); grid = -1; return; }
        (void)hipGetLastError();
        grid = cus;
    }
    if (grid < 0) return;
    if (hipMemsetAsync((char*)d_ws + WS_CTL, 0, CTL_ZERO_BYTES, stream) != hipSuccess) return;
    Args a{};
    for (int i = 0; i < 16; ++i) a.in[i] = (const float*)d_in[i];
    a.out = (float*)d_out; a.ws = (unsigned char*)d_ws;
    constexpr int NL = MK_N_LAUNCHES;
    static_assert(NL == 1 || NL == N_PHASES, "MK_N_LAUNCHES is 1 or N_PHASES");
    for (int li = 0; li < NL; ++li) {
        a.ph_lo = (NL == 1) ? 0 : li; a.ph_hi = (NL == 1) ? N_PHASES : li + 1;
        hipLaunchKernelGGL(fwd, dim3(grid), dim3(NWAVES * 64), LDS_BYTES, stream, a);
        const hipError_t le = hipPeekAtLastError();
        if (le != hipSuccess) { fprintf(stderr, "kernel_launch: launch %d failed: %s\n", li, hipGetErrorName(le)); break; }
#ifdef SELFTEST
        if (NL == N_PHASES && li < 8) { Args c = a; c.ph_lo = 16 + li; c.ph_hi = 17 + li; hipLaunchKernelGGL(fwd, dim3(grid), dim3(NWAVES * 64), LDS_BYTES, stream, c); }
#endif
    }
}
```

```cpp
#include <hip/hip_runtime.h>
#include <cstdio>
#include <cstdint>
constexpr int SEQ = 8192, DM = 4096, NIN = 18944, DFF = 16384;
constexpr int NWAVES = 8;
constexpr float RMS_EPS = 1e-6f;
constexpr float ATT_SCALE = 0.08838834764831845f;
constexpr int N_PHASES = 9;
#ifndef MK_N_LAUNCHES
#define MK_N_LAUNCHES 1
#endif
constexpr size_t MiB = 1u << 20;
constexpr size_t WS_CTL = 0, CTL_ZERO_BYTES = 1 * MiB;
constexpr size_t WS_WIN = 1 * MiB;
constexpr size_t WS_WA = 149 * MiB;
constexpr size_t WS_WB = 153 * MiB;
constexpr size_t WS_WOUT = 169 * MiB;
constexpr size_t WS_WFF1 = 201 * MiB;
constexpr size_t WS_WFF2 = 329 * MiB;
constexpr size_t WS_H = 457 * MiB;
constexpr size_t WS_YA = 521 * MiB;
constexpr size_t WS_YB = 529 * MiB;
constexpr size_t WS_T = 561 * MiB;
constexpr size_t WS_MG = 625 * MiB;
constexpr size_t WS_RSS = 689 * MiB;
constexpr size_t WS_LSE = 691 * MiB;
constexpr size_t WS_R1 = 692 * MiB;
constexpr size_t WS_QA = WS_R1, WS_KA = WS_R1 + 24 * MiB, WS_VA = WS_R1 + 48 * MiB;
constexpr size_t WS_QB = WS_R1 + 72 * MiB, WS_KB = WS_R1 + 104 * MiB, WS_VB = WS_R1 + 136 * MiB;
constexpr size_t WS_GA = WS_R1 + 168 * MiB, WS_GB = WS_R1 + 232 * MiB;
constexpr size_t WS_OA = WS_R1 + 296 * MiB;
constexpr size_t WS_OB = WS_R1 + 344 * MiB;
constexpr size_t WS_U2 = WS_R1;
constexpr size_t WS_END = WS_R1 + 472 * MiB;
constexpr int CW_BAR = 4096;
constexpr int RING_BYTES = 131072, LDSCTL_OFF = RING_BYTES, MISC_OFF = LDSCTL_OFF + 320, RTAB_OFF = LDSCTL_OFF + 1024, LDS_BYTES = 147456;
namespace pg8 {
#define PG8_LAS __attribute__((address_space(3)))
typedef unsigned short bf16_t;
typedef short bf16x8 __attribute__((ext_vector_type(8)));
typedef float f32x4 __attribute__((ext_vector_type(4)));
typedef unsigned u32x4 __attribute__((ext_vector_type(4)));
constexpr int BM = 256, BK = 64, HALF = 128, HTB = HALF * BK * 2  , STAGE_BYTES = 8 * HTB, NXCD = 8, WGM = 8;

__host__ __device__ __forceinline__ int lds_byte(int r, int c) { const int st = (r >> 4) * 2 + (c >> 5), rr = r & 15, cc = c & 31, ob = rr * 64 + cc * 2; return st * 1024 + (ob ^ (((ob >> 9) & 1) << 5)); }
__host__ __device__ __forceinline__ void stage_rc(int b, int& R, int& C) { const int st = b / 1024, sb = b % 1024, swz = sb ^ (((sb >> 9) & 1) << 5); R = (st >> 1) * 16 + swz / 64; C = (st & 1) * 32 + (swz % 64) / 2; }
__host__ __device__ __forceinline__ int perm32(int rho) { const int n = rho >> 4, i = rho & 15; return 8 * (i >> 2) + 4 * n + (i & 3); }

struct Unit { int pm, pn; };
struct Gemm { const bf16_t* A; const bf16_t* Bt; int M, N, K; };

struct StaticOrder {
    int nM, nN, nwg, G, c, rep;
    __host__ __device__ void init(int M, int N, int G_, int c_) { nM = M / BM; nN = N / BM; nwg = nM * nN; G = G_; c = c_; rep = 1; }
    __host__ __device__ bool next(int i, Unit& u) const {
        if (rep > 1) { const int per = (nwg - c + G - 1) / G; if (i >= per * rep) return false; i = i % per; }
        const long L = (long)i * G + c; if (L >= nwg) return false;
        int wgid = (int)L; { const int q = nwg / NXCD, r = nwg % NXCD, xcd = wgid % NXCD, off = wgid / NXCD; wgid = (xcd < r ? xcd * (q + 1) : r * (q + 1) + (xcd - r) * q) + off; }
        const int nig = WGM * nN, gid = wgid / nig, fm = gid * WGM, gsz = (nM - fm) < WGM ? (nM - fm) : WGM;
        u.pm = fm + ((wgid % nig) % gsz); u.pn = (wgid % nig) / gsz; return true;
    }
    __device__ __forceinline__ void a_ready(const Unit&) const {}
    __device__ __forceinline__ void done(const Unit&) const {}
};

typedef float f32x2c_t __attribute__((ext_vector_type(2))); typedef __bf16 bf16x2c_t __attribute__((ext_vector_type(2)));
__device__ __forceinline__ unsigned cvt_pk_bf16(float lo, float hi) { const f32x2c_t v = {lo, hi}; const bf16x2c_t b = __builtin_convertvector(v, bf16x2c_t); return __builtin_bit_cast(unsigned, b); }
typedef float f32x2 __attribute__((ext_vector_type(2)));
template <class Epi, class Sched, bool ALIGN_EPI = false, bool SP2 = false>
__device__ __forceinline__ void gemm_phase(PG8_LAS unsigned char* lds, const Gemm g, const Sched& S, const Epi& E) {
    const int tid = threadIdx.x, wid = __builtin_amdgcn_readfirstlane(tid >> 6), lane = tid & 63, wr = wid >> 2, wc = wid & 3, fr = lane & 15, fq = lane >> 4;
    const int K = g.K, nt = K / BK;
    unsigned voffA[2], voffB[2];
#pragma unroll
    for (int i = 0; i < 2; ++i) { int R, C; stage_rc(tid * 16 + i * 8192, R, C); const int Rb = Epi::PERM ? ((R & ~31) + perm32(R & 31)) : R;
        voffA[i] = (unsigned)(R * K + C) * 2u; voffB[i] = (unsigned)(Rb * K + C) * 2u; }
    const size_t kstep = (size_t)(BK * 2);
    const size_t hstep = (size_t)HALF * K * 2;
    const size_t tstep = 2 * hstep;
    const unsigned ldsw = (unsigned)wid * 1024u;
    const int aoff = lds_byte(wr * 64 + fr, fq * 8), boff = lds_byte(wc * 32 + fr, fq * 8);
#define PG8_SA(b, h) (((b) * 2 + (h)) * HTB)
#define PG8_SB(b, h) ((4 + (b) * 2 + (h)) * HTB)
#define PG8_STAGE(bufoff, gbase, voff) do { _Pragma("unroll") for (int _i = 0; _i < 2; ++_i) \
        __builtin_amdgcn_global_load_lds((const unsigned*)((const char*)(gbase) + (voff)[_i]), (PG8_LAS unsigned*)(lds + (bufoff) + ldsw + _i * 8192), 16, 0, 0); } while (0)
#define PG8_LDA(dst, b, h) do { _Pragma("unroll") for (int m = 0; m < 4; ++m) _Pragma("unroll") for (int k = 0; k < 2; ++k) dst[m][k] = *(const PG8_LAS bf16x8*)(lds + PG8_SA(b, h) + aoff + m * 2048 + k * 1024); } while (0)
#define PG8_LDB(dst, b, h) do { _Pragma("unroll") for (int n = 0; n < 2; ++n) _Pragma("unroll") for (int k = 0; k < 2; ++k) dst[n][k] = *(const PG8_LAS bf16x8*)(lds + PG8_SB(b, h) + boff + n * 2048 + k * 1024); } while (0)
#define PG8_MMA(ai, bj, At, Bt) do { __builtin_amdgcn_s_setprio(1); _Pragma("unroll") for (int m = 0; m < 4; ++m) _Pragma("unroll") for (int n = 0; n < 2; ++n) _Pragma("unroll") for (int k = 0; k < 2; ++k) \
        acc[ai][bj][m][n] = __builtin_amdgcn_mfma_f32_16x16x32_bf16(Bt[n][k], At[m][k], acc[ai][bj][m][n], 0, 0, 0); __builtin_amdgcn_s_setprio(0); } while (0)
#define PG8_WAIT_V(n) asm volatile("s_waitcnt vmcnt(" #n ")" ::: "memory")
#define PG8_WAIT_L(n) asm volatile("s_waitcnt lgkmcnt(" #n ")" ::: "memory")
#define PG8_BAR __builtin_amdgcn_s_barrier()
#define PG8_SCHED __builtin_amdgcn_sched_barrier(0)
    Unit cur, nxt; int ui = 0;
    if (!S.next(0, cur)) return;
    f32x4 acc[2][2][4][2];
#pragma unroll
    for (int a = 0; a < 2; ++a)
#pragma unroll
        for (int b = 0; b < 2; ++b)
#pragma unroll
            for (int m = 0; m < 4; ++m)
#pragma unroll
                for (int n = 0; n < 2; ++n) acc[a][b][m][n] = (f32x4){0.f, 0.f, 0.f, 0.f};
    bf16x8 At[4][2], B0[2][2], B1[2][2];
    const char* cA = (const char*)g.A + (size_t)cur.pm * tstep; const char* cB = (const char*)g.Bt + (size_t)cur.pn * tstep;
    S.a_ready(cur);
    if constexpr (SP2) {
        PG8_STAGE(PG8_SB(0, 0), cB, voffB); PG8_STAGE(PG8_SB(0, 1), cB + hstep, voffB); PG8_STAGE(PG8_SA(0, 0), cA, voffA); PG8_STAGE(PG8_SA(0, 1), cA + hstep, voffA);
        if (wr == 1) PG8_BAR;
        PG8_WAIT_V(2); PG8_BAR;
        PG8_STAGE(PG8_SB(1, 0), cB + kstep, voffB); PG8_STAGE(PG8_SA(1, 0), cA + kstep, voffA); PG8_STAGE(PG8_SB(1, 1), cB + hstep + kstep, voffB);
        PG8_WAIT_V(6); PG8_BAR;
    } else {
        PG8_STAGE(PG8_SB(0, 0), cB, voffB); PG8_STAGE(PG8_SA(0, 0), cA, voffA); PG8_STAGE(PG8_SB(0, 1), cB + hstep, voffB); PG8_STAGE(PG8_SA(0, 1), cA + hstep, voffA);
        if (wr == 1) PG8_BAR;
        PG8_WAIT_V(4); PG8_BAR;
        PG8_STAGE(PG8_SB(1, 0), cB + kstep, voffB); PG8_STAGE(PG8_SA(1, 0), cA + kstep, voffA); PG8_STAGE(PG8_SB(1, 1), cB + hstep + kstep, voffB);
        PG8_WAIT_V(6); PG8_BAR;
    }
    for (;;) {
        const bool has_next = S.next(ui + 1, nxt);
        const char* nA = has_next ? (const char*)g.A + (size_t)nxt.pm * tstep : cA; const char* nB = has_next ? (const char*)g.Bt + (size_t)nxt.pn * tstep : cB;
        for (int t = 0; t < nt; t += 2) {
            const bool last = (t == nt - 2);
            const char* a1 = cA + (size_t)(t + 1) * kstep;
            const char* a2 = last ? nA : cA + (size_t)(t + 2) * kstep; const char* b2 = last ? nB : cB + (size_t)(t + 2) * kstep;
            const char* a3 = a2 + kstep; const char* b3 = b2 + kstep;
            if (last && has_next) S.a_ready(nxt);
            if constexpr (SP2) {
            PG8_LDB(B0, 0, 0); PG8_LDB(B1, 0, 1); PG8_SCHED; PG8_LDA(At, 0, 0); PG8_STAGE(PG8_SA(1, 1), a1 + hstep, voffA);
            PG8_WAIT_V(8); PG8_WAIT_L(0); PG8_BAR; PG8_MMA(0, 0, At, B0); PG8_MMA(0, 1, At, B1); PG8_BAR; PG8_SCHED;
            PG8_LDA(At, 0, 1); PG8_STAGE(PG8_SB(0, 0), b2, voffB); PG8_STAGE(PG8_SB(0, 1), b2 + hstep, voffB); PG8_STAGE(PG8_SA(0, 0), a2, voffA);
            PG8_WAIT_V(8); PG8_WAIT_L(0); PG8_BAR; PG8_MMA(1, 0, At, B0); PG8_MMA(1, 1, At, B1); PG8_BAR; PG8_SCHED;
            PG8_LDB(B0, 1, 0); PG8_LDB(B1, 1, 1); PG8_SCHED; PG8_LDA(At, 1, 0); PG8_STAGE(PG8_SA(0, 1), a2 + hstep, voffA);
            PG8_WAIT_V(8); PG8_WAIT_L(0); PG8_BAR; PG8_MMA(0, 0, At, B0); PG8_MMA(0, 1, At, B1); PG8_BAR; PG8_SCHED;
            PG8_LDA(At, 1, 1); PG8_STAGE(PG8_SB(1, 0), b3, voffB); PG8_STAGE(PG8_SB(1, 1), b3 + hstep, voffB); PG8_STAGE(PG8_SA(1, 0), a3, voffA);
            PG8_WAIT_V(8); PG8_WAIT_L(0); PG8_BAR; PG8_MMA(1, 0, At, B0); PG8_MMA(1, 1, At, B1); PG8_BAR; PG8_SCHED;
            } else {
            PG8_LDB(B0, 0, 0); PG8_SCHED; PG8_LDA(At, 0, 0); PG8_STAGE(PG8_SA(1, 1), a1 + hstep, voffA);
            PG8_WAIT_L(8); PG8_BAR; PG8_WAIT_L(0); PG8_MMA(0, 0, At, B0); PG8_BAR; PG8_SCHED;
            PG8_LDB(B1, 0, 1); PG8_STAGE(PG8_SB(0, 0), b2, voffB);
            PG8_BAR; PG8_WAIT_L(0); PG8_MMA(0, 1, At, B1); PG8_BAR;
            PG8_LDA(At, 0, 1); PG8_STAGE(PG8_SA(0, 0), a2, voffA);
            PG8_BAR; PG8_WAIT_L(0); PG8_MMA(1, 0, At, B0); PG8_BAR; PG8_SCHED;
            PG8_STAGE(PG8_SB(0, 1), b2 + hstep, voffB);
            PG8_WAIT_V(6); PG8_BAR; PG8_MMA(1, 1, At, B1); PG8_BAR;
            PG8_LDB(B0, 1, 0); PG8_SCHED; PG8_LDA(At, 1, 0); PG8_STAGE(PG8_SA(0, 1), a2 + hstep, voffA);
            PG8_WAIT_L(8); PG8_BAR; PG8_WAIT_L(0); PG8_MMA(0, 0, At, B0); PG8_BAR; PG8_SCHED;
            PG8_LDB(B1, 1, 1); PG8_STAGE(PG8_SB(1, 0), b3, voffB);
            PG8_BAR; PG8_WAIT_L(0); PG8_MMA(0, 1, At, B1); PG8_BAR;
            PG8_LDA(At, 1, 1); PG8_STAGE(PG8_SA(1, 0), a3, voffA);
            PG8_BAR; PG8_WAIT_L(0); PG8_MMA(1, 0, At, B0); PG8_BAR; PG8_SCHED;
            PG8_STAGE(PG8_SB(1, 1), b3 + hstep, voffB);
            PG8_WAIT_V(6); PG8_BAR; PG8_MMA(1, 1, At, B1); PG8_BAR;
            }
        }
        if constexpr (ALIGN_EPI) { if (wr == 0) PG8_BAR; }
        if constexpr (!Epi::AFTER_DRAIN) { E(acc, cur, wr, wc, fr, fq); S.done(cur); }
        if (!has_next) break;
#pragma unroll
        for (int a = 0; a < 2; ++a)
#pragma unroll
            for (int b = 0; b < 2; ++b)
#pragma unroll
                for (int m = 0; m < 4; ++m)
#pragma unroll
                    for (int n = 0; n < 2; ++n) acc[a][b][m][n] = (f32x4){0.f, 0.f, 0.f, 0.f};
        cur = nxt; cA = nA; cB = nB; ++ui;
        if constexpr (ALIGN_EPI) { if (wr == 1) PG8_BAR; }
    }
    PG8_WAIT_V(0);
    if constexpr (!ALIGN_EPI) { if (wr == 0) PG8_BAR; }
    PG8_BAR;
    if constexpr (Epi::AFTER_DRAIN) { E.fused(acc, cur, wr, wc, fr, fq, lds, wid, lane); S.done(cur); }
#undef PG8_SA
#undef PG8_SB
#undef PG8_STAGE
#undef PG8_LDA
#undef PG8_LDB
#undef PG8_MMA
#undef PG8_WAIT_V
#undef PG8_WAIT_L
#undef PG8_BAR
#undef PG8_SCHED
}
}
namespace pg8 {
__device__ __forceinline__ float bf_lo(unsigned u) { return __uint_as_float(u << 16); }
__device__ __forceinline__ float bf_hi(unsigned u) { return __uint_as_float(u & 0xffff0000u); }
__device__ __forceinline__ u32x4 pack8bf(const f32x4 v0, const f32x4 v1) { u32x4 w; w.x = cvt_pk_bf16(v0[0], v0[1]); w.y = cvt_pk_bf16(v0[2], v0[3]); w.z = cvt_pk_bf16(v1[0], v1[1]); w.w = cvt_pk_bf16(v1[2], v1[3]); return w; }
__device__ __forceinline__ float sigmoidf_(float x) { return __builtin_amdgcn_rcpf(1.0f + __builtin_amdgcn_exp2f(-1.4426950408889634f * x)); }

struct EpiProj {
    static constexpr bool PERM = true, AFTER_DRAIN = false;
    unsigned char* ws; const float* bgate;
    __device__ __forceinline__ void operator()(const f32x4 (&acc)[2][2][4][2], const Unit& u, int wr, int wc, int fr, int fq) const {
        const int pn = u.pn;
        size_t off; int ld, ct, mode, boff = 0;
        if (pn < 6)       { off = WS_QA; ld = 1536; ct = pn;      mode = 1; }
        else if (pn < 12) { off = WS_KA; ld = 1536; ct = pn - 6;  mode = 1; }
        else if (pn < 18) { off = WS_VA; ld = 1536; ct = pn - 12; mode = 0; }
        else if (pn < 26) { off = WS_QB; ld = 2048; ct = pn - 18; mode = 1; }
        else if (pn < 34) { off = WS_KB; ld = 2048; ct = pn - 26; mode = 1; }
        else if (pn < 42) { off = WS_VB; ld = 2048; ct = pn - 34; mode = 0; }
        else if (pn < 58) { off = WS_GA; ld = 4096; ct = pn - 42; mode = 2; boff = (pn - 42) * 256; }
        else              { off = WS_GB; ld = 4096; ct = pn - 58; mode = 2; boff = 4096 + (pn - 58) * 256; }
        bf16_t* dst = (bf16_t*)(ws + off);
        const int row0 = u.pm * BM + wr * 64 + fr, col0 = ct * 256 + wc * 32 + 8 * fq;
        if (mode == 2) {
            f32x4 bv[2][2];
#pragma unroll
            for (int bj = 0; bj < 2; ++bj)
#pragma unroll
                for (int n = 0; n < 2; ++n) bv[bj][n] = *(const f32x4*)(bgate + boff + wc * 32 + 8 * fq + bj * HALF + 4 * n);
#pragma unroll
            for (int ai = 0; ai < 2; ++ai)
#pragma unroll
                for (int m = 0; m < 4; ++m) { bf16_t* rowp = dst + (size_t)(row0 + ai * HALF + m * 16) * ld + col0;
#pragma unroll
                    for (int bj = 0; bj < 2; ++bj) { f32x4 v0 = acc[ai][bj][m][0] + bv[bj][0], v1 = acc[ai][bj][m][1] + bv[bj][1];
#pragma unroll
                        for (int i = 0; i < 4; ++i) { v0[i] = sigmoidf_(v0[i]); v1[i] = sigmoidf_(v1[i]); }
                        *(u32x4*)(rowp + bj * HALF) = pack8bf(v0, v1); } }
        } else if (mode == 1 && wc == 0) {
            const bool odd = (fq & 1) != 0, lo = fq < 2;
            float invf[2][4];
            invf[0][0] = odd ? 0.00141421356f : 1.0f;            invf[0][1] = odd ? 0.000622772437f : 0.440366596f;
            invf[0][2] = odd ? 0.000274248188f : 0.193922743f;   invf[0][3] = odd ? 0.000120769735f : 0.0853971019f;
            invf[1][0] = odd ? 5.31829573e-05f : 0.0376060307f;  invf[1][1] = odd ? 2.34199997e-05f : 0.0165604409f;
            invf[1][2] = odd ? 1.03133852e-05f : 0.00729266461f; invf[1][3] = odd ? 4.54167048e-06f : 0.00321144611f;
#pragma unroll
            for (int ai = 0; ai < 2; ++ai)
#pragma unroll
                for (int m = 0; m < 4; ++m) { const int row = row0 + ai * HALF + m * 16; const float pos = (float)row; bf16_t* rowp = dst + (size_t)row * ld + col0;
                    float cs[2][4], sn[2][4];
#pragma unroll
                    for (int n = 0; n < 2; ++n)
#pragma unroll
                        for (int i = 0; i < 4; ++i) { const float ang = pos * invf[n][i]; const float k = rintf(ang * 0.15915494309189535f);
                            float r = fmaf(-k, 6.2831855f, ang); r = fmaf(-k, -1.7484555e-07f, r); const float rev = r * 0.15915494309189535f;
                            cs[n][i] = __builtin_amdgcn_cosf(rev); sn[n][i] = lo ? -__builtin_amdgcn_sinf(rev) : __builtin_amdgcn_sinf(rev); }
#pragma unroll
                    for (int bj = 0; bj < 2; ++bj) { f32x4 v0 = acc[ai][bj][m][0], v1 = acc[ai][bj][m][1], o0, o1;
#pragma unroll
                        for (int i = 0; i < 4; ++i) { const float p0 = __shfl_xor(v0[i], 32), p1 = __shfl_xor(v1[i], 32);
                            o0[i] = v0[i] * cs[0][i] + p0 * sn[0][i]; o1[i] = v1[i] * cs[1][i] + p1 * sn[1][i]; }
                        *(u32x4*)(rowp + bj * HALF) = pack8bf(o0, o1); } }
        } else {
#pragma unroll
            for (int ai = 0; ai < 2; ++ai)
#pragma unroll
                for (int m = 0; m < 4; ++m) { bf16_t* rowp = dst + (size_t)(row0 + ai * HALF + m * 16) * ld + col0;
#pragma unroll
                    for (int bj = 0; bj < 2; ++bj) *(u32x4*)(rowp + bj * HALF) = pack8bf(acc[ai][bj][m][0], acc[ai][bj][m][1]); }
        }
    }
};
template <bool ADD> struct EpiGate {
    static constexpr bool PERM = true, AFTER_DRAIN = false;
    const bf16_t* G; const bf16_t* Tin; bf16_t* O;
    __device__ __forceinline__ void operator()(const f32x4 (&acc)[2][2][4][2], const Unit& u, int wr, int wc, int fr, int fq) const {
        const int row0 = u.pm * BM + wr * 64 + fr, col0 = u.pn * BM + wc * 32 + 8 * fq;
#pragma unroll
        for (int ai = 0; ai < 2; ++ai)
#pragma unroll
            for (int m = 0; m < 4; ++m) {
#pragma unroll
                for (int bj = 0; bj < 2; ++bj) { const size_t idx = (size_t)(row0 + ai * HALF + m * 16) * DM + col0 + bj * HALF;
                    const u32x4 gw = *(const u32x4*)(G + idx);
                    f32x4 v0 = acc[ai][bj][m][0], v1 = acc[ai][bj][m][1];
                    v0[0] *= bf_lo(gw.x); v0[1] *= bf_hi(gw.x); v0[2] *= bf_lo(gw.y); v0[3] *= bf_hi(gw.y);
                    v1[0] *= bf_lo(gw.z); v1[1] *= bf_hi(gw.z); v1[2] *= bf_lo(gw.w); v1[3] *= bf_hi(gw.w);
                    if (ADD) { const u32x4 tw = *(const u32x4*)(Tin + idx);
                        v0[0] += bf_lo(tw.x); v0[1] += bf_hi(tw.x); v0[2] += bf_lo(tw.y); v0[3] += bf_hi(tw.y);
                        v1[0] += bf_lo(tw.z); v1[1] += bf_hi(tw.z); v1[2] += bf_lo(tw.w); v1[3] += bf_hi(tw.w); }
                    *(u32x4*)(O + idx) = pack8bf(v0, v1); }
                if (m & 1) asm volatile("" ::: "memory"); }
    }
};
template <bool STATS> struct EpiResid {
    static constexpr bool PERM = false, AFTER_DRAIN = false;
    const float* base; float* out; bf16_t* xb; float* rss;
    __device__ __forceinline__ void operator()(const f32x4 (&acc)[2][2][4][2], const Unit& u, int wr, int wc, int fr, int fq) const {
        typedef unsigned u32x2v __attribute__((ext_vector_type(2)));
        const int col0 = u.pn * BM + wc * 32 + 4 * fq;
#pragma unroll
        for (int ai = 0; ai < 2; ++ai)
#pragma unroll
            for (int m = 0; m < 4; ++m) { const int row = u.pm * BM + ai * HALF + wr * 64 + m * 16 + fr; const size_t off = (size_t)row * DM + col0; float ss = 0.f;
#pragma unroll
                for (int bj = 0; bj < 2; ++bj)
#pragma unroll
                    for (int n = 0; n < 2; ++n) { const f32x4 o = *(const f32x4*)(base + off + bj * HALF + n * 16) + acc[ai][bj][m][n];
                        *(f32x4*)(out + off + bj * HALF + n * 16) = o;
                        if (STATS) { ss += (o[0] * o[0] + o[1] * o[1]) + (o[2] * o[2] + o[3] * o[3]);
                            u32x2v w; w.x = cvt_pk_bf16(o[0], o[1]); w.y = cvt_pk_bf16(o[2], o[3]); *(u32x2v*)(xb + off + bj * HALF + n * 16) = w; } }
                if (STATS) { ss += __shfl_xor(ss, 16); ss += __shfl_xor(ss, 32); if (fq == 0) rss[(size_t)row * 64 + u.pn * 4 + wc] = ss; }
                if (m & 1) asm volatile("" ::: "memory"); }
    }
};
template <bool TAB> struct EpiRelu2 {
    static constexpr bool PERM = true, AFTER_DRAIN = false;
    bf16_t* O; const float* rss; const PG8_LAS float* rtab;
    __device__ __forceinline__ void operator()(const f32x4 (&acc)[2][2][4][2], const Unit& u, int wr, int wc, int fr, int fq) const {
        const int row0 = u.pm * BM + wr * 64 + fr, col0 = u.pn * BM + wc * 32 + 8 * fq;
#pragma unroll
        for (int ai = 0; ai < 2; ++ai)
#pragma unroll
            for (int m = 0; m < 4; ++m) { const int row = row0 + ai * HALF + m * 16; float rstd;
                if (TAB) rstd = rtab[ai * HALF + wr * 64 + m * 16 + fr];
                else { const f32x4* rp = (const f32x4*)(rss + (size_t)row * 64 + fq * 16);
                    const f32x4 a = rp[0], b = rp[1], c = rp[2], d = rp[3];
                    float t = ((a[0] + a[1]) + (a[2] + a[3])) + ((b[0] + b[1]) + (b[2] + b[3])) + ((c[0] + c[1]) + (c[2] + c[3])) + ((d[0] + d[1]) + (d[2] + d[3]));
                    t += __shfl_xor(t, 16); t += __shfl_xor(t, 32);
                    rstd = rsqrtf(t * (1.0f / DM) + RMS_EPS); }
                bf16_t* rowp = O + (size_t)row * DFF + col0;
#pragma unroll
                for (int bj = 0; bj < 2; ++bj) { f32x4 v0 = acc[ai][bj][m][0] * rstd, v1 = acc[ai][bj][m][1] * rstd;
#pragma unroll
                    for (int i = 0; i < 4; ++i) { v0[i] = fmaxf(v0[i], 0.f); v0[i] *= v0[i]; v1[i] = fmaxf(v1[i], 0.f); v1[i] *= v1[i]; }
                    *(u32x4*)(rowp + bj * HALF) = pack8bf(v0, v1); } }
    }
};
}
namespace swa {
typedef short bf16x8 __attribute__((ext_vector_type(8)));
typedef short s16x4 __attribute__((ext_vector_type(4)));
typedef float f32x16 __attribute__((ext_vector_type(16)));
typedef float f32x4 __attribute__((ext_vector_type(4)));
typedef unsigned u32x4 __attribute__((ext_vector_type(4)));
typedef unsigned short bf16;
constexpr int D = 128, NW = 8, QBLK = 32, KVBLK = 64, QB = NW * QBLK;
constexpr int SHM_V = KVBLK * D * 2, SHM_K = KVBLK * D * 2;
constexpr int LDS_BYTES = 2 * SHM_V + 2 * SHM_K + NW * 64 * 4;
constexpr float SCALE = 0.08838834764831845f, THR = 8.f;
#define KSWZ(row, colB) ((row) * 256 + ((colB) ^ (((row) & 7) << 4)))
#define SBAR() __builtin_amdgcn_sched_barrier(0)
__device__ __forceinline__ int v_st(int k, int c) { const int kk = (k & ~0xC) | ((k & 4) << 1) | ((k & 8) >> 1); return ((kk >> 3) * 4 + (c >> 5)) * 512 + ((kk & 7) * 32 + (c & 31)) * 2; }
__device__ __forceinline__ int v_rd_base(int lane) { return ((lane & 3) << 3) | (((lane >> 2) & 3) << 6) | (((lane >> 4) & 1) << 5) | (((lane >> 5) & 1) << 8); }
constexpr int v_rd_off(int d0, int ks, int half) { return d0 * 512 + ks * 4096 + half * 2048; }
__device__ __forceinline__ int crow(int r, int hi) { return (r & 3) + 8 * (r >> 2) + 4 * hi; }
typedef float f32x2_t __attribute__((ext_vector_type(2))); typedef __bf16 bf16x2_t __attribute__((ext_vector_type(2)));
__device__ __forceinline__ unsigned cvtpk(float lo, float hi) { const f32x2_t v = {lo, hi}; const bf16x2_t b = __builtin_convertvector(v, bf16x2_t); return __builtin_bit_cast(unsigned, b); }
__device__ __forceinline__ bf16x8 load8(const bf16* p) { return *reinterpret_cast<const bf16x8*>(p); }
__device__ __forceinline__ void mask_tile(f32x16& p0, f32x16& p1, int dq, unsigned W) {
    const float NEG = -__builtin_inff();
#pragma unroll
    for (int r = 0; r < 16; ++r) {
        const int c = (r & 3) + 8 * (r >> 2);
        if ((unsigned)(dq - c) >= W) p0[r] = NEG;
        if ((unsigned)(dq - c - 32) >= W) p1[r] = NEG;
    }
}
__device__ __forceinline__ void partialSM(f32x16& p0, f32x16& p1, float& m_reg, float& mn, float& alpha) {
    float pmax = p0[0]; for (int r = 1; r < 16; ++r) pmax = fmaxf(pmax, p0[r]); for (int r = 0; r < 16; ++r) pmax = fmaxf(pmax, p1[r]);
    { auto rr = __builtin_amdgcn_permlane32_swap(__float_as_uint(pmax), __float_as_uint(pmax), false, false);
      pmax = fmaxf(__uint_as_float(rr[0]), __uint_as_float(rr[1])); }
    constexpr float C2 = 1.4426950408889634f * SCALE;
    if (__builtin_expect(__all((pmax - m_reg) * SCALE <= THR), 1)) { mn = m_reg; alpha = 1.f; }
    else { mn = fmaxf(m_reg, pmax); alpha = __builtin_amdgcn_exp2f((m_reg - mn) * C2); m_reg = mn; }
    const float mnL = -mn * C2;
    for (int r = 0; r < 16; ++r) p0[r] = fmaf(p0[r], C2, mnL); for (int r = 0; r < 16; ++r) p1[r] = fmaf(p1[r], C2, mnL);
    for (int r = 0; r < 16; ++r) p0[r] = __builtin_amdgcn_exp2f(p0[r]);
}
__device__ __forceinline__ void finishSM(f32x16& p0, f32x16& p1, float alpha, float& l_reg, bf16x8& pa0, bf16x8& pa1, bf16x8& pa2, bf16x8& pa3) {
    for (int r = 0; r < 16; ++r) p1[r] = __builtin_amdgcn_exp2f(p1[r]);
    float ps = 0; for (int r = 0; r < 16; ++r) ps += p0[r]; for (int r = 0; r < 16; ++r) ps += p1[r];
    { auto rr = __builtin_amdgcn_permlane32_swap(__float_as_uint(ps), __float_as_uint(ps), false, false);
      ps = __uint_as_float(rr[0]) + __uint_as_float(rr[1]); }
    l_reg = l_reg * alpha + ps;
#define PK4(P, B_, OUT) do { unsigned a0 = cvtpk(P[B_+0], P[B_+1]), a1 = cvtpk(P[B_+2], P[B_+3]);                          \
        unsigned b0 = cvtpk(P[B_+4], P[B_+5]), b1 = cvtpk(P[B_+6], P[B_+7]);                                             \
        auto r0 = __builtin_amdgcn_permlane32_swap(a0, b0, false, false); auto r1 = __builtin_amdgcn_permlane32_swap(a1, b1, false, false); \
        u32x4 w = {r0[0], r1[0], r0[1], r1[1]}; OUT = *reinterpret_cast<bf16x8*>(&w); } while (0)
    PK4(p0, 0, pa0); PK4(p0, 8, pa1); PK4(p1, 0, pa2); PK4(p1, 8, pa3);
#undef PK4
}
template <int KB>
__device__ __forceinline__ void qkt(f32x16& p0, f32x16& p1, const char* K_lds, int r32, int hi, const bf16x8* qr) {
    p0 = f32x16{}; p1 = f32x16{};
    const char* kb[4];
#pragma unroll
    for (int dd = 0; dd < 4; ++dd) kb[dd] = K_lds + KB * SHM_K + KSWZ(r32, (dd * 16 + hi * 8) * 2);
#pragma unroll
    for (int d0 = 0; d0 < 8; ++d0) { const char* a = kb[d0 & 3] + (d0 >> 2) * 128;
        bf16x8 b0 = *reinterpret_cast<const bf16x8*>(a);
        bf16x8 b1 = *reinterpret_cast<const bf16x8*>(a + 32 * 256);
        p0 = __builtin_amdgcn_mfma_f32_32x32x16_bf16(b0, qr[d0], p0, 0, 0, 0);
        p1 = __builtin_amdgcn_mfma_f32_32x32x16_bf16(b1, qr[d0], p1, 0, 0, 0); }
}
template <int VB>
__device__ __forceinline__ void pv_tile(f32x16* o, int vb0, bf16x8 pa0, bf16x8 pa1, bf16x8 pa2, bf16x8 pa3) {
#define TRRD(dst, off) asm volatile("ds_read_b64_tr_b16 %0, %1 offset:%2" : "=&v"(dst) : "v"(vb0), "i"(off) : "memory")
#define PV_D0(d0) do { s16x4 l0, l1, l2, l3, h0, h1, h2, h3; constexpr int b_ = VB * SHM_V + v_rd_off(d0, 0, 0);     \
        TRRD(l0, b_); TRRD(h0, b_ + 2048); TRRD(l1, b_ + 4096); TRRD(h1, b_ + 6144); TRRD(l2, b_ + 8192); TRRD(h2, b_ + 10240); TRRD(l3, b_ + 12288); TRRD(h3, b_ + 14336); \
        asm volatile("s_waitcnt lgkmcnt(0)" ::: "memory"); SBAR();                                                             \
        o[d0] = __builtin_amdgcn_mfma_f32_32x32x16_bf16(pa0, (bf16x8){l0[0], l0[1], l0[2], l0[3], h0[0], h0[1], h0[2], h0[3]}, o[d0], 0, 0, 0);   \
        o[d0] = __builtin_amdgcn_mfma_f32_32x32x16_bf16(pa1, (bf16x8){l1[0], l1[1], l1[2], l1[3], h1[0], h1[1], h1[2], h1[3]}, o[d0], 0, 0, 0);   \
        o[d0] = __builtin_amdgcn_mfma_f32_32x32x16_bf16(pa2, (bf16x8){l2[0], l2[1], l2[2], l2[3], h2[0], h2[1], h2[2], h2[3]}, o[d0], 0, 0, 0);   \
        o[d0] = __builtin_amdgcn_mfma_f32_32x32x16_bf16(pa3, (bf16x8){l3[0], l3[1], l3[2], l3[3], h3[0], h3[1], h3[2], h3[3]}, o[d0], 0, 0, 0); } while (0)
    PV_D0(0); PV_D0(1); PV_D0(2); PV_D0(3);
#undef PV_D0
#undef TRRD
}
struct BlockRef { const bf16* Q; const bf16* K; const bf16* V; float* O; float* L; int P0, qp, kp, op, lp, skv, W; };
struct Seam { bf16x8 qr[8]; bf16x8 st_v0, st_v1, st_k0, st_k1; };
__device__ __forceinline__ int swa_jlo(int P0, int W) { const int lowk = P0 - W + 1; return lowk > 0 ? lowk / KVBLK : 0; }
#define ROW(p, k0, rr, pitch) ((p) + (size_t)((k0) + (rr)) * (pitch) + sc)
#define VMW() asm volatile("s_waitcnt vmcnt(0)" ::: "memory")
#define VMWN(n) asm volatile("s_waitcnt vmcnt(%0)" :: "i"(n) : "memory")
#define SLOAD_H(Kp, Vp, k0, pitch) do { S.st_v0 = load8(ROW(Vp, k0, sr, pitch)); S.st_v1 = load8(ROW(Vp, k0, 32 + sr, pitch));              \
                         S.st_k0 = load8(ROW(Kp, k0, sr, pitch)); S.st_k1 = load8(ROW(Kp, k0, 32 + sr, pitch)); } while (0)
#define SWRITE_HK(bf) do { *(bf16x8*)(K_lds + (bf) * SHM_K + kws) = S.st_k0; *(bf16x8*)(K_lds + (bf) * SHM_K + kws + 32 * 256) = S.st_k1; } while (0)
#define SWRITE_HV(bf) do { *(bf16x8*)(V_lds + (bf) * SHM_V + vst0) = S.st_v0; *(bf16x8*)(V_lds + (bf) * SHM_V + vst1) = S.st_v1; } while (0)
#define SWRITE_H(bf) do { SWRITE_HV(bf); SWRITE_HK(bf); } while (0)
__device__ __forceinline__ void causal_swa_prime(const BlockRef& cur, char* lds, Seam& S) {
    const int tid = threadIdx.x, wid = __builtin_amdgcn_readfirstlane(tid >> 6), lane = tid & 63, r32 = lane & 31, hi = lane >> 5;
    const int sr = tid >> 4, sc = (tid & 15) * 8, kws = KSWZ(sr, sc * 2); char* K_lds = lds + 2 * SHM_V;
    const int kb0 = swa_jlo(cur.P0, cur.W) * KVBLK;
#pragma unroll
    for (int d0 = 0; d0 < 8; ++d0) S.qr[d0] = load8(cur.Q + (size_t)(wid * QBLK + r32) * cur.qp + d0 * 16 + hi * 8);
    SLOAD_H(cur.K, cur.V, kb0, cur.kp); VMW(); SWRITE_HK(0);
    __syncthreads();
}
__device__ __forceinline__ void causal_swa_block(const BlockRef& cur, const BlockRef& nxt, char* lds, Seam& S) {
    const int tid = threadIdx.x, wid = __builtin_amdgcn_readfirstlane(tid >> 6), lane = tid & 63, r32 = lane & 31, hi = lane >> 5;
    const int W = cur.W, kp = cur.kp;
    const int j_lo = swa_jlo(cur.P0, W);
    int j_hi = (cur.P0 + QB - 1) / KVBLK + 1; if (j_hi > cur.skv / KVBLK) j_hi = cur.skv / KVBLK;
    const int NT = j_hi - j_lo;
    const int kbn = swa_jlo(nxt.P0, nxt.W) * KVBLK;
    const int qlo = cur.P0 + wid * QBLK, qm = qlo + r32 - 4 * hi;
    char* V_lds = lds; char* K_lds = lds + 2 * SHM_V;
    float* ws = (float*)(lds + 2 * SHM_V + 2 * SHM_K) + wid * 64; float* li_l = ws, * al_l = ws + 32;
    float m_reg = -1e30f, l_reg = 0; f32x16 o[4] = {};
    const int sr = tid >> 4, sc = (tid & 15) * 8, vst0 = v_st(sr, sc), vst1 = v_st(32 + sr, sc), kws = KSWZ(sr, sc * 2);
    const int vb0 = (int)(uintptr_t)V_lds + v_rd_base(lane);
    const bf16* Kh = cur.K; const bf16* Vh = cur.V;
#define RESC(a) do { if (__any((a) < 1.f)) { if (hi == 0) al_l[r32] = (a); asm volatile("s_waitcnt lgkmcnt(0)" ::: "memory");              \
                     for (int d_ = 0; d_ < 4; ++d_) for (int r = 0; r < 16; ++r) o[d_][r] *= al_l[crow(r, hi)]; } } while (0)
#define KBASE(t) ((j_lo + (t)) * KVBLK)
#define MASKT(P0_, P1_, t) do { const int kb_ = KBASE(t); if (kb_ + KVBLK - 1 > qlo || kb_ <= qlo + QBLK - 1 - W) mask_tile(P0_, P1_, qm - kb_, (unsigned)W); } while (0)
    constexpr int NQL = 8;
#define SEAM_K0() do { VMWN(NQL); SWRITE_HK(0); SBAR(); } while (0)
    f32x16 pA0, pA1, pB0, pB1; float mnA, mnB, alA, alB; bf16x8 pa0, pa1, pa2, pa3;
    SWRITE_HV(0); SBAR();
    if (NT > 1) SLOAD_H(Kh, Vh, KBASE(1), kp);
    SBAR(); qkt<0>(pA0, pA1, K_lds, r32, hi, S.qr);
    MASKT(pA0, pA1, 0); partialSM(pA0, pA1, m_reg, mnA, alA);
    if (NT > 1) { VMW(); SWRITE_H(1); }
    __syncthreads();
#define HALF_STEP(PX0, PX1, mnX, alX, PY0, PY1, alY, t, KB, VB, SB) do {                                                      \
        SBAR(); qkt<KB>(PX0, PX1, K_lds, r32, hi, S.qr);                                                                      \
        finishSM(PY0, PY1, alY, l_reg, pa0, pa1, pa2, pa3); SBAR();                                                           \
        if ((t) + 1 < NT) { SLOAD_H(Kh, Vh, KBASE((t) + 1), kp); SBAR(); }                                                    \
        pv_tile<VB>(o, vb0, pa0, pa1, pa2, pa3); MASKT(PX0, PX1, (t)); partialSM(PX0, PX1, m_reg, mnX, alX);                  \
        __syncthreads();                                                                                                      \
        if ((t) + 1 < NT) { VMW(); SWRITE_H(SB); }                                                                            \
        RESC(alX); __syncthreads(); } while (0)
    for (int t = 1; t + 1 < NT; t += 2) {
        HALF_STEP(pB0, pB1, mnB, alB, pA0, pA1, alA, t, 1, 0, 0);
        HALF_STEP(pA0, pA1, mnA, alA, pB0, pB1, alB, t + 1, 0, 1, 1);
    }
    const bool even = (NT & 1) == 0;
    if (even) { SBAR(); qkt<1>(pB0, pB1, K_lds, r32, hi, S.qr); SBAR(); }
    SLOAD_H(nxt.K, nxt.V, kbn, nxt.kp); SBAR();
#pragma unroll
    for (int d0 = 0; d0 < 8; ++d0) S.qr[d0] = load8(nxt.Q + (size_t)(wid * QBLK + r32) * nxt.qp + d0 * 16 + hi * 8);
    SBAR();
    finishSM(pA0, pA1, alA, l_reg, pa0, pa1, pa2, pa3); SBAR();
    pv_tile<0>(o, vb0, pa0, pa1, pa2, pa3);
    if (even) { MASKT(pB0, pB1, NT - 1); partialSM(pB0, pB1, m_reg, mnB, alB); __syncthreads(); RESC(alB);
        finishSM(pB0, pB1, alB, l_reg, pa0, pa1, pa2, pa3); SBAR(); pv_tile<1>(o, vb0, pa0, pa1, pa2, pa3); }
    SBAR(); SEAM_K0();
    if (hi == 0) li_l[r32] = l_reg; asm volatile("s_waitcnt lgkmcnt(0)" ::: "memory");
    float rli[16];
#pragma unroll
    for (int r = 0; r < 16; ++r) rli[r] = __builtin_amdgcn_rcpf(li_l[crow(r, hi)]);
    float* Ow = cur.O + (size_t)(wid * QBLK) * cur.op;
#pragma unroll
    for (int r = 0; r < 16; ++r) { const int orow = crow(r, hi);
#pragma unroll
        for (int d0 = 0; d0 < 4; ++d0) Ow[(size_t)orow * cur.op + d0 * 32 + r32] = o[d0][r] * rli[r]; }
    if (cur.L != nullptr && hi == 0) cur.L[(size_t)(wid * QBLK + r32) * cur.lp] = m_reg * SCALE + __logf(l_reg);
    __syncthreads();
#undef RESC
#undef KBASE
#undef MASKT
#undef SEAM_K0
#undef HALF_STEP
}
#undef ROW
#undef VMW
#undef VMWN
#undef SLOAD_H
#undef SWRITE_HK
#undef SWRITE_HV
#undef SWRITE_H
#undef KSWZ
#undef SBAR
}
#define GAS __attribute__((address_space(1)))
#define LAS __attribute__((address_space(3)))
typedef unsigned short bf16;
typedef unsigned v4u __attribute__((ext_vector_type(4)));
typedef unsigned v2u __attribute__((ext_vector_type(2)));
typedef float f32x4 __attribute__((ext_vector_type(4)));
typedef GAS unsigned gu32;
#define RLX_AGENT __ATOMIC_RELAXED, __HIP_MEMORY_SCOPE_AGENT
#define LDS_WAIT() asm volatile("s_waitcnt lgkmcnt(0)" ::: "memory")
#define VM_WAIT() asm volatile("s_waitcnt vmcnt(0)" ::: "memory")
__device__ __forceinline__ unsigned f2bf(float f) { unsigned u = __builtin_bit_cast(unsigned, f); return (u + 0x7fffu + ((u >> 16) & 1u)) >> 16; }
__device__ __forceinline__ unsigned pk2(float lo, float hi) { return f2bf(lo) | (f2bf(hi) << 16); }
__device__ __forceinline__ float bflo(unsigned u) { return __uint_as_float(u << 16); }
__device__ __forceinline__ float bfhi(unsigned u) { return __uint_as_float(u & 0xffff0000u); }
__device__ __forceinline__ float wave_sum(float v) {
#pragma unroll
    for (int o = 1; o < 64; o <<= 1) v += __shfl_xor(v, o);
    return v;
}
__device__ __forceinline__ float wave_max(float v) {
#pragma unroll
    for (int o = 1; o < 64; o <<= 1) v = fmaxf(v, __shfl_xor(v, o));
    return v;
}
#define XB_TMO      128
#define XB_XCNT(j)  (256  + 64 * (j))
#define XB_XSUB(j)  (1280 + 64 * (j))
#define XB_XGEN(j)  (2304 + 64 * (j))
#define XB_TOP      3328
#define XB_TOPGEN   3392
#define XCD_BAR_WORDS 3456
#define XB_SPIN_CAP (1u << 23)

__device__ __forceinline__ unsigned xb_ld(unsigned* p)              { return __hip_atomic_load(p, __ATOMIC_RELAXED, __HIP_MEMORY_SCOPE_AGENT); }
__device__ __forceinline__ unsigned xb_add(unsigned* p, unsigned v) { return __hip_atomic_fetch_add(p, v, __ATOMIC_RELAXED, __HIP_MEMORY_SCOPE_AGENT); }
__device__ __forceinline__ unsigned xb_xcc_id() { return (unsigned)__builtin_amdgcn_s_getreg((3 << 11) | 20) & 0xFu; }
#define XB_SPIN(cond, bar) do { unsigned _sp = 0; while (cond) { __builtin_amdgcn_s_sleep(1); \
    if ((++_sp & 255u) == 0u) { if (xb_ld(&(bar)[XB_TMO])) break; if (_sp > XB_SPIN_CAP) { atomicAdd(&(bar)[XB_TMO], 1u); break; } } } } while (0)

struct XcdBarrier {
    unsigned* bar; unsigned x;
    volatile LAS unsigned* st;
};

__device__ __forceinline__ XcdBarrier xcd_barrier_post(unsigned* bar, volatile LAS unsigned* st) {
    XcdBarrier b; b.bar = bar; b.x = xb_xcc_id(); b.st = st;
    if (threadIdx.x == 0) (void)xb_add(&bar[XB_XCNT(b.x)], 1u);
    return b;
}
__device__ __forceinline__ void xcd_barrier_complete(unsigned* bar, unsigned x, unsigned& nloc, unsigned& nx) {
    const unsigned G = gridDim.x * gridDim.y * gridDim.z;
    unsigned sum, cnt, mine, sp = 0u;
    for (;;) {
        sum = 0u; cnt = 0u; mine = 0u;
#pragma unroll
        for (unsigned j = 0; j < 16; ++j) { const unsigned c = xb_ld(&bar[XB_XCNT(j)]); sum += c; cnt += (c > 0u) ? 1u : 0u; mine = (j == x) ? c : mine; }
        if (sum == G) break;
        __builtin_amdgcn_s_sleep(1);
        if ((++sp & 255u) == 0u) { if (xb_ld(&bar[XB_TMO])) break; if (sp > XB_SPIN_CAP) { atomicAdd(&bar[XB_TMO], 1u); break; } }
    }
    nloc = mine > 0u ? mine : 1u; nx = cnt > 0u ? cnt : 1u;
}

__device__ __forceinline__ void xcd_barrier(const XcdBarrier& b) {
    asm volatile("s_waitcnt vmcnt(0)" ::: "memory");
    __syncthreads();
    if (threadIdx.x == 0) {
        unsigned* bar = b.bar;
        __builtin_amdgcn_s_waitcnt(0);
        unsigned nloc = b.st[0], nx = b.st[1];
        if (nloc == 0u) { xcd_barrier_complete(bar, b.x, nloc, nx); b.st[0] = nloc; b.st[1] = nx; }
        const unsigned old = xb_add(&bar[XB_XSUB(b.x)], 1u);
        const unsigned gen = old / nloc;
        if (old + 1u == (gen + 1u) * nloc) {
            __builtin_amdgcn_fence(__ATOMIC_RELEASE, "agent");
            asm volatile("s_waitcnt vmcnt(0)" ::: "memory");
            const unsigned og = xb_add(&bar[XB_TOP], 1u);
            const unsigned tg = og / nx;
            if (og + 1u == (tg + 1u) * nx) xb_add(&bar[XB_TOPGEN], 1u);
            else XB_SPIN(xb_ld(&bar[XB_TOPGEN]) == tg, bar);
            __builtin_amdgcn_fence(__ATOMIC_ACQUIRE, "agent");
            xb_add(&bar[XB_XGEN(b.x)], 1u);
            asm volatile("s_waitcnt vmcnt(0)" ::: "memory");
        } else {
            XB_SPIN(xb_ld(&bar[XB_XGEN(b.x)]) == gen, bar);
            __builtin_amdgcn_fence(__ATOMIC_ACQUIRE, "agent");
            asm volatile("s_waitcnt vmcnt(0)" ::: "memory");
        }
    }
    __syncthreads();
}
struct Args { const float* in[16]; float* out; unsigned char* ws; int ph_lo, ph_hi; };

#ifdef SELFTEST
constexpr int CW_FLAG = 64, CW_FLAG2 = 128;
__device__ __forceinline__ void st_flag2(gu32* ctl, unsigned bits) { atomicOr((unsigned*)ctl + CW_FLAG2, bits); }
__device__ __forceinline__ void st_flag(gu32* ctl, int code) { atomicOr((unsigned*)ctl + CW_FLAG, 1u << code); }
__device__ __forceinline__ bool st_close(float got, float want, float rel, float ab) { return fabsf(got - want) <= rel * fabsf(want) + ab; }
__device__ __forceinline__ void scan_poison(const void* p, size_t nbytes, int code, gu32* ctl, size_t gtid, size_t nthreads) {
    const v4u* q = (const v4u*)p; bool bad = false;
    for (size_t i = gtid; i < nbytes / 16; i += nthreads) { const v4u w = q[i]; bad |= (w.x == 0xAAAAAAAAu) | (w.y == 0xAAAAAAAAu) | (w.z == 0xAAAAAAAAu) | (w.w == 0xAAAAAAAAu); }
    if (bad) st_flag(ctl, code);
}
__device__ __forceinline__ float dot_bf16(const bf16* a, const bf16* b, int K, int lane) {
    float s = 0.f;
    for (int k = lane * 8; k < K; k += 512) { const v4u x = *(const v4u*)(a + k), y = *(const v4u*)(b + k);
        s += bflo(x.x) * bflo(y.x) + bfhi(x.x) * bfhi(y.x) + bflo(x.y) * bflo(y.y) + bfhi(x.y) * bfhi(y.y) + bflo(x.z) * bflo(y.z) + bfhi(x.z) * bfhi(y.z) + bflo(x.w) * bflo(y.w) + bfhi(x.w) * bfhi(y.w); }
    return wave_sum(s);
}
__device__ __forceinline__ unsigned hash_u(unsigned x) { x ^= x >> 16; x *= 0x7feb352dU; x ^= x >> 15; x *= 0x846ca68bU; x ^= x >> 16; return x; }
__device__ __forceinline__ float ldbf(const bf16* p) { return __uint_as_float((unsigned)(*p) << 16); }
__device__ __forceinline__ void sincos_d(double x, double& s, double& c) {
    const double TWO_PI = 6.283185307179586; const double k = rint(x / TWO_PI); const double r = x - k * TWO_PI, r2 = r * r;
    double ts = 1.0, tc = 1.0;
    for (int i = 14; i >= 1; --i) { ts = 1.0 - r2 / (double)((2 * i) * (2 * i + 1)) * ts; tc = 1.0 - r2 / (double)((2 * i - 1) * (2 * i)) * tc; }
    s = r * ts; c = tc;
}

template <int NC> __device__ __forceinline__ void brute_row(const bf16* q, const bf16* Kb, const bf16* Vb, size_t kstride, int nkeys, float (&o)[NC], float& lse, int lane) {
    const unsigned qw = *(const unsigned*)(q + 2 * lane); const float q0 = bflo(qw), q1 = bfhi(qw);
    float mx = -1e30f;
    for (int j = 0; j < nkeys; ++j) { const unsigned kw = *(const unsigned*)(Kb + (size_t)j * kstride + 2 * lane); const float sc = wave_sum(q0 * bflo(kw) + q1 * bfhi(kw)) * ATT_SCALE; mx = fmaxf(mx, sc); }
    float l = 0.f;
#pragma unroll
    for (int c = 0; c < NC; ++c) o[c] = 0.f;
    for (int j = 0; j < nkeys; ++j) { const unsigned kw = *(const unsigned*)(Kb + (size_t)j * kstride + 2 * lane); const float sc = wave_sum(q0 * bflo(kw) + q1 * bfhi(kw)) * ATT_SCALE;
        const float p = expf(sc - mx); l += p;
#pragma unroll
        for (int c = 0; c < NC; ++c) o[c] += p * ldbf(Vb + (size_t)j * kstride + lane * NC + c); }
#pragma unroll
    for (int c = 0; c < NC; ++c) o[c] /= l;
    lse = mx + logf(l);
}
__device__ __forceinline__ void selftest(int k, const Args& a, int gw, int NGW, int lane) {
    unsigned char* ws = a.ws; gu32* ctl = (gu32*)(ws + WS_CTL);
    const size_t gtid = (size_t)gw * 64 + lane, nth = (size_t)NGW * 64;
    const bf16* H = (const bf16*)(ws + WS_H);
    if (k == 0) {
        scan_poison(ws + WS_WIN, WS_H + 64 * MiB - WS_WIN, 1, ctl, gtid, nth);
        for (unsigned s = (unsigned)gtid; s < 1u << 20; s += (unsigned)nth) {
            const unsigned h1 = hash_u(s * 2u + 1u), h2 = hash_u(s * 2u + 2u); const int mat = s % 6;
            const float* W; const bf16* WT; int K, N; const float* sc = nullptr;
            if (mat == 0) { W = a.in[2]; WT = (const bf16*)(ws + WS_WIN); K = DM; N = NIN; }
            else if (mat == 1) { W = a.in[4]; WT = (const bf16*)(ws + WS_WA); K = 512; N = DM; }
            else if (mat == 2) { W = a.in[5]; WT = (const bf16*)(ws + WS_WB); K = 2048; N = DM; }
            else if (mat == 3) { W = a.in[6]; WT = (const bf16*)(ws + WS_WOUT); K = DM; N = DM; }
            else if (mat == 4) { W = a.in[13]; WT = (const bf16*)(ws + WS_WFF1); K = DM; N = DFF; sc = a.in[12]; }
            else { W = a.in[14]; WT = (const bf16*)(ws + WS_WFF2); K = DFF; N = DM; }
            const int kk = h1 % K, n = h2 % N; float w = W[(size_t)kk * N + n]; if (sc) w *= sc[kk];
            if (WT[(size_t)n * K + kk] != (bf16)f2bf(w)) st_flag(ctl, 1);
        }
        for (int s = gw; s < 256; s += NGW) {
            const int row = hash_u(s + 777u) % SEQ; const float* xr = a.in[0] + (size_t)row * DM; float ss = 0.f;
            for (int c = lane; c < DM; c += 64) ss += xr[c] * xr[c];
            const float rstd = rsqrtf(wave_sum(ss) * (1.f / DM) + RMS_EPS); bool bad = false;
            for (int c = lane; c < DM; c += 64) bad |= !st_close(ldbf(H + (size_t)row * DM + c), xr[c] * rstd * a.in[1][c], 0.01f, 1e-3f);
            if (bad) st_flag(ctl, 1);
        }
    } else if (k == 1) {
        { const v4u* q = (const v4u*)(ws + WS_QA); bool bad = false;
          for (size_t i = gtid; i < 296 * MiB / 16; i += nth) { const v4u w = q[i]; bad |= (w.x == 0xAAAAAAAAu) | (w.y == 0xAAAAAAAAu) | (w.z == 0xAAAAAAAAu) | (w.w == 0xAAAAAAAAu); }
          if (bad) { st_flag(ctl, 2); st_flag2(ctl, 1u); } }
        for (int s = gw; s < 16384; s += NGW) {
            const int row = (s < 64) ? (s * 131) % SEQ : hash_u(s * 2u + 1u) % SEQ, col = hash_u(s * 2u + 2u) % NIN;
            const float acc = dot_bf16(H + (size_t)row * DM, (const bf16*)(ws + WS_WIN) + (size_t)col * DM, DM, lane);
            size_t off; int ld, c0, mode;
            if (col < 1536) { off = WS_QA; ld = 1536; c0 = col; mode = 1; }
            else if (col < 3072) { off = WS_KA; ld = 1536; c0 = col - 1536; mode = 1; }
            else if (col < 4608) { off = WS_VA; ld = 1536; c0 = col - 3072; mode = 0; }
            else if (col < 6656) { off = WS_QB; ld = 2048; c0 = col - 4608; mode = 1; }
            else if (col < 8704) { off = WS_KB; ld = 2048; c0 = col - 6656; mode = 1; }
            else if (col < 10752) { off = WS_VB; ld = 2048; c0 = col - 8704; mode = 0; }
            else if (col < 14848) { off = WS_GA; ld = 4096; c0 = col - 10752; mode = 2; }
            else { off = WS_GB; ld = 4096; c0 = col - 14848; mode = 2; }
            const float got = ldbf((const bf16*)(ws + off) + (size_t)row * ld + c0);
            float want = acc; int code = 2;
            if (mode == 2) want = 1.f / (1.f + expf(-(acc + a.in[3][col - 10752])));
            else if (mode == 1 && (c0 & 127) < 32) { code = 3; const int d = c0 & 127, j = d & 15;
                const float acc2 = dot_bf16(H + (size_t)row * DM, (const bf16*)(ws + WS_WIN) + (size_t)(col ^ 16) * DM, DM, lane);
                const float inv = (float)exp2(-(double)j * (18.931568569324174 / 16.0)); const float ang = (float)row * inv;
                double sn, cs; sincos_d((double)ang, sn, cs);
                want = (d < 16) ? acc * (float)cs - acc2 * (float)sn : acc * (float)cs + acc2 * (float)sn; }
            if (mode == 2 && lane == 0) atomicAdd((unsigned*)ctl + CW_FLAG2 + 2, 1u);
            if (!st_close(got, want, 0.02f, 0.03f)) { st_flag(ctl, code);
                if (mode == 2) { const int pn = col / 256; st_flag2(ctl, (pn < 58 ? 1u : 0u) | ((pn >= 58 && pn != 73) ? 2u : 0u) | (pn == 73 ? 4u : 0u) | (((row & 255) < 128) ? 8u : 16u)); if (lane == 0) atomicAdd((unsigned*)ctl + CW_FLAG2 + 1, 1u); } }
        }
    } else if (k == 2) {
        scan_poison(ws + WS_OA, 176 * MiB, 4, ctl, gtid, nth); scan_poison(ws + WS_LSE, 3 * SEQ * 4 * 4, 4, ctl, gtid, nth);
        const float* OA = (const float*)(ws + WS_OA); const float* OB = (const float*)(ws + WS_OB); const float* LSE = (const float*)(ws + WS_LSE);
        for (int s = gw; s < 1024; s += NGW) {
            const int t = (s < 200) ? s * 3 : hash_u(s * 2u + 1u) % SEQ, ah = hash_u(s * 2u + 2u) % 12, g = ah >> 2, r = (g == 0) ? 1 : (g == 1) ? 4 : 16;
            const int i = t / r, rho = t % r, i0 = (i > 128) ? i - 128 : 0;
            const bf16* KA = (const bf16*)(ws + WS_KA) + (size_t)(rho + r * i0) * 1536 + ah * 128; const bf16* VA = (const bf16*)(ws + WS_VA) + (size_t)(rho + r * i0) * 1536 + ah * 128;
            float o[2]; float lse; brute_row<2>((const bf16*)(ws + WS_QA) + (size_t)t * 1536 + ah * 128, KA, VA, (size_t)r * 1536, i - i0 + 1, o, lse, lane);
            const float* got = OA + ((size_t)g * SEQ + t) * 512 + (ah & 3) * 128 + lane * 2;
            if (!st_close(got[0], o[0], 2e-3f, 2e-3f) || !st_close(got[1], o[1], 2e-3f, 2e-3f) || !st_close(LSE[((size_t)g * SEQ + t) * 4 + (ah & 3)], lse, 1e-3f, 2e-3f)) st_flag(ctl, 10);
        }
        for (int s = gw; s < 512; s += NGW) {
            const int t = (s < 100) ? s * 2 : hash_u(s * 2u + 1u) % SEQ, hi = hash_u(s * 2u + 2u) % 16;
            float o[4]; float lse; brute_row<4>((const bf16*)(ws + WS_QB) + (size_t)t * 2048 + hi * 128, (const bf16*)(ws + WS_KB) + hi * 128, (const bf16*)(ws + WS_VB) + (hi >> 1) * 256, (size_t)2048, t + 1, o, lse, lane);
            const float* got = OB + (size_t)t * 4096 + hi * 256 + lane * 4; bool bad = false;
#pragma unroll
            for (int c = 0; c < 4; ++c) bad |= !st_close(got[c], o[c], 2e-3f, 2e-3f);
            if (bad) st_flag(ctl, 11);
        }
    } else if (k == 3) {
        scan_poison(ws + WS_YA, 40 * MiB, 5, ctl, gtid, nth);
        const float* OA = (const float*)(ws + WS_OA); const float* OB = (const float*)(ws + WS_OB); const float* LSE = (const float*)(ws + WS_LSE);
        float d1 = 0.f, d2 = 0.f; for (int e = 0; e < 128; ++e) { d1 += a.in[7][e] * a.in[8][e]; d2 += a.in[9][e] * a.in[10][e]; }
        const float lam = expf(d1) - expf(d2) + 0.2f;
        for (int s = gw; s < 256; s += NGW) { const int t = hash_u(s + 99u) % SEQ; bool bad = false;
            for (int c = lane; c < 512; c += 64) { const int hg = c >> 7; float l[3], mx = -1e30f; for (int g = 0; g < 3; ++g) { l[g] = LSE[((size_t)g * SEQ + t) * 4 + hg]; mx = fmaxf(mx, l[g]); }
                float den = 0.f, num = 0.f; for (int g = 0; g < 3; ++g) { const float e = expf(l[g] - mx); den += e; num += e * OA[((size_t)g * SEQ + t) * 512 + c]; }
                bad |= !st_close(ldbf((const bf16*)(ws + WS_YA) + (size_t)t * 512 + c), num / den, 0.01f, 1e-3f); }
            for (int h = 0; h < 8; ++h) { float dd[4]; float ss = 0.f;
                for (int e = 0; e < 4; ++e) { const int c = lane + 64 * e; dd[e] = OB[(size_t)t * 4096 + (2 * h) * 256 + c] - lam * OB[(size_t)t * 4096 + (2 * h + 1) * 256 + c]; ss += dd[e] * dd[e]; }
                ss = wave_sum(ss); const float rstd = 0.8f / sqrtf(ss / 256.f + RMS_EPS);
                for (int e = 0; e < 4; ++e) { const int c = lane + 64 * e; bad |= !st_close(ldbf((const bf16*)(ws + WS_YB) + (size_t)t * 2048 + h * 256 + c), dd[e] * rstd * a.in[11][c], 0.01f, 2e-3f); } }
            if (bad) st_flag(ctl, 12);
        }
    } else if (k == 4) {
        scan_poison(ws + WS_T, 128 * MiB, 6, ctl, gtid, nth);
        for (int s = gw; s < 8192; s += NGW) {
            const int row = (s < 64) ? (s * 131) % SEQ : hash_u(s * 2u + 1u) % SEQ, col = hash_u(s * 2u + 2u) % DM;
            const float pa = dot_bf16((const bf16*)(ws + WS_YA) + (size_t)row * 512, (const bf16*)(ws + WS_WA) + (size_t)col * 512, 512, lane);
            const float pb = dot_bf16((const bf16*)(ws + WS_YB) + (size_t)row * 2048, (const bf16*)(ws + WS_WB) + (size_t)col * 2048, 2048, lane);
            const size_t idx = (size_t)row * DM + col;
            const float want = ldbf((const bf16*)(ws + WS_GA) + idx) * pa + ldbf((const bf16*)(ws + WS_GB) + idx) * pb;
            if (!st_close(ldbf((const bf16*)(ws + WS_MG) + idx), want, 0.02f, 0.02f)) st_flag(ctl, 6);
        }
    } else if (k == 5) {
        scan_poison(ws + WS_H, 64 * MiB, 7, ctl, gtid, nth); scan_poison(ws + WS_RSS, 2 * MiB, 7, ctl, gtid, nth);
        for (int s = gw; s < 8192; s += NGW) {
            const int row = (s < 64) ? (s * 131) % SEQ : hash_u(s * 2u + 1u) % SEQ, col = hash_u(s * 2u + 2u) % DM; const size_t idx = (size_t)row * DM + col;
            const float acc = dot_bf16((const bf16*)(ws + WS_MG) + (size_t)row * DM, (const bf16*)(ws + WS_WOUT) + (size_t)col * DM, DM, lane);
            const float want = a.in[0][idx] + acc;
            if (!st_close(ldbf(H + idx), want, 0.01f, 0.005f)) st_flag(ctl, 7);
            if (s < 512) { float ss = 0.f; for (int c = lane; c < DM; c += 64) { const float v = ldbf(H + (size_t)row * DM + c); ss += v * v; }
                ss = wave_sum(ss); const float part = wave_sum(((const float*)(ws + WS_RSS))[(size_t)row * 64 + lane]);
                if (!st_close(part, ss, 5e-3f, 1e-3f)) st_flag(ctl, 13); }
        }
    } else if (k == 6) {
        scan_poison(ws + WS_U2, 256 * MiB, 8, ctl, gtid, nth);
        for (int s = gw; s < 8192; s += NGW) {
            const int row = (s < 64) ? (s * 131) % SEQ : hash_u(s * 2u + 1u) % SEQ, col = hash_u(s * 2u + 2u) % DFF;
            const float part = wave_sum(((const float*)(ws + WS_RSS))[(size_t)row * 64 + lane]);
            const float rstd = rsqrtf(part * (1.f / DM) + RMS_EPS);
            const float acc = dot_bf16(H + (size_t)row * DM, (const bf16*)(ws + WS_WFF1) + (size_t)col * DM, DM, lane);
            float u = fmaxf(acc * rstd, 0.f); u *= u;
            if (!st_close(ldbf((const bf16*)(ws + WS_U2) + (size_t)row * DFF + col), u, 0.02f, 0.01f)) st_flag(ctl, 8);
        }
    } else if (k == 7) {
        for (int s = gw; s < 8192; s += NGW) {
            const int row = (s < 64) ? (s * 131) % SEQ : hash_u(s * 2u + 1u) % SEQ, col = hash_u(s * 2u + 2u) % DM; const size_t idx = (size_t)row * DM + col;
            const float acc = dot_bf16((const bf16*)(ws + WS_U2) + (size_t)row * DFF, (const bf16*)(ws + WS_WFF2) + (size_t)col * DFF, DFF, lane);
            const float x1 = ldbf(H + idx);
            if (!st_close(a.out[idx], x1 + acc, 0.005f, 0.01f + 0.005f * fabsf(x1))) st_flag(ctl, 9);
        }
    }
}
#endif
__device__ __forceinline__ void p0_transpose_item(const float* W, int K, int N, bf16* WT, const float* kscale, LAS float* scr, int item, int lane) {
    const int nblk = N / 32, kb = item / nblk, nb = item % nblk, k0 = 64 * kb, n0 = 32 * nb;
#pragma unroll 8
    for (int i = 0; i < 32; ++i) { const int kk = 2 * i + (lane >> 5); float w = W[(size_t)(k0 + kk) * N + n0 + (lane & 31)]; if (kscale) w *= kscale[k0 + kk]; scr[kk * 33 + (lane & 31)] = w; }
    LDS_WAIT(); asm volatile("" ::: "memory");
    const int c = lane & 7;
#pragma unroll
    for (int j = 0; j < 4; ++j) { const int n = (lane >> 3) + 8 * j; const LAS float* s = scr + (8 * c) * 33 + n;
        v4u o; o.x = pk2(s[0 * 33], s[1 * 33]); o.y = pk2(s[2 * 33], s[3 * 33]); o.z = pk2(s[4 * 33], s[5 * 33]); o.w = pk2(s[6 * 33], s[7 * 33]);
        *(GAS v4u*)(WT + (size_t)(n0 + n) * K + k0 + 8 * c) = o; }
    LDS_WAIT(); asm volatile("" ::: "memory");
}
template <bool OUT_BF16> __device__ __forceinline__ void rms_row(const float* xrow, const float* g, void* orow, int lane, float oscale = 1.f) {
    const GAS f32x4* xr = (const GAS f32x4*)xrow + lane; const GAS f32x4* gr = (const GAS f32x4*)g + lane;
    f32x4 v[16]; float s = 0.f;
#pragma unroll
    for (int j = 0; j < 16; ++j) { v[j] = xr[64 * j]; s += (v[j].x * v[j].x + v[j].y * v[j].y) + (v[j].z * v[j].z + v[j].w * v[j].w); }
    const float rstd = rsqrtf(wave_sum(s) * (1.f / DM) + RMS_EPS) * oscale;
#pragma unroll
    for (int j = 0; j < 16; ++j) { const f32x4 gv = gr[64 * j]; const f32x4 o = v[j] * rstd * gv;
        if (OUT_BF16) { v2u w; w.x = pk2(o.x, o.y); w.y = pk2(o.z, o.w); ((GAS v2u*)orow)[lane + 64 * j] = w; }
        else ((GAS f32x4*)orow)[lane + 64 * j] = o; }
}
__device__ __forceinline__ void p0_prologue(const Args& a, LAS unsigned char* L, int gw, int NGW, int wave, int lane) {
    LAS float* scr = (LAS float*)(L + wave * 16384);
    unsigned char* ws = a.ws;
    constexpr int I_IN = (DM / 64) * (NIN / 32);
    for (int it = gw; it < I_IN; it += NGW) p0_transpose_item(a.in[2], DM, NIN, (bf16*)(ws + WS_WIN), nullptr, scr, it, lane);
    for (int m = gw; m < SEQ; m += NGW) rms_row<true>(a.in[0] + (size_t)m * DM, a.in[1], (bf16*)(ws + WS_H) + (size_t)m * DM, lane);
}
__device__ __forceinline__ void p0_convert_rest(const Args& a, LAS unsigned char* L, int cw, int NCW, int wave, int lane) {
    LAS float* scr = (LAS float*)(L + wave * 16384);
    unsigned char* ws = a.ws;
    constexpr int I_A = (512 / 64) * (DM / 32), I_B = (2048 / 64) * (DM / 32), I_O = (DM / 64) * (DM / 32), I_1 = (DM / 64) * (DFF / 32), I_2 = (DFF / 64) * (DM / 32);
    constexpr int NITEMS = I_A + I_B + I_O + I_1 + I_2;
    for (int it = cw; it < NITEMS; it += NCW) {
        int r = it;
        if (r < I_A) { p0_transpose_item(a.in[4], 512, DM, (bf16*)(ws + WS_WA), nullptr, scr, r, lane); continue; } r -= I_A;
        if (r < I_B) { p0_transpose_item(a.in[5], 2048, DM, (bf16*)(ws + WS_WB), nullptr, scr, r, lane); continue; } r -= I_B;
        if (r < I_O) { p0_transpose_item(a.in[6], DM, DM, (bf16*)(ws + WS_WOUT), nullptr, scr, r, lane); continue; } r -= I_O;
        if (r < I_1) { p0_transpose_item(a.in[13], DM, DFF, (bf16*)(ws + WS_WFF1), a.in[12], scr, r, lane); continue; } r -= I_1;
        p0_transpose_item(a.in[14], DFF, DM, (bf16*)(ws + WS_WFF2), nullptr, scr, r, lane);
    }
}

template <int DV> __device__ __forceinline__ void naive_row(const bf16* q, const bf16* Kb, const bf16* Vb, size_t kstride, int nkeys, LAS float* qs, LAS float* ps, float (&o)[DV / 64], float& lse, int lane) {
    constexpr int NC = DV / 64;
    { const unsigned w = *(const unsigned*)(q + 2 * lane); qs[2 * lane] = bflo(w); qs[2 * lane + 1] = bfhi(w); }
    LDS_WAIT(); asm volatile("" ::: "memory");
    float m = -1e30f, l = 0.f;
#pragma unroll
    for (int c = 0; c < NC; ++c) o[c] = 0.f;
    for (int c0 = 0; c0 < nkeys; c0 += 64) {
        const int j = c0 + lane; const bool valid = j < nkeys;
        float s = -__builtin_inff();
        if (valid) { const v4u* kp = (const v4u*)(Kb + (size_t)j * kstride); float acc = 0.f;
#pragma unroll 4
            for (int d = 0; d < 16; ++d) { const v4u kv = kp[d]; const LAS float* qq = qs + 8 * d;
                acc += bflo(kv.x) * qq[0] + bfhi(kv.x) * qq[1] + bflo(kv.y) * qq[2] + bfhi(kv.y) * qq[3] + bflo(kv.z) * qq[4] + bfhi(kv.z) * qq[5] + bflo(kv.w) * qq[6] + bfhi(kv.w) * qq[7]; }
            s = acc * ATT_SCALE; }
        const float mn = fmaxf(m, wave_max(s));
        const float p = valid ? __expf(s - mn) : 0.f;
        const float alpha = __expf(m - mn);
        l = l * alpha + wave_sum(p); m = mn;
#pragma unroll
        for (int c = 0; c < NC; ++c) o[c] *= alpha;
        ps[lane] = p; LDS_WAIT(); asm volatile("" ::: "memory");
        const int cnt = (nkeys - c0) < 64 ? (nkeys - c0) : 64;
        const bf16* vp = Vb + (size_t)c0 * kstride + lane * NC;
#pragma unroll 4
        for (int kk = 0; kk < cnt; ++kk) { const float pj = ps[kk];
            if constexpr (NC == 2) { const unsigned w = *(const unsigned*)(vp + (size_t)kk * kstride); o[0] += pj * bflo(w); o[1] += pj * bfhi(w); }
            else { const v2u w = *(const v2u*)(vp + (size_t)kk * kstride); o[0] += pj * bflo(w.x); o[1] += pj * bfhi(w.x); o[NC - 2] += pj * bflo(w.y); o[NC - 1] += pj * bfhi(w.y); } }
        LDS_WAIT(); asm volatile("" ::: "memory");
    }
    const float inv = 1.f / l;
#pragma unroll
    for (int c = 0; c < NC; ++c) o[c] *= inv;
    lse = m + __logf(l);
}
__device__ __forceinline__ void p2_attention_naive(const Args& a, LAS unsigned char* L, int gw, int NGW, int wave, int lane) {
    unsigned char* ws = a.ws;
    LAS float* qs = (LAS float*)(L + wave * 1024); LAS float* ps = qs + 128;
    const bf16* QA = (const bf16*)(ws + WS_QA); const bf16* KA = (const bf16*)(ws + WS_KA); const bf16* VA = (const bf16*)(ws + WS_VA);
    const bf16* QB = (const bf16*)(ws + WS_QB); const bf16* KB = (const bf16*)(ws + WS_KB); const bf16* VB = (const bf16*)(ws + WS_VB);
    float* OA = (float*)(ws + WS_OA); float* OB = (float*)(ws + WS_OB); float* LSE = (float*)(ws + WS_LSE);
    for (int it = gw; it < SEQ * 12; it += NGW) {
        const int t = it / 12, ah = it - t * 12, g = ah >> 2, r = (g == 0) ? 1 : (g == 1) ? 4 : 16;
        const int i = t / r, rho = t - i * r, i0 = (i - 128) > 0 ? (i - 128) : 0, nkeys = i - i0 + 1;
        const size_t first = (size_t)(rho + r * i0) * 1536 + ah * 128;
        float o[2]; float lse;
        naive_row<128>(QA + (size_t)t * 1536 + ah * 128, KA + first, VA + first, (size_t)r * 1536, nkeys, qs, ps, o, lse, lane);
        float* op = OA + ((size_t)g * SEQ + t) * 512 + (ah & 3) * 128 + lane * 2; op[0] = o[0]; op[1] = o[1];
        if (lane == 0) LSE[((size_t)g * SEQ + t) * 4 + (ah & 3)] = lse;
    }
    for (int it = gw; it < SEQ * 16; it += NGW) {
        const int t = it >> 4, hi = it & 15;
        float o[4]; float lse;
        naive_row<256>(QB + (size_t)t * 2048 + hi * 128, KB + hi * 128, VB + (hi >> 1) * 256, (size_t)2048, t + 1, qs, ps, o, lse, lane);
        *(f32x4*)(OB + (size_t)t * 4096 + hi * 256 + lane * 4) = (f32x4){o[0], o[1], o[2], o[3]};
    }
}
__device__ __forceinline__ void p2_make_block(unsigned char* ws, int vcu, int k, swa::BlockRef& b) {
    if (k < 4) {
        const int item = vcu + 256 * (k >> 1), vh = item >> 4, x = item & 15, hi = vh >> 1, vhalf = vh & 1, qb = (k & 1) ? 31 - x : x;
        b.Q = (const swa::bf16*)(ws + WS_QB) + (size_t)(qb * 256) * 2048 + hi * 128; b.K = (const swa::bf16*)(ws + WS_KB) + hi * 128; b.V = (const swa::bf16*)(ws + WS_VB) + (hi >> 1) * 256 + vhalf * 128;
        b.O = (float*)(ws + WS_OB) + (size_t)(qb * 256) * 4096 + hi * 256 + vhalf * 128; b.L = nullptr;
        b.P0 = qb * 256; b.qp = 2048; b.kp = 2048; b.op = 4096; b.lp = 0; b.skv = SEQ; b.W = 1 << 20;
    } else {
        const int ab = vcu + 256 * (k - 4), g = ab >> 7, idx = ab & 127, hg = idx >> 5, rem = idx & 31;
        const int r = (g == 0) ? 1 : (g == 1) ? 4 : 16, rho = (g == 0) ? 0 : (g == 1) ? (rem >> 3) : (rem >> 1), qb = (g == 0) ? rem : (g == 1) ? (rem & 7) : (rem & 1), ah = g * 4 + hg;
        const size_t row0 = (size_t)rho + (size_t)r * (qb * 256);
        b.Q = (const swa::bf16*)(ws + WS_QA) + row0 * 1536 + ah * 128; b.K = (const swa::bf16*)(ws + WS_KA) + (size_t)rho * 1536 + ah * 128; b.V = (const swa::bf16*)(ws + WS_VA) + (size_t)rho * 1536 + ah * 128;
        b.O = (float*)(ws + WS_OA) + ((size_t)g * SEQ + row0) * 512 + hg * 128; b.L = (float*)(ws + WS_LSE) + ((size_t)g * SEQ + row0) * 4 + hg;
        b.P0 = qb * 256; b.qp = r * 1536; b.kp = r * 1536; b.op = r * 512; b.lp = r * 4; b.skv = SEQ / r; b.W = 129;
    }
}
__device__ __forceinline__ void p2_attention_mfma(unsigned char* ws, char* lds, int vcu, int reps) {
    swa::Seam S; swa::BlockRef cur, nxt;
    const int nb1 = (vcu < 128) ? 6 : 5, nblk = nb1 * reps;
    p2_make_block(ws, vcu, 0, cur);
    swa::causal_swa_prime(cur, lds, S);
    for (int k = 0; k < nblk; ++k) {
        if (k + 1 < nblk) p2_make_block(ws, vcu, (k + 1) % nb1, nxt); else nxt = cur;
        swa::causal_swa_block(cur, nxt, lds, S);
        cur = nxt;
    }
}
__device__ __forceinline__ void p3_combine(const Args& a, int gw, int NGW, int lane) {
    unsigned char* ws = a.ws;
    const float* OA = (const float*)(ws + WS_OA); const float* OB = (const float*)(ws + WS_OB); const float* LSE = (const float*)(ws + WS_LSE);
    bf16* YA = (bf16*)(ws + WS_YA); bf16* YB = (bf16*)(ws + WS_YB);
    float d1 = a.in[7][lane] * a.in[8][lane] + a.in[7][lane + 64] * a.in[8][lane + 64];
    float d2 = a.in[9][lane] * a.in[10][lane] + a.in[9][lane + 64] * a.in[10][lane + 64];
    d1 = wave_sum(d1); d2 = wave_sum(d2);
    const float lam_init = 0.2f;
    const float lam = expf(d1) - expf(d2) + lam_init;
    const f32x4 sg = *(const f32x4*)(a.in[11] + lane * 4);
    for (int t = gw; t < SEQ; t += NGW) {
        { const int hg = lane >> 4;
          const float l0 = LSE[((size_t)0 * SEQ + t) * 4 + hg], l1 = LSE[((size_t)1 * SEQ + t) * 4 + hg], l2 = LSE[((size_t)2 * SEQ + t) * 4 + hg];
          const float mx = fmaxf(l0, fmaxf(l1, l2)); const float e0 = expf(l0 - mx), e1 = expf(l1 - mx), e2 = expf(l2 - mx); const float inv = 1.f / (e0 + e1 + e2);
          const float a0 = e0 * inv, a1 = e1 * inv, a2 = e2 * inv;
          const f32x4* p0 = (const f32x4*)(OA + ((size_t)0 * SEQ + t) * 512 + lane * 8); const f32x4* p1 = (const f32x4*)(OA + ((size_t)1 * SEQ + t) * 512 + lane * 8); const f32x4* p2 = (const f32x4*)(OA + ((size_t)2 * SEQ + t) * 512 + lane * 8);
          const f32x4 x0 = p0[0] * a0 + p1[0] * a1 + p2[0] * a2, x1 = p0[1] * a0 + p1[1] * a1 + p2[1] * a2;
          v4u w; w.x = pk2(x0.x, x0.y); w.y = pk2(x0.z, x0.w); w.z = pk2(x1.x, x1.y); w.w = pk2(x1.z, x1.w);
          *(v4u*)(YA + (size_t)t * 512 + lane * 8) = w; }
#pragma unroll 2
        for (int h = 0; h < 8; ++h) {
            const f32x4 o1 = *(const f32x4*)(OB + (size_t)t * 4096 + (2 * h) * 256 + lane * 4), o2 = *(const f32x4*)(OB + (size_t)t * 4096 + (2 * h + 1) * 256 + lane * 4);
            const f32x4 d = o1 - o2 * lam;
            const float ss = wave_sum((d.x * d.x + d.y * d.y) + (d.z * d.z + d.w * d.w));
            const float rstd = rsqrtf(ss * (1.f / 256.f) + RMS_EPS) * (1.f - lam_init);
            const f32x4 y = d * rstd * sg;
            v2u w; w.x = pk2(y.x, y.y); w.y = pk2(y.z, y.w);
            *(v2u*)(YB + (size_t)t * 2048 + h * 256 + lane * 4) = w;
        }
    }
}

__global__ void __launch_bounds__(NWAVES * 64, 2) fwd(Args args) {
    extern __shared__ __attribute__((aligned(16))) unsigned char lds[];
    LAS unsigned char* L = (LAS unsigned char*)lds;
    volatile LAS unsigned* MISC = (volatile LAS unsigned*)(L + MISC_OFF);
    const int tid = threadIdx.x, lane = tid & 63, wave = __builtin_amdgcn_readfirstlane(tid >> 6);
    const int G = gridDim.x, bx = blockIdx.x;
    const int vcu = (G % 8 == 0) ? (bx % 8) * (G / 8) + bx / 8 : bx;
    const int gw = vcu * NWAVES + wave, NGW = G * NWAVES;
    unsigned char* ws = args.ws;
    gu32* ctl = (gu32*)(ws + WS_CTL);
    for (int u = tid; u < (LDS_BYTES - LDSCTL_OFF) / 4; u += NWAVES * 64) ((LAS unsigned*)(L + LDSCTL_OFF))[u] = 0u;
    __syncthreads();
    const int lo = args.ph_lo, hi = args.ph_hi;
    const bool multi = (hi - lo) > 1;
    XcdBarrier bar; bar.bar = (unsigned*)(ctl + CW_BAR); bar.x = 0; bar.st = nullptr;
    if (multi) bar = xcd_barrier_post((unsigned*)(ctl + CW_BAR), MISC + 8);
#ifdef SELFTEST
    if (lo >= 16) { selftest(lo - 16, args, gw, NGW, lane); return; }
#endif
#define IN(k) (lo <= (k) && (k) < hi)
#ifdef SELFTEST
#define SEAM(k) do { if (IN(k) && IN((k) + 1)) { xcd_barrier(bar); selftest((k), args, gw, NGW, lane); xcd_barrier(bar); } } while (0)
#else
#define SEAM(k) do { if (IN(k) && IN((k) + 1)) xcd_barrier(bar); } while (0)
#endif

#ifndef PROBE_REPEAT
#define PROBE_REPEAT -1
#endif
#define NREP(k) ((PROBE_REPEAT == (k)) ? 2 : 1)
    if (IN(0)) { for (int rep_ = 0; rep_ < NREP(0); ++rep_) p0_prologue(args, L, gw, NGW, wave, lane); SEAM(0); }

    if (IN(1)) {
        pg8::Gemm g{(const bf16*)(ws + WS_H), (const bf16*)(ws + WS_WIN), SEQ, NIN, DM}; pg8::StaticOrder S; S.init(SEQ, NIN, G, bx); S.rep = NREP(1);
        pg8::EpiProj E{ws, args.in[3]};
        pg8::gemm_phase<pg8::EpiProj, pg8::StaticOrder, true, true>(L, g, S, E);
        { const int extra = ((SEQ / 256) * (NIN / 256)) % G;
          if (bx >= extra) p0_convert_rest(args, L, (bx - extra) * NWAVES + wave, (G - extra) * NWAVES, wave, lane); }
        SEAM(1);
    }
#ifdef NAIVE_ATTN
    if (IN(2)) { p2_attention_naive(args, L, gw, NGW, wave, lane); SEAM(2); }
#else
    if (IN(2)) { p2_attention_mfma(ws, (char*)lds, vcu, NREP(2)); SEAM(2); }
#endif
    if (IN(3)) { p3_combine(args, gw, NGW, lane); SEAM(3); }
    if (IN(4)) {
        { pg8::Gemm g{(const bf16*)(ws + WS_YA), (const bf16*)(ws + WS_WA), SEQ, DM, 512}; pg8::StaticOrder S; S.init(SEQ, DM, G, bx);
          pg8::EpiGate<false> E{(const bf16*)(ws + WS_GA), nullptr, (bf16*)(ws + WS_T)};
          pg8::gemm_phase<pg8::EpiGate<false>, pg8::StaticOrder, true, true>(L, g, S, E); }
        VM_WAIT(); __syncthreads();
        { pg8::Gemm g{(const bf16*)(ws + WS_YB), (const bf16*)(ws + WS_WB), SEQ, DM, 2048}; pg8::StaticOrder S; S.init(SEQ, DM, G, bx);
          pg8::EpiGate<true> E{(const bf16*)(ws + WS_GB), (const bf16*)(ws + WS_T), (bf16*)(ws + WS_MG)};
          pg8::gemm_phase<pg8::EpiGate<true>, pg8::StaticOrder, true, true>(L, g, S, E); }
        SEAM(4);
    }
    if (IN(5)) {
        pg8::Gemm g{(const bf16*)(ws + WS_MG), (const bf16*)(ws + WS_WOUT), SEQ, DM, DM}; pg8::StaticOrder S; S.init(SEQ, DM, G, bx); S.rep = NREP(5);
        pg8::EpiResid<true> E{args.in[0], args.out, (bf16*)(ws + WS_H), (float*)(ws + WS_RSS)};
        pg8::gemm_phase<pg8::EpiResid<true>, pg8::StaticOrder, true, true>(L, g, S, E);
        SEAM(5);
    }
    if (IN(6)) {
        pg8::Gemm g{(const bf16*)(ws + WS_H), (const bf16*)(ws + WS_WFF1), SEQ, DFF, DM}; pg8::StaticOrder S; S.init(SEQ, DFF, G, bx); S.rep = NREP(6);
        pg8::Unit u0, ui; u0.pm = 0; u0.pn = 0; bool same = S.next(0, u0);
        for (int i = 1; S.next(i, ui); ++i) same = same && (ui.pm == u0.pm);
        if (same) {
            LAS float* rtab = (LAS float*)(L + RTAB_OFF);
            { const int row = tid >> 1, half = tid & 1; const f32x4* rp = (const f32x4*)((const float*)(ws + WS_RSS) + ((size_t)u0.pm * 256 + row) * 64 + half * 32); float t = 0.f;
#pragma unroll
              for (int j = 0; j < 8; ++j) { const f32x4 v = rp[j]; t += (v.x + v.y) + (v.z + v.w); }
              t += __shfl_xor(t, 1);
              if (half == 0) rtab[row] = rsqrtf(t * (1.0f / DM) + RMS_EPS); }
            __syncthreads();
            pg8::EpiRelu2<true> E{(bf16*)(ws + WS_U2), nullptr, rtab};
            pg8::gemm_phase<pg8::EpiRelu2<true>, pg8::StaticOrder, true, true>(L, g, S, E);
        } else {
            pg8::EpiRelu2<false> E{(bf16*)(ws + WS_U2), (const float*)(ws + WS_RSS), nullptr};
            pg8::gemm_phase<pg8::EpiRelu2<false>, pg8::StaticOrder, true, true>(L, g, S, E);
        }
        SEAM(6);
    }
    if (IN(7)) {
        pg8::Gemm g{(const bf16*)(ws + WS_U2), (const bf16*)(ws + WS_WFF2), SEQ, DM, DFF}; pg8::StaticOrder S; S.init(SEQ, DM, G, bx);
        pg8::EpiResid<false> E{args.out, args.out, nullptr, nullptr};
        pg8::gemm_phase<pg8::EpiResid<false>, pg8::StaticOrder, true, true>(L, g, S, E);
        SEAM(7);
    }
    if (IN(8)) {
#ifdef SELFTEST
        const unsigned f = __hip_atomic_load((unsigned*)ctl + CW_FLAG, RLX_AGENT) & ~(unsigned)(SELFTEST_IGNORE);
        if (f) { const unsigned f2 = __hip_atomic_load((unsigned*)ctl + CW_FLAG2, RLX_AGENT), nf = __hip_atomic_load((unsigned*)ctl + CW_FLAG2 + 1, RLX_AGENT), nt = __hip_atomic_load((unsigned*)ctl + CW_FLAG2 + 2, RLX_AGENT);
            const float cv1 = f2 ? (float)f2 : (float)__builtin_ctz(f), cv2 = nt ? 1.f + (float)((nf * 30u) / nt) : 0.f;
            for (int m = gw; m < SEQ; m += NGW) for (int c = lane; c < DM; c += 64) args.out[(size_t)m * DM + c] = (m < SEQ / 2) ? cv1 : cv2; }
        else
#endif
        for (int m = gw; m < SEQ; m += NGW) rms_row<false>(args.out + (size_t)m * DM, args.in[15], args.out + (size_t)m * DM, lane);
    }
#undef IN
#undef SEAM
}

extern "C" void kernel_launch(void* const* d_in, const int* in_sizes, int n_in, void* d_out, int out_size, void* d_ws, size_t ws_size, hipStream_t stream) {
    static int grid = 0;
    if (grid == 0) {
        if (n_in != 16 || in_sizes[0] != SEQ * DM || out_size != SEQ * DM || ws_size < WS_END) { fprintf(stderr, "kernel_launch: shape/workspace mismatch (n_in %d, in0 %d, out %d, ws %zu, need %zu); nothing launched\n", n_in, n_in > 0 ? in_sizes[0] : -1, out_size, ws_size, (size_t)WS_END); grid = -1; return; }
        int dev = 0, cus = 0;
        if (hipGetDevice(&dev) != hipSuccess || hipDeviceGetAttribute(&cus, hipDeviceAttributeMultiprocessorCount, dev) != hipSuccess) { grid = -1; return; }
        if (hipFuncSetAttribute((const void*)fwd, hipFuncAttributeMaxDynamicSharedMemorySize, LDS_BYTES) != hipSuccess) { fprintf(stderr, "kernel_launch: hipFuncSetAttribute failed\n"); grid = -1; return; }
        (void)hipGetLastError();
        grid = cus;
    }
    if (grid < 0) return;
    if (hipMemsetAsync((char*)d_ws + WS_CTL, 0, CTL_ZERO_BYTES, stream) != hipSuccess) return;
    Args a{};
    for (int i = 0; i < 16; ++i) a.in[i] = (const float*)d_in[i];
    a.out = (float*)d_out; a.ws = (unsigned char*)d_ws;
    constexpr int NL = MK_N_LAUNCHES;
    static_assert(NL == 1 || NL == N_PHASES, "MK_N_LAUNCHES is 1 or N_PHASES");
    for (int li = 0; li < NL; ++li) {
        a.ph_lo = (NL == 1) ? 0 : li; a.ph_hi = (NL == 1) ? N_PHASES : li + 1;
        hipLaunchKernelGGL(fwd, dim3(grid), dim3(NWAVES * 64), LDS_BYTES, stream, a);
        const hipError_t le = hipPeekAtLastError();
        if (le != hipSuccess) { fprintf(stderr, "kernel_launch: launch %d failed: %s\n", li, hipGetErrorName(le)); break; }
#ifdef SELFTEST
        if (NL == N_PHASES && li < 8) { Args c = a; c.ph_lo = 16 + li; c.ph_hi = 17 + li; hipLaunchKernelGGL(fwd, dim3(grid), dim3(NWAVES * 64), LDS_BYTES, stream, c); }
#endif
    }
}
```

```cpp
#include <hip/hip_runtime.h>
#include <cstdio>
#include <cstdint>
constexpr int SEQ = 8192, DM = 4096, NIN = 18944, DFF = 16384;
constexpr int NWAVES = 8;
constexpr float RMS_EPS = 1e-6f;
constexpr float ATT_SCALE = 0.08838834764831845f;
constexpr int N_PHASES = 9;
#ifndef MK_N_LAUNCHES
#define MK_N_LAUNCHES 1
#endif
constexpr size_t MiB = 1u << 20;
constexpr size_t WS_CTL = 0, CTL_ZERO_BYTES = 1 * MiB;
constexpr size_t WS_WIN = 1 * MiB;
constexpr size_t WS_WA = 149 * MiB;
constexpr size_t WS_WB = 153 * MiB;
constexpr size_t WS_WOUT = 169 * MiB;
constexpr size_t WS_WFF1 = 201 * MiB;
constexpr size_t WS_WFF2 = 329 * MiB;
constexpr size_t WS_H = 457 * MiB;
constexpr size_t WS_YA = 521 * MiB;
constexpr size_t WS_YB = 529 * MiB;
constexpr size_t WS_T = 561 * MiB;
constexpr size_t WS_MG = 625 * MiB;
constexpr size_t WS_RSS = 689 * MiB;
constexpr size_t WS_LSE = 691 * MiB;
constexpr size_t WS_R1 = 692 * MiB;
constexpr size_t WS_QA = WS_R1, WS_KA = WS_R1 + 24 * MiB, WS_VA = WS_R1 + 48 * MiB;
constexpr size_t WS_QB = WS_R1 + 72 * MiB, WS_KB = WS_R1 + 104 * MiB, WS_VB = WS_R1 + 136 * MiB;
constexpr size_t WS_GA = WS_R1 + 168 * MiB, WS_GB = WS_R1 + 232 * MiB;
constexpr size_t WS_OA = WS_R1 + 296 * MiB;
constexpr size_t WS_OB = WS_R1 + 344 * MiB;
constexpr size_t WS_U2 = WS_R1;
constexpr size_t WS_END = WS_R1 + 472 * MiB;
constexpr int CW_BAR = 4096;
constexpr int RING_BYTES = 131072, LDSCTL_OFF = RING_BYTES, MISC_OFF = LDSCTL_OFF + 320, PTAB_OFF = LDSCTL_OFF + 512, RTAB_OFF = LDSCTL_OFF + 1024, LDS_BYTES = 147456;
namespace pg8 {
#define PG8_LAS __attribute__((address_space(3)))
typedef unsigned short bf16_t;
typedef short bf16x8 __attribute__((ext_vector_type(8)));
typedef float f32x4 __attribute__((ext_vector_type(4)));
typedef unsigned u32x4 __attribute__((ext_vector_type(4)));
constexpr int BM = 256, BK = 64, HALF = 128, HTB = HALF * BK * 2  , STAGE_BYTES = 8 * HTB, NXCD = 8, WGM = 8;

__host__ __device__ __forceinline__ int lds_byte(int r, int c) { const int st = (r >> 4) * 2 + (c >> 5), rr = r & 15, cc = c & 31, ob = rr * 64 + cc * 2; return st * 1024 + (ob ^ (((ob >> 9) & 1) << 5)); }
__host__ __device__ __forceinline__ void stage_rc(int b, int& R, int& C) { const int st = b / 1024, sb = b % 1024, swz = sb ^ (((sb >> 9) & 1) << 5); R = (st >> 1) * 16 + swz / 64; C = (st & 1) * 32 + (swz % 64) / 2; }
__host__ __device__ __forceinline__ int perm32(int rho) { const int n = rho >> 4, i = rho & 15; return 8 * (i >> 2) + 4 * n + (i & 3); }

struct Unit { int pm, pn; };
struct Gemm { const bf16_t* A; const bf16_t* Bt; int M, N, K; };

struct StaticOrder {
    int nM, nN, nwg, G, c, rep;
    __host__ __device__ void init(int M, int N, int G_, int c_) { nM = M / BM; nN = N / BM; nwg = nM * nN; G = G_; c = c_; rep = 1; }
    __host__ __device__ bool next(int i, Unit& u) const {
        if (rep > 1) { const int per = (nwg - c + G - 1) / G; if (i >= per * rep) return false; i = i % per; }
        const long L = (long)i * G + c; if (L >= nwg) return false;
        int wgid = (int)L; { const int q = nwg / NXCD, r = nwg % NXCD, xcd = wgid % NXCD, off = wgid / NXCD; wgid = (xcd < r ? xcd * (q + 1) : r * (q + 1) + (xcd - r) * q) + off; }
        const int nig = WGM * nN, gid = wgid / nig, fm = gid * WGM, gsz = (nM - fm) < WGM ? (nM - fm) : WGM;
        u.pm = fm + ((wgid % nig) % gsz); u.pn = (wgid % nig) / gsz; return true;
    }
    __device__ __forceinline__ void a_ready(const Unit&) const {}
    __device__ __forceinline__ void done(const Unit&) const {}
};

typedef float f32x2c_t __attribute__((ext_vector_type(2))); typedef __bf16 bf16x2c_t __attribute__((ext_vector_type(2)));
__device__ __forceinline__ unsigned cvt_pk_bf16(float lo, float hi) { const f32x2c_t v = {lo, hi}; const bf16x2c_t b = __builtin_convertvector(v, bf16x2c_t); return __builtin_bit_cast(unsigned, b); }
typedef float f32x2 __attribute__((ext_vector_type(2)));
template <class Epi, class Sched, bool ALIGN_EPI = false, bool SP2 = false>
__device__ __forceinline__ void gemm_phase(PG8_LAS unsigned char* lds, const Gemm g, const Sched& S, const Epi& E) {
    const int tid = threadIdx.x, wid = __builtin_amdgcn_readfirstlane(tid >> 6), lane = tid & 63, wr = wid >> 2, wc = wid & 3, fr = lane & 15, fq = lane >> 4;
    const int K = g.K, nt = K / BK;
    unsigned voffA[2], voffB[2];
#pragma unroll
    for (int i = 0; i < 2; ++i) { int R, C; stage_rc(tid * 16 + i * 8192, R, C); const int Rb = Epi::PERM ? ((R & ~31) + perm32(R & 31)) : R;
        voffA[i] = (unsigned)(R * K + C) * 2u; voffB[i] = (unsigned)(Rb * K + C) * 2u; }
    const size_t kstep = (size_t)(BK * 2);
    const size_t hstep = (size_t)HALF * K * 2;
    const size_t tstep = 2 * hstep;
    const unsigned ldsw = (unsigned)wid * 1024u;
    const int aoff = lds_byte(wr * 64 + fr, fq * 8), boff = lds_byte(wc * 32 + fr, fq * 8);
#define PG8_SA(b, h) (((b) * 2 + (h)) * HTB)
#define PG8_SB(b, h) ((4 + (b) * 2 + (h)) * HTB)
#define PG8_STAGE(bufoff, gbase, voff) do { _Pragma("unroll") for (int _i = 0; _i < 2; ++_i) \
        __builtin_amdgcn_global_load_lds((const unsigned*)((const char*)(gbase) + (voff)[_i]), (PG8_LAS unsigned*)(lds + (bufoff) + ldsw + _i * 8192), 16, 0, 0); } while (0)
#define PG8_LDA(dst, b, h) do { _Pragma("unroll") for (int m = 0; m < 4; ++m) _Pragma("unroll") for (int k = 0; k < 2; ++k) dst[m][k] = *(const PG8_LAS bf16x8*)(lds + PG8_SA(b, h) + aoff + m * 2048 + k * 1024); } while (0)
#define PG8_LDB(dst, b, h) do { _Pragma("unroll") for (int n = 0; n < 2; ++n) _Pragma("unroll") for (int k = 0; k < 2; ++k) dst[n][k] = *(const PG8_LAS bf16x8*)(lds + PG8_SB(b, h) + boff + n * 2048 + k * 1024); } while (0)
#define PG8_MMA(ai, bj, At, Bt) do { __builtin_amdgcn_s_setprio(1); _Pragma("unroll") for (int m = 0; m < 4; ++m) _Pragma("unroll") for (int n = 0; n < 2; ++n) _Pragma("unroll") for (int k = 0; k < 2; ++k) \
        acc[ai][bj][m][n] = __builtin_amdgcn_mfma_f32_16x16x32_bf16(Bt[n][k], At[m][k], acc[ai][bj][m][n], 0, 0, 0); __builtin_amdgcn_s_setprio(0); } while (0)
#define PG8_WAIT_V(n) asm volatile("s_waitcnt vmcnt(" #n ")" ::: "memory")
#define PG8_WAIT_L(n) asm volatile("s_waitcnt lgkmcnt(" #n ")" ::: "memory")
#define PG8_BAR __builtin_amdgcn_s_barrier()
#define PG8_SCHED __builtin_amdgcn_sched_barrier(0)
    Unit cur, nxt; int ui = 0;
    if (!S.next(0, cur)) return;
    f32x4 acc[2][2][4][2];
#pragma unroll
    for (int a = 0; a < 2; ++a)
#pragma unroll
        for (int b = 0; b < 2; ++b)
#pragma unroll
            for (int m = 0; m < 4; ++m)
#pragma unroll
                for (int n = 0; n < 2; ++n) acc[a][b][m][n] = (f32x4){0.f, 0.f, 0.f, 0.f};
    bf16x8 At[4][2], B0[2][2], B1[2][2];
    const char* cA = (const char*)g.A + (size_t)cur.pm * tstep; const char* cB = (const char*)g.Bt + (size_t)cur.pn * tstep;
    S.a_ready(cur);
    if constexpr (SP2) {
        PG8_STAGE(PG8_SB(0, 0), cB, voffB); PG8_STAGE(PG8_SB(0, 1), cB + hstep, voffB); PG8_STAGE(PG8_SA(0, 0), cA, voffA); PG8_STAGE(PG8_SA(0, 1), cA + hstep, voffA);
        if (wr == 1) PG8_BAR;
        PG8_WAIT_V(2); PG8_BAR;
        PG8_STAGE(PG8_SB(1, 0), cB + kstep, voffB); PG8_STAGE(PG8_SA(1, 0), cA + kstep, voffA); PG8_STAGE(PG8_SB(1, 1), cB + hstep + kstep, voffB);
        PG8_WAIT_V(6); PG8_BAR;
    } else {
        PG8_STAGE(PG8_SB(0, 0), cB, voffB); PG8_STAGE(PG8_SA(0, 0), cA, voffA); PG8_STAGE(PG8_SB(0, 1), cB + hstep, voffB); PG8_STAGE(PG8_SA(0, 1), cA + hstep, voffA);
        if (wr == 1) PG8_BAR;
        PG8_WAIT_V(4); PG8_BAR;
        PG8_STAGE(PG8_SB(1, 0), cB + kstep, voffB); PG8_STAGE(PG8_SA(1, 0), cA + kstep, voffA); PG8_STAGE(PG8_SB(1, 1), cB + hstep + kstep, voffB);
        PG8_WAIT_V(6); PG8_BAR;
    }
    for (;;) {
        const bool has_next = S.next(ui + 1, nxt);
        const char* nA = has_next ? (const char*)g.A + (size_t)nxt.pm * tstep : cA; const char* nB = has_next ? (const char*)g.Bt + (size_t)nxt.pn * tstep : cB;
        for (int t = 0; t < nt; t += 2) {
            const bool last = (t == nt - 2);
            const char* a1 = cA + (size_t)(t + 1) * kstep;
            const char* a2 = last ? nA : cA + (size_t)(t + 2) * kstep; const char* b2 = last ? nB : cB + (size_t)(t + 2) * kstep;
            const char* a3 = a2 + kstep; const char* b3 = b2 + kstep;
            if (last && has_next) S.a_ready(nxt);
            if constexpr (SP2) {
            PG8_LDB(B0, 0, 0); PG8_LDB(B1, 0, 1); PG8_SCHED; PG8_LDA(At, 0, 0); PG8_STAGE(PG8_SA(1, 1), a1 + hstep, voffA);
            PG8_WAIT_V(8); PG8_WAIT_L(0); PG8_BAR; PG8_MMA(0, 0, At, B0); PG8_MMA(0, 1, At, B1); PG8_BAR; PG8_SCHED;
            PG8_LDA(At, 0, 1); PG8_STAGE(PG8_SB(0, 0), b2, voffB); PG8_STAGE(PG8_SB(0, 1), b2 + hstep, voffB); PG8_STAGE(PG8_SA(0, 0), a2, voffA);
            PG8_WAIT_V(8); PG8_WAIT_L(0); PG8_BAR; PG8_MMA(1, 0, At, B0); PG8_MMA(1, 1, At, B1); PG8_BAR; PG8_SCHED;
            PG8_LDB(B0, 1, 0); PG8_LDB(B1, 1, 1); PG8_SCHED; PG8_LDA(At, 1, 0); PG8_STAGE(PG8_SA(0, 1), a2 + hstep, voffA);
            PG8_WAIT_V(8); PG8_WAIT_L(0); PG8_BAR; PG8_MMA(0, 0, At, B0); PG8_MMA(0, 1, At, B1); PG8_BAR; PG8_SCHED;
            PG8_LDA(At, 1, 1); PG8_STAGE(PG8_SB(1, 0), b3, voffB); PG8_STAGE(PG8_SB(1, 1), b3 + hstep, voffB); PG8_STAGE(PG8_SA(1, 0), a3, voffA);
            PG8_WAIT_V(8); PG8_WAIT_L(0); PG8_BAR; PG8_MMA(1, 0, At, B0); PG8_MMA(1, 1, At, B1); PG8_BAR; PG8_SCHED;
            } else {
            PG8_LDB(B0, 0, 0); PG8_SCHED; PG8_LDA(At, 0, 0); PG8_STAGE(PG8_SA(1, 1), a1 + hstep, voffA);
            PG8_WAIT_L(8); PG8_BAR; PG8_WAIT_L(0); PG8_MMA(0, 0, At, B0); PG8_BAR; PG8_SCHED;
            PG8_LDB(B1, 0, 1); PG8_STAGE(PG8_SB(0, 0), b2, voffB);
            PG8_BAR; PG8_WAIT_L(0); PG8_MMA(0, 1, At, B1); PG8_BAR;
            PG8_LDA(At, 0, 1); PG8_STAGE(PG8_SA(0, 0), a2, voffA);
            PG8_BAR; PG8_WAIT_L(0); PG8_MMA(1, 0, At, B0); PG8_BAR; PG8_SCHED;
            PG8_STAGE(PG8_SB(0, 1), b2 + hstep, voffB);
            PG8_WAIT_V(6); PG8_BAR; PG8_MMA(1, 1, At, B1); PG8_BAR;
            PG8_LDB(B0, 1, 0); PG8_SCHED; PG8_LDA(At, 1, 0); PG8_STAGE(PG8_SA(0, 1), a2 + hstep, voffA);
            PG8_WAIT_L(8); PG8_BAR; PG8_WAIT_L(0); PG8_MMA(0, 0, At, B0); PG8_BAR; PG8_SCHED;
            PG8_LDB(B1, 1, 1); PG8_STAGE(PG8_SB(1, 0), b3, voffB);
            PG8_BAR; PG8_WAIT_L(0); PG8_MMA(0, 1, At, B1); PG8_BAR;
            PG8_LDA(At, 1, 1); PG8_STAGE(PG8_SA(1, 0), a3, voffA);
            PG8_BAR; PG8_WAIT_L(0); PG8_MMA(1, 0, At, B0); PG8_BAR; PG8_SCHED;
            PG8_STAGE(PG8_SB(1, 1), b3 + hstep, voffB);
            PG8_WAIT_V(6); PG8_BAR; PG8_MMA(1, 1, At, B1); PG8_BAR;
            }
        }
        if constexpr (ALIGN_EPI) { if (wr == 0) PG8_BAR; }
        if constexpr (!Epi::AFTER_DRAIN) { E(acc, cur, wr, wc, fr, fq); S.done(cur); }
        if (!has_next) break;
#pragma unroll
        for (int a = 0; a < 2; ++a)
#pragma unroll
            for (int b = 0; b < 2; ++b)
#pragma unroll
                for (int m = 0; m < 4; ++m)
#pragma unroll
                    for (int n = 0; n < 2; ++n) acc[a][b][m][n] = (f32x4){0.f, 0.f, 0.f, 0.f};
        cur = nxt; cA = nA; cB = nB; ++ui;
        if constexpr (ALIGN_EPI) { if (wr == 1) PG8_BAR; }
    }
    PG8_WAIT_V(0);
    if constexpr (!ALIGN_EPI) { if (wr == 0) PG8_BAR; }
    PG8_BAR;
    if constexpr (Epi::AFTER_DRAIN) { E.fused(acc, cur, wr, wc, fr, fq, lds, wid, lane); S.done(cur); }
#undef PG8_SA
#undef PG8_SB
#undef PG8_STAGE
#undef PG8_LDA
#undef PG8_LDB
#undef PG8_MMA
#undef PG8_WAIT_V
#undef PG8_WAIT_L
#undef PG8_BAR
#undef PG8_SCHED
}
}
namespace pg8 {
__device__ __forceinline__ float bf_lo(unsigned u) { return __uint_as_float(u << 16); }
__device__ __forceinline__ float bf_hi(unsigned u) { return __uint_as_float(u & 0xffff0000u); }
__device__ __forceinline__ u32x4 pack8bf(const f32x4 v0, const f32x4 v1) { u32x4 w; w.x = cvt_pk_bf16(v0[0], v0[1]); w.y = cvt_pk_bf16(v0[2], v0[3]); w.z = cvt_pk_bf16(v1[0], v1[1]); w.w = cvt_pk_bf16(v1[2], v1[3]); return w; }
__device__ __forceinline__ float sigmoidf_(float x) { return __builtin_amdgcn_rcpf(1.0f + __builtin_amdgcn_exp2f(-1.4426950408889634f * x)); }

struct EpiProj {
    static constexpr bool PERM = true, AFTER_DRAIN = false;
    unsigned char* ws; const float* bgate;
    __device__ __forceinline__ void operator()(const f32x4 (&acc)[2][2][4][2], const Unit& u, int wr, int wc, int fr, int fq) const {
        const int pn = u.pn;
        size_t off; int ld, ct, mode, boff = 0;
        if (pn < 6)       { off = WS_QA; ld = 1536; ct = pn;      mode = 1; }
        else if (pn < 12) { off = WS_KA; ld = 1536; ct = pn - 6;  mode = 1; }
        else if (pn < 18) { off = WS_VA; ld = 1536; ct = pn - 12; mode = 0; }
        else if (pn < 26) { off = WS_QB; ld = 2048; ct = pn - 18; mode = 1; }
        else if (pn < 34) { off = WS_KB; ld = 2048; ct = pn - 26; mode = 1; }
        else if (pn < 42) { off = WS_VB; ld = 2048; ct = pn - 34; mode = 0; }
        else if (pn < 58) { off = WS_GA; ld = 4096; ct = pn - 42; mode = 2; boff = (pn - 42) * 256; }
        else              { off = WS_GB; ld = 4096; ct = pn - 58; mode = 2; boff = 4096 + (pn - 58) * 256; }
        bf16_t* dst = (bf16_t*)(ws + off);
        const int row0 = u.pm * BM + wr * 64 + fr, col0 = ct * 256 + wc * 32 + 8 * fq;
        if (mode == 2) {
            f32x4 bv[2][2];
#pragma unroll
            for (int bj = 0; bj < 2; ++bj)
#pragma unroll
                for (int n = 0; n < 2; ++n) bv[bj][n] = *(const f32x4*)(bgate + boff + wc * 32 + 8 * fq + bj * HALF + 4 * n);
#pragma unroll
            for (int ai = 0; ai < 2; ++ai)
#pragma unroll
                for (int m = 0; m < 4; ++m) { bf16_t* rowp = dst + (size_t)(row0 + ai * HALF + m * 16) * ld + col0;
#pragma unroll
                    for (int bj = 0; bj < 2; ++bj) { f32x4 v0 = acc[ai][bj][m][0] + bv[bj][0], v1 = acc[ai][bj][m][1] + bv[bj][1];
#pragma unroll
                        for (int i = 0; i < 4; ++i) { v0[i] = sigmoidf_(v0[i]); v1[i] = sigmoidf_(v1[i]); }
                        *(u32x4*)(rowp + bj * HALF) = pack8bf(v0, v1); } }
        } else if (mode == 1 && wc == 0) {
            const bool odd = (fq & 1) != 0, lo = fq < 2;
            float invf[2][4];
            invf[0][0] = odd ? 0.00141421356f : 1.0f;            invf[0][1] = odd ? 0.000622772437f : 0.440366596f;
            invf[0][2] = odd ? 0.000274248188f : 0.193922743f;   invf[0][3] = odd ? 0.000120769735f : 0.0853971019f;
            invf[1][0] = odd ? 5.31829573e-05f : 0.0376060307f;  invf[1][1] = odd ? 2.34199997e-05f : 0.0165604409f;
            invf[1][2] = odd ? 1.03133852e-05f : 0.00729266461f; invf[1][3] = odd ? 4.54167048e-06f : 0.00321144611f;
#pragma unroll
            for (int ai = 0; ai < 2; ++ai)
#pragma unroll
                for (int m = 0; m < 4; ++m) { const int row = row0 + ai * HALF + m * 16; const float pos = (float)row; bf16_t* rowp = dst + (size_t)row * ld + col0;
                    float cs[2][4], sn[2][4];
#pragma unroll
                    for (int n = 0; n < 2; ++n)
#pragma unroll
                        for (int i = 0; i < 4; ++i) { const float ang = pos * invf[n][i]; const float k = rintf(ang * 0.15915494309189535f);
                            float r = fmaf(-k, 6.2831855f, ang); r = fmaf(-k, -1.7484555e-07f, r); const float rev = r * 0.15915494309189535f;
                            cs[n][i] = __builtin_amdgcn_cosf(rev); sn[n][i] = lo ? -__builtin_amdgcn_sinf(rev) : __builtin_amdgcn_sinf(rev); }
#pragma unroll
                    for (int bj = 0; bj < 2; ++bj) { f32x4 v0 = acc[ai][bj][m][0], v1 = acc[ai][bj][m][1], o0, o1;
#pragma unroll
                        for (int i = 0; i < 4; ++i) { const float p0 = __shfl_xor(v0[i], 32), p1 = __shfl_xor(v1[i], 32);
                            o0[i] = v0[i] * cs[0][i] + p0 * sn[0][i]; o1[i] = v1[i] * cs[1][i] + p1 * sn[1][i]; }
                        *(u32x4*)(rowp + bj * HALF) = pack8bf(o0, o1); } }
        } else {
#pragma unroll
            for (int ai = 0; ai < 2; ++ai)
#pragma unroll
                for (int m = 0; m < 4; ++m) { bf16_t* rowp = dst + (size_t)(row0 + ai * HALF + m * 16) * ld + col0;
#pragma unroll
                    for (int bj = 0; bj < 2; ++bj) *(u32x4*)(rowp + bj * HALF) = pack8bf(acc[ai][bj][m][0], acc[ai][bj][m][1]); }
        }
    }
};
template <bool ADD> struct EpiGate {
    static constexpr bool PERM = true, AFTER_DRAIN = false;
    const bf16_t* G; const bf16_t* Tin; bf16_t* O;
    __device__ __forceinline__ void operator()(const f32x4 (&acc)[2][2][4][2], const Unit& u, int wr, int wc, int fr, int fq) const {
        const int row0 = u.pm * BM + wr * 64 + fr, col0 = u.pn * BM + wc * 32 + 8 * fq;
#pragma unroll
        for (int ai = 0; ai < 2; ++ai) {
            u32x4 gw[4][2], tw[4][2];
#pragma unroll
            for (int m = 0; m < 4; ++m)
#pragma unroll
                for (int bj = 0; bj < 2; ++bj) { const size_t idx = (size_t)(row0 + ai * HALF + m * 16) * DM + col0 + bj * HALF;
                    gw[m][bj] = *(const u32x4*)(G + idx); if (ADD) tw[m][bj] = *(const u32x4*)(Tin + idx); }
#pragma unroll
            for (int m = 0; m < 4; ++m)
#pragma unroll
                for (int bj = 0; bj < 2; ++bj) { const size_t idx = (size_t)(row0 + ai * HALF + m * 16) * DM + col0 + bj * HALF;
                    const u32x4 g = gw[m][bj];
                    f32x4 v0 = acc[ai][bj][m][0], v1 = acc[ai][bj][m][1];
                    v0[0] *= bf_lo(g.x); v0[1] *= bf_hi(g.x); v0[2] *= bf_lo(g.y); v0[3] *= bf_hi(g.y);
                    v1[0] *= bf_lo(g.z); v1[1] *= bf_hi(g.z); v1[2] *= bf_lo(g.w); v1[3] *= bf_hi(g.w);
                    if (ADD) { const u32x4 t = tw[m][bj];
                        v0[0] += bf_lo(t.x); v0[1] += bf_hi(t.x); v0[2] += bf_lo(t.y); v0[3] += bf_hi(t.y);
                        v1[0] += bf_lo(t.z); v1[1] += bf_hi(t.z); v1[2] += bf_lo(t.w); v1[3] += bf_hi(t.w); }
                    *(u32x4*)(O + idx) = pack8bf(v0, v1); }
            asm volatile("" ::: "memory"); }
    }
};
template <bool STATS> struct EpiResid {
    static constexpr bool PERM = false, AFTER_DRAIN = false;
    const float* base; float* out; bf16_t* xb; float* rss;
    __device__ __forceinline__ void operator()(const f32x4 (&acc)[2][2][4][2], const Unit& u, int wr, int wc, int fr, int fq) const {
        typedef unsigned u32x2v __attribute__((ext_vector_type(2)));
        const int col0 = u.pn * BM + wc * 32 + 4 * fq;
#pragma unroll
        for (int ai = 0; ai < 2; ++ai) {
            f32x4 bs[4][2][2];
#pragma unroll
            for (int m = 0; m < 4; ++m) { const size_t off = (size_t)(u.pm * BM + ai * HALF + wr * 64 + m * 16 + fr) * DM + col0;
#pragma unroll
                for (int bj = 0; bj < 2; ++bj)
#pragma unroll
                    for (int n = 0; n < 2; ++n) bs[m][bj][n] = *(const f32x4*)(base + off + bj * HALF + n * 16); }
#pragma unroll
            for (int m = 0; m < 4; ++m) { const int row = u.pm * BM + ai * HALF + wr * 64 + m * 16 + fr; const size_t off = (size_t)row * DM + col0; float ss = 0.f;
#pragma unroll
                for (int bj = 0; bj < 2; ++bj)
#pragma unroll
                    for (int n = 0; n < 2; ++n) { const f32x4 o = bs[m][bj][n] + acc[ai][bj][m][n];
                        *(f32x4*)(out + off + bj * HALF + n * 16) = o;
                        if (STATS) { ss += (o[0] * o[0] + o[1] * o[1]) + (o[2] * o[2] + o[3] * o[3]);
                            u32x2v w; w.x = cvt_pk_bf16(o[0], o[1]); w.y = cvt_pk_bf16(o[2], o[3]); *(u32x2v*)(xb + off + bj * HALF + n * 16) = w; } }
                if (STATS) { ss += __shfl_xor(ss, 16); ss += __shfl_xor(ss, 32); if (fq == 0) rss[(size_t)row * 64 + u.pn * 4 + wc] = ss; } }
            asm volatile("" ::: "memory"); }
    }
};
template <bool TAB> struct EpiRelu2 {
    static constexpr bool PERM = true, AFTER_DRAIN = false;
    bf16_t* O; const float* rss; const PG8_LAS float* rtab;
    __device__ __forceinline__ void operator()(const f32x4 (&acc)[2][2][4][2], const Unit& u, int wr, int wc, int fr, int fq) const {
        const int row0 = u.pm * BM + wr * 64 + fr, col0 = u.pn * BM + wc * 32 + 8 * fq;
#pragma unroll
        for (int ai = 0; ai < 2; ++ai)
#pragma unroll
            for (int m = 0; m < 4; ++m) { const int row = row0 + ai * HALF + m * 16; float rstd;
                if (TAB) rstd = rtab[ai * HALF + wr * 64 + m * 16 + fr];
                else { const f32x4* rp = (const f32x4*)(rss + (size_t)row * 64 + fq * 16);
                    const f32x4 a = rp[0], b = rp[1], c = rp[2], d = rp[3];
                    float t = ((a[0] + a[1]) + (a[2] + a[3])) + ((b[0] + b[1]) + (b[2] + b[3])) + ((c[0] + c[1]) + (c[2] + c[3])) + ((d[0] + d[1]) + (d[2] + d[3]));
                    t += __shfl_xor(t, 16); t += __shfl_xor(t, 32);
                    rstd = rsqrtf(t * (1.0f / DM) + RMS_EPS); }
                bf16_t* rowp = O + (size_t)row * DFF + col0;
#pragma unroll
                for (int bj = 0; bj < 2; ++bj) { f32x4 v0 = acc[ai][bj][m][0] * rstd, v1 = acc[ai][bj][m][1] * rstd;
#pragma unroll
                    for (int i = 0; i < 4; ++i) { v0[i] = fmaxf(v0[i], 0.f); v0[i] *= v0[i]; v1[i] = fmaxf(v1[i], 0.f); v1[i] *= v1[i]; }
                    *(u32x4*)(rowp + bj * HALF) = pack8bf(v0, v1); } }
    }
};
}
namespace swa {
typedef short bf16x8 __attribute__((ext_vector_type(8)));
typedef short s16x4 __attribute__((ext_vector_type(4)));
typedef float f32x16 __attribute__((ext_vector_type(16)));
typedef float f32x4 __attribute__((ext_vector_type(4)));
typedef unsigned u32x4 __attribute__((ext_vector_type(4)));
typedef unsigned short bf16;
constexpr int D = 128, NW = 8, QBLK = 32, KVBLK = 64, QB = NW * QBLK;
constexpr int SHM_V = KVBLK * D * 2, SHM_K = KVBLK * D * 2;
constexpr int LDS_BYTES = 2 * SHM_V + 2 * SHM_K + NW * 64 * 4;
constexpr float SCALE = 0.08838834764831845f, THR = 8.f;
#define KSWZ(row, colB) ((row) * 256 + ((colB) ^ (((row) & 7) << 4)))
#define SBAR() __builtin_amdgcn_sched_barrier(0)
__device__ __forceinline__ int v_st(int k, int c) { const int kk = (k & ~0xC) | ((k & 4) << 1) | ((k & 8) >> 1); return ((kk >> 3) * 4 + (c >> 5)) * 512 + ((kk & 7) * 32 + (c & 31)) * 2; }
__device__ __forceinline__ int v_rd_base(int lane) { return ((lane & 3) << 3) | (((lane >> 2) & 3) << 6) | (((lane >> 4) & 1) << 5) | (((lane >> 5) & 1) << 8); }
constexpr int v_rd_off(int d0, int ks, int half) { return d0 * 512 + ks * 4096 + half * 2048; }
__device__ __forceinline__ int crow(int r, int hi) { return (r & 3) + 8 * (r >> 2) + 4 * hi; }
typedef float f32x2_t __attribute__((ext_vector_type(2))); typedef __bf16 bf16x2_t __attribute__((ext_vector_type(2)));
__device__ __forceinline__ unsigned cvtpk(float lo, float hi) { const f32x2_t v = {lo, hi}; const bf16x2_t b = __builtin_convertvector(v, bf16x2_t); return __builtin_bit_cast(unsigned, b); }
__device__ __forceinline__ bf16x8 load8(const bf16* p) { return *reinterpret_cast<const bf16x8*>(p); }
__device__ __forceinline__ void mask_tile(f32x16& p0, f32x16& p1, int dq, unsigned W) {
    const float NEG = -__builtin_inff();
#pragma unroll
    for (int r = 0; r < 16; ++r) {
        const int c = (r & 3) + 8 * (r >> 2);
        if ((unsigned)(dq - c) >= W) p0[r] = NEG;
        if ((unsigned)(dq - c - 32) >= W) p1[r] = NEG;
    }
}
__device__ __forceinline__ void partialSM(f32x16& p0, f32x16& p1, float& m_reg, float& mn, float& alpha) {
    float pmax = p0[0]; for (int r = 1; r < 16; ++r) pmax = fmaxf(pmax, p0[r]); for (int r = 0; r < 16; ++r) pmax = fmaxf(pmax, p1[r]);
    { auto rr = __builtin_amdgcn_permlane32_swap(__float_as_uint(pmax), __float_as_uint(pmax), false, false);
      pmax = fmaxf(__uint_as_float(rr[0]), __uint_as_float(rr[1])); }
    constexpr float C2 = 1.4426950408889634f * SCALE;
    if (__builtin_expect(__all((pmax - m_reg) * SCALE <= THR), 1)) { mn = m_reg; alpha = 1.f; }
    else { mn = fmaxf(m_reg, pmax); alpha = __builtin_amdgcn_exp2f((m_reg - mn) * C2); m_reg = mn; }
    const float mnL = -mn * C2;
    for (int r = 0; r < 16; ++r) p0[r] = fmaf(p0[r], C2, mnL); for (int r = 0; r < 16; ++r) p1[r] = fmaf(p1[r], C2, mnL);
    for (int r = 0; r < 16; ++r) p0[r] = __builtin_amdgcn_exp2f(p0[r]);
}
__device__ __forceinline__ void finishSM(f32x16& p0, f32x16& p1, float alpha, float& l_reg, bf16x8& pa0, bf16x8& pa1, bf16x8& pa2, bf16x8& pa3) {
    for (int r = 0; r < 16; ++r) p1[r] = __builtin_amdgcn_exp2f(p1[r]);
    float ps = 0; for (int r = 0; r < 16; ++r) ps += p0[r]; for (int r = 0; r < 16; ++r) ps += p1[r];
    { auto rr = __builtin_amdgcn_permlane32_swap(__float_as_uint(ps), __float_as_uint(ps), false, false);
      ps = __uint_as_float(rr[0]) + __uint_as_float(rr[1]); }
    l_reg = l_reg * alpha + ps;
#define PK4(P, B_, OUT) do { unsigned a0 = cvtpk(P[B_+0], P[B_+1]), a1 = cvtpk(P[B_+2], P[B_+3]);                          \
        unsigned b0 = cvtpk(P[B_+4], P[B_+5]), b1 = cvtpk(P[B_+6], P[B_+7]);                                             \
        auto r0 = __builtin_amdgcn_permlane32_swap(a0, b0, false, false); auto r1 = __builtin_amdgcn_permlane32_swap(a1, b1, false, false); \
        u32x4 w = {r0[0], r1[0], r0[1], r1[1]}; OUT = *reinterpret_cast<bf16x8*>(&w); } while (0)
    PK4(p0, 0, pa0); PK4(p0, 8, pa1); PK4(p1, 0, pa2); PK4(p1, 8, pa3);
#undef PK4
}
template <int KB>
__device__ __forceinline__ void qkt(f32x16& p0, f32x16& p1, const char* K_lds, int r32, int hi, const bf16x8* qr) {
    p0 = f32x16{}; p1 = f32x16{};
    const char* kb[4];
#pragma unroll
    for (int dd = 0; dd < 4; ++dd) kb[dd] = K_lds + KB * SHM_K + KSWZ(r32, (dd * 16 + hi * 8) * 2);
#pragma unroll
    for (int d0 = 0; d0 < 8; ++d0) { const char* a = kb[d0 & 3] + (d0 >> 2) * 128;
        bf16x8 b0 = *reinterpret_cast<const bf16x8*>(a);
        bf16x8 b1 = *reinterpret_cast<const bf16x8*>(a + 32 * 256);
        p0 = __builtin_amdgcn_mfma_f32_32x32x16_bf16(b0, qr[d0], p0, 0, 0, 0);
        p1 = __builtin_amdgcn_mfma_f32_32x32x16_bf16(b1, qr[d0], p1, 0, 0, 0); }
}
template <int VB>
__device__ __forceinline__ void pv_tile(f32x16* o, int vb0, bf16x8 pa0, bf16x8 pa1, bf16x8 pa2, bf16x8 pa3) {
#define TRRD(dst, off) asm volatile("ds_read_b64_tr_b16 %0, %1 offset:%2" : "=&v"(dst) : "v"(vb0), "i"(off) : "memory")
#define PV_D0(d0) do { s16x4 l0, l1, l2, l3, h0, h1, h2, h3; constexpr int b_ = VB * SHM_V + v_rd_off(d0, 0, 0);     \
        TRRD(l0, b_); TRRD(h0, b_ + 2048); TRRD(l1, b_ + 4096); TRRD(h1, b_ + 6144); TRRD(l2, b_ + 8192); TRRD(h2, b_ + 10240); TRRD(l3, b_ + 12288); TRRD(h3, b_ + 14336); \
        asm volatile("s_waitcnt lgkmcnt(0)" ::: "memory"); SBAR();                                                             \
        o[d0] = __builtin_amdgcn_mfma_f32_32x32x16_bf16(pa0, (bf16x8){l0[0], l0[1], l0[2], l0[3], h0[0], h0[1], h0[2], h0[3]}, o[d0], 0, 0, 0);   \
        o[d0] = __builtin_amdgcn_mfma_f32_32x32x16_bf16(pa1, (bf16x8){l1[0], l1[1], l1[2], l1[3], h1[0], h1[1], h1[2], h1[3]}, o[d0], 0, 0, 0);   \
        o[d0] = __builtin_amdgcn_mfma_f32_32x32x16_bf16(pa2, (bf16x8){l2[0], l2[1], l2[2], l2[3], h2[0], h2[1], h2[2], h2[3]}, o[d0], 0, 0, 0);   \
        o[d0] = __builtin_amdgcn_mfma_f32_32x32x16_bf16(pa3, (bf16x8){l3[0], l3[1], l3[2], l3[3], h3[0], h3[1], h3[2], h3[3]}, o[d0], 0, 0, 0); } while (0)
    PV_D0(0); PV_D0(1); PV_D0(2); PV_D0(3);
#undef PV_D0
#undef TRRD
}
struct BlockRef { const bf16* Q; const bf16* K; const bf16* V; float* O; float* L; int P0, qp, kp, op, lp, skv, W; };
struct Seam { bf16x8 qr[8]; bf16x8 st_v0, st_v1, st_k0, st_k1; };
__device__ __forceinline__ int swa_jlo(int P0, int W) { const int lowk = P0 - W + 1; return lowk > 0 ? lowk / KVBLK : 0; }
#define ROW(p, k0, rr, pitch) ((p) + (size_t)((k0) + (rr)) * (pitch) + sc)
#define VMW() asm volatile("s_waitcnt vmcnt(0)" ::: "memory")
#define VMWN(n) asm volatile("s_waitcnt vmcnt(%0)" :: "i"(n) : "memory")
#define SLOAD_H(Kp, Vp, k0, pitch) do { S.st_v0 = load8(ROW(Vp, k0, sr, pitch)); S.st_v1 = load8(ROW(Vp, k0, 32 + sr, pitch));              \
                         S.st_k0 = load8(ROW(Kp, k0, sr, pitch)); S.st_k1 = load8(ROW(Kp, k0, 32 + sr, pitch)); } while (0)
#define SWRITE_HK(bf) do { *(bf16x8*)(K_lds + (bf) * SHM_K + kws) = S.st_k0; *(bf16x8*)(K_lds + (bf) * SHM_K + kws + 32 * 256) = S.st_k1; } while (0)
#define SWRITE_HV(bf) do { *(bf16x8*)(V_lds + (bf) * SHM_V + vst0) = S.st_v0; *(bf16x8*)(V_lds + (bf) * SHM_V + vst1) = S.st_v1; } while (0)
#define SWRITE_H(bf) do { SWRITE_HV(bf); SWRITE_HK(bf); } while (0)
__device__ __forceinline__ void causal_swa_prime(const BlockRef& cur, char* lds, Seam& S) {
    const int tid = threadIdx.x, wid = __builtin_amdgcn_readfirstlane(tid >> 6), lane = tid & 63, r32 = lane & 31, hi = lane >> 5;
    const int sr = tid >> 4, sc = (tid & 15) * 8, kws = KSWZ(sr, sc * 2); char* K_lds = lds + 2 * SHM_V;
    const int kb0 = swa_jlo(cur.P0, cur.W) * KVBLK;
#pragma unroll
    for (int d0 = 0; d0 < 8; ++d0) S.qr[d0] = load8(cur.Q + (size_t)(wid * QBLK + r32) * cur.qp + d0 * 16 + hi * 8);
    SLOAD_H(cur.K, cur.V, kb0, cur.kp); VMW(); SWRITE_HK(0);
    __syncthreads();
}
__device__ __forceinline__ void causal_swa_block(const BlockRef& cur, const BlockRef& nxt, char* lds, Seam& S) {
    const int tid = threadIdx.x, wid = __builtin_amdgcn_readfirstlane(tid >> 6), lane = tid & 63, r32 = lane & 31, hi = lane >> 5;
    const int W = cur.W, kp = cur.kp;
    const int j_lo = swa_jlo(cur.P0, W);
    int j_hi = (cur.P0 + QB - 1) / KVBLK + 1; if (j_hi > cur.skv / KVBLK) j_hi = cur.skv / KVBLK;
    const int NT = j_hi - j_lo;
    const int kbn = swa_jlo(nxt.P0, nxt.W) * KVBLK;
    const int qlo = cur.P0 + wid * QBLK, qm = qlo + r32 - 4 * hi;
    char* V_lds = lds; char* K_lds = lds + 2 * SHM_V;
    float* ws = (float*)(lds + 2 * SHM_V + 2 * SHM_K) + wid * 64; float* li_l = ws, * al_l = ws + 32;
    float m_reg = -1e30f, l_reg = 0; f32x16 o[4] = {};
    const int sr = tid >> 4, sc = (tid & 15) * 8, vst0 = v_st(sr, sc), vst1 = v_st(32 + sr, sc), kws = KSWZ(sr, sc * 2);
    const int vb0 = (int)(uintptr_t)V_lds + v_rd_base(lane);
    const bf16* Kh = cur.K; const bf16* Vh = cur.V;
#define RESC(a) do { if (__any((a) < 1.f)) { if (hi == 0) al_l[r32] = (a); asm volatile("s_waitcnt lgkmcnt(0)" ::: "memory");              \
                     for (int d_ = 0; d_ < 4; ++d_) for (int r = 0; r < 16; ++r) o[d_][r] *= al_l[crow(r, hi)]; } } while (0)
#define KBASE(t) ((j_lo + (t)) * KVBLK)
#define MASKT(P0_, P1_, t) do { const int kb_ = KBASE(t); if (kb_ + KVBLK - 1 > qlo || kb_ <= qlo + QBLK - 1 - W) mask_tile(P0_, P1_, qm - kb_, (unsigned)W); } while (0)
    constexpr int NQL = 8;
#define SEAM_K0() do { VMWN(NQL); SWRITE_HK(0); SBAR(); } while (0)
    f32x16 pA0, pA1, pB0, pB1; float mnA, mnB, alA, alB; bf16x8 pa0, pa1, pa2, pa3;
    SWRITE_HV(0); SBAR();
    if (NT > 1) SLOAD_H(Kh, Vh, KBASE(1), kp);
    SBAR(); qkt<0>(pA0, pA1, K_lds, r32, hi, S.qr);
    MASKT(pA0, pA1, 0); partialSM(pA0, pA1, m_reg, mnA, alA);
    if (NT > 1) { VMW(); SWRITE_H(1); }
    __syncthreads();
#define HALF_STEP(PX0, PX1, mnX, alX, PY0, PY1, alY, t, KB, VB, SB) do {                                                      \
        SBAR(); qkt<KB>(PX0, PX1, K_lds, r32, hi, S.qr);                                                                      \
        finishSM(PY0, PY1, alY, l_reg, pa0, pa1, pa2, pa3); SBAR();                                                           \
        if ((t) + 1 < NT) { SLOAD_H(Kh, Vh, KBASE((t) + 1), kp); SBAR(); }                                                    \
        pv_tile<VB>(o, vb0, pa0, pa1, pa2, pa3); MASKT(PX0, PX1, (t)); partialSM(PX0, PX1, m_reg, mnX, alX);                  \
        __syncthreads();                                                                                                      \
        if ((t) + 1 < NT) { VMW(); SWRITE_H(SB); }                                                                            \
        RESC(alX); __syncthreads(); } while (0)
    for (int t = 1; t + 1 < NT; t += 2) {
        HALF_STEP(pB0, pB1, mnB, alB, pA0, pA1, alA, t, 1, 0, 0);
        HALF_STEP(pA0, pA1, mnA, alA, pB0, pB1, alB, t + 1, 0, 1, 1);
    }
    const bool even = (NT & 1) == 0;
    if (even) { SBAR(); qkt<1>(pB0, pB1, K_lds, r32, hi, S.qr); SBAR(); }
    SLOAD_H(nxt.K, nxt.V, kbn, nxt.kp); SBAR();
#pragma unroll
    for (int d0 = 0; d0 < 8; ++d0) S.qr[d0] = load8(nxt.Q + (size_t)(wid * QBLK + r32) * nxt.qp + d0 * 16 + hi * 8);
    SBAR();
    finishSM(pA0, pA1, alA, l_reg, pa0, pa1, pa2, pa3); SBAR();
    pv_tile<0>(o, vb0, pa0, pa1, pa2, pa3);
    if (even) { MASKT(pB0, pB1, NT - 1); partialSM(pB0, pB1, m_reg, mnB, alB); __syncthreads(); RESC(alB);
        finishSM(pB0, pB1, alB, l_reg, pa0, pa1, pa2, pa3); SBAR(); pv_tile<1>(o, vb0, pa0, pa1, pa2, pa3); }
    SBAR(); SEAM_K0();
    if (hi == 0) li_l[r32] = l_reg; asm volatile("s_waitcnt lgkmcnt(0)" ::: "memory");
    float rli[16];
#pragma unroll
    for (int r = 0; r < 16; ++r) rli[r] = __builtin_amdgcn_rcpf(li_l[crow(r, hi)]);
    float* Ow = cur.O + (size_t)(wid * QBLK) * cur.op;
#pragma unroll
    for (int r = 0; r < 16; ++r) { const int orow = crow(r, hi);
#pragma unroll
        for (int d0 = 0; d0 < 4; ++d0) Ow[(size_t)orow * cur.op + d0 * 32 + r32] = o[d0][r] * rli[r]; }
    if (cur.L != nullptr && hi == 0) cur.L[(size_t)(wid * QBLK + r32) * cur.lp] = m_reg * SCALE + __logf(l_reg);
    __syncthreads();
#undef RESC
#undef KBASE
#undef MASKT
#undef SEAM_K0
#undef HALF_STEP
}
#undef ROW
#undef VMW
#undef VMWN
#undef SLOAD_H
#undef SWRITE_HK
#undef SWRITE_HV
#undef SWRITE_H
#undef KSWZ
#undef SBAR
}

namespace att2 {
typedef short bf16x8 __attribute__((ext_vector_type(8)));
typedef short s16x4 __attribute__((ext_vector_type(4)));
typedef float f32x16 __attribute__((ext_vector_type(16)));
typedef unsigned u32x4 __attribute__((ext_vector_type(4)));
typedef unsigned short bf16;
#define A2_LAS __attribute__((address_space(3)))
constexpr int D = 128, NW = 8, QBLK = 32, KVBLK = 64, QB = NW * QBLK;
constexpr int KBUF = KVBLK * D * 2, VIMG = KVBLK * 128 * 2, VBUF = 2 * VIMG;
constexpr int OFF_K = 0, OFF_V = 2 * KBUF, OFF_P = OFF_V + 2 * VBUF, OFF_WS = 131072 + 2048, LDS_END = OFF_WS + NW * 64 * 4;
constexpr float SCALE = 0.08838834764831845f, THR = 8.f;
#define A2_KSWZ(row, colB) ((row) * 256 + ((colB) ^ (((row) & 7) << 4)))
#define A2_SBAR() __builtin_amdgcn_sched_barrier(0)
__device__ __forceinline__ int v_rd_base(int lane) { return ((lane & 3) << 3) | (((lane >> 2) & 3) << 6) | (((lane >> 4) & 1) << 5) | (((lane >> 5) & 1) << 8); }
constexpr int v_rd_off(int d0, int ks, int half) { return d0 * 512 + ks * 4096 + half * 2048; }
__device__ __forceinline__ int crow(int r, int hi) { return (r & 3) + 8 * (r >> 2) + 4 * hi; }
typedef float f32x2_t __attribute__((ext_vector_type(2))); typedef __bf16 bf16x2_t __attribute__((ext_vector_type(2)));
__device__ __forceinline__ unsigned cvtpk(float lo, float hi) { const f32x2_t v = {lo, hi}; const bf16x2_t b = __builtin_convertvector(v, bf16x2_t); return __builtin_bit_cast(unsigned, b); }
__device__ __forceinline__ void mask_tile(f32x16& p0, f32x16& p1, int dq, unsigned W) {
    const float NEG = -__builtin_inff();
#pragma unroll
    for (int r = 0; r < 16; ++r) { const int c = (r & 3) + 8 * (r >> 2);
        if ((unsigned)(dq - c) >= W) p0[r] = NEG;
        if ((unsigned)(dq - c - 32) >= W) p1[r] = NEG; }
}
__device__ __forceinline__ void qkt(f32x16& p0, f32x16& p1, const A2_LAS char* Kb, int r32, int hi, const bf16x8* qr) {
    p0 = f32x16{}; p1 = f32x16{};
    const A2_LAS char* kb[4];
#pragma unroll
    for (int dd = 0; dd < 4; ++dd) kb[dd] = Kb + A2_KSWZ(r32, (dd * 16 + hi * 8) * 2);
    bf16x8 b0 = *reinterpret_cast<const A2_LAS bf16x8*>(kb[0]), b1 = *reinterpret_cast<const A2_LAS bf16x8*>(kb[0] + 32 * 256);
#pragma unroll
    for (int d0 = 0; d0 < 8; ++d0) { bf16x8 n0 = b0, n1 = b1;
        if (d0 < 7) { const A2_LAS char* a = kb[(d0 + 1) & 3] + ((d0 + 1) >> 2) * 128; n0 = *reinterpret_cast<const A2_LAS bf16x8*>(a); n1 = *reinterpret_cast<const A2_LAS bf16x8*>(a + 32 * 256); }
        asm volatile("" ::: "memory");
        p0 = __builtin_amdgcn_mfma_f32_32x32x16_bf16(b0, qr[d0], p0, 0, 0, 0);
        p1 = __builtin_amdgcn_mfma_f32_32x32x16_bf16(b1, qr[d0], p1, 0, 0, 0);
        b0 = n0; b1 = n1; }
}
__device__ __forceinline__ void softmax_tile(f32x16& p0, f32x16& p1, float& m_reg, float& l_reg, float& alpha, bf16x8& pa0, bf16x8& pa1, bf16x8& pa2, bf16x8& pa3) {
#define A2_MX3(a, b, c) __builtin_fmaxf(__builtin_fmaxf((a), (b)), (c))
    float ma = A2_MX3(p0[0], p0[1], p0[2]), mb = A2_MX3(p1[0], p1[1], p1[2]);
#pragma unroll
    for (int r = 3; r + 1 < 16; r += 2) { ma = A2_MX3(ma, p0[r], p0[r + 1]); mb = A2_MX3(mb, p1[r], p1[r + 1]); }
    float pmax = A2_MX3(ma, mb, p0[15]); pmax = fmaxf(pmax, p1[15]);
#undef A2_MX3
    { auto rr = __builtin_amdgcn_permlane32_swap(__float_as_uint(pmax), __float_as_uint(pmax), false, false);
      pmax = fmaxf(__uint_as_float(rr[0]), __uint_as_float(rr[1])); }
    constexpr float C2 = 1.4426950408889634f * SCALE;
    float mn;
    if (__builtin_expect(__all((pmax - m_reg) * SCALE <= THR), 1)) { mn = m_reg; alpha = 1.f; }
    else { mn = fmaxf(m_reg, pmax); alpha = __builtin_amdgcn_exp2f((m_reg - mn) * C2); m_reg = mn; }
    const f32x2_t c2 = {C2, C2}, mnl = {-mn * C2, -mn * C2};
    f32x2_t acc = {0.f, 0.f};
#pragma unroll
    for (int r = 0; r < 16; r += 2) {
        f32x2_t a = {p0[r], p0[r + 1]}, b = {p1[r], p1[r + 1]};
        a = a * c2 + mnl; b = b * c2 + mnl;
        a.x = __builtin_amdgcn_exp2f(a.x); a.y = __builtin_amdgcn_exp2f(a.y); b.x = __builtin_amdgcn_exp2f(b.x); b.y = __builtin_amdgcn_exp2f(b.y);
        acc = acc + a; acc = acc + b;
        p0[r] = a.x; p0[r + 1] = a.y; p1[r] = b.x; p1[r + 1] = b.y; }
    float ps = acc.x + acc.y;
    { auto rr = __builtin_amdgcn_permlane32_swap(__float_as_uint(ps), __float_as_uint(ps), false, false);
      ps = __uint_as_float(rr[0]) + __uint_as_float(rr[1]); }
    l_reg = l_reg * alpha + ps;
#define A2_PK4(P, B_, OUT) do { const unsigned a0 = cvtpk(P[B_+0], P[B_+1]), a1 = cvtpk(P[B_+2], P[B_+3]);                 \
        const unsigned b0 = cvtpk(P[B_+4], P[B_+5]), b1 = cvtpk(P[B_+6], P[B_+7]);                                       \
        auto r0 = __builtin_amdgcn_permlane32_swap(a0, b0, false, false); auto r1 = __builtin_amdgcn_permlane32_swap(a1, b1, false, false); \
        u32x4 w = {r0[0], r1[0], r0[1], r1[1]}; OUT = *reinterpret_cast<bf16x8*>(&w); } while (0)
    A2_PK4(p0, 0, pa0); A2_PK4(p0, 8, pa1); A2_PK4(p1, 0, pa2); A2_PK4(p1, 8, pa3);
#undef A2_PK4
}
__device__ __forceinline__ void pv_img(f32x16* o, int vb, bf16x8 pa0, bf16x8 pa1, bf16x8 pa2, bf16x8 pa3) {
#define A2_TRRD(dst, off) asm volatile("ds_read_b64_tr_b16 %0, %1 offset:%2" : "=&v"(dst) : "v"(vb), "i"(off) : "memory")
#define A2_PV_D0(d0) do { s16x4 l0, l1, l2, l3, h0, h1, h2, h3; constexpr int b_ = v_rd_off(d0, 0, 0);                          \
        A2_TRRD(l0, b_); A2_TRRD(h0, b_ + 2048); A2_TRRD(l1, b_ + 4096); A2_TRRD(h1, b_ + 6144); A2_TRRD(l2, b_ + 8192); A2_TRRD(h2, b_ + 10240); A2_TRRD(l3, b_ + 12288); A2_TRRD(h3, b_ + 14336); \
        asm volatile("s_waitcnt lgkmcnt(0)" ::: "memory"); A2_SBAR();                                                        \
        o[d0] = __builtin_amdgcn_mfma_f32_32x32x16_bf16(pa0, (bf16x8){l0[0], l0[1], l0[2], l0[3], h0[0], h0[1], h0[2], h0[3]}, o[d0], 0, 0, 0);   \
        o[d0] = __builtin_amdgcn_mfma_f32_32x32x16_bf16(pa1, (bf16x8){l1[0], l1[1], l1[2], l1[3], h1[0], h1[1], h1[2], h1[3]}, o[d0], 0, 0, 0);   \
        o[d0] = __builtin_amdgcn_mfma_f32_32x32x16_bf16(pa2, (bf16x8){l2[0], l2[1], l2[2], l2[3], h2[0], h2[1], h2[2], h2[3]}, o[d0], 0, 0, 0);   \
        o[d0] = __builtin_amdgcn_mfma_f32_32x32x16_bf16(pa3, (bf16x8){l3[0], l3[1], l3[2], l3[3], h3[0], h3[1], h3[2], h3[3]}, o[d0], 0, 0, 0); } while (0)
    A2_PV_D0(0); A2_PV_D0(1); A2_PV_D0(2); A2_PV_D0(3);
#undef A2_PV_D0
#undef A2_TRRD
}
__device__ __forceinline__ void pv_all(f32x16* o, int vb, bf16x8 pa0, bf16x8 pa1, bf16x8 pa2, bf16x8 pa3) {
#define A2_TR(dst, off) asm volatile("ds_read_b64_tr_b16 %0, %1 offset:%2" : "=&v"(dst) : "v"(vb), "i"(off) : "memory")
#define A2_RD(S, d) do { constexpr int b_ = ((d) >> 2) * VIMG + v_rd_off((d) & 3, 0, 0);                                                        \
        A2_TR(S##l0, b_); A2_TR(S##h0, b_ + 2048); A2_TR(S##l1, b_ + 4096); A2_TR(S##h1, b_ + 6144); A2_TR(S##l2, b_ + 8192); A2_TR(S##h2, b_ + 10240); A2_TR(S##l3, b_ + 12288); A2_TR(S##h3, b_ + 14336); } while (0)
#define A2_WT(S, n) asm volatile("s_waitcnt lgkmcnt(" #n ")" : "+v"(S##l0), "+v"(S##h0), "+v"(S##l1), "+v"(S##h1), "+v"(S##l2), "+v"(S##h2), "+v"(S##l3), "+v"(S##h3) :: "memory")
#define A2_MM(S, d) do {                                                                                                                         \
        o[d] = __builtin_amdgcn_mfma_f32_32x32x16_bf16(pa0, (bf16x8){S##l0[0], S##l0[1], S##l0[2], S##l0[3], S##h0[0], S##h0[1], S##h0[2], S##h0[3]}, o[d], 0, 0, 0);   \
        o[d] = __builtin_amdgcn_mfma_f32_32x32x16_bf16(pa1, (bf16x8){S##l1[0], S##l1[1], S##l1[2], S##l1[3], S##h1[0], S##h1[1], S##h1[2], S##h1[3]}, o[d], 0, 0, 0);   \
        o[d] = __builtin_amdgcn_mfma_f32_32x32x16_bf16(pa2, (bf16x8){S##l2[0], S##l2[1], S##l2[2], S##l2[3], S##h2[0], S##h2[1], S##h2[2], S##h2[3]}, o[d], 0, 0, 0);   \
        o[d] = __builtin_amdgcn_mfma_f32_32x32x16_bf16(pa3, (bf16x8){S##l3[0], S##l3[1], S##l3[2], S##l3[3], S##h3[0], S##h3[1], S##h3[2], S##h3[3]}, o[d], 0, 0, 0); } while (0)
    s16x4 Al0, Ah0, Al1, Ah1, Al2, Ah2, Al3, Ah3, Bl0, Bh0, Bl1, Bh1, Bl2, Bh2, Bl3, Bh3;
    A2_RD(A, 0);
    A2_RD(B, 1); A2_WT(A, 8); A2_MM(A, 0);
    A2_RD(A, 2); A2_WT(B, 8); A2_MM(B, 1);
    A2_RD(B, 3); A2_WT(A, 8); A2_MM(A, 2);
    A2_RD(A, 4); A2_WT(B, 8); A2_MM(B, 3);
    A2_RD(B, 5); A2_WT(A, 8); A2_MM(A, 4);
    A2_RD(A, 6); A2_WT(B, 8); A2_MM(B, 5);
    A2_RD(B, 7); A2_WT(A, 8); A2_MM(A, 6);
    A2_WT(B, 0); A2_MM(B, 7);
#undef A2_TR
#undef A2_RD
#undef A2_WT
#undef A2_MM
}
struct BlockRef { const bf16* Q; const bf16* K; const bf16* V; float* O; float* L; int P0, qp, kp, op, lp, skv, W, dvs; };
__device__ __forceinline__ int jlo(int P0, int W) { const int lowk = P0 - W + 1; return lowk > 0 ? lowk / KVBLK : 0; }
#define A2_BAR() do { asm volatile("" ::: "memory"); __builtin_amdgcn_s_barrier(); asm volatile("" ::: "memory"); } while (0)
#define A2_WAITV(n) asm volatile("s_waitcnt vmcnt(" #n ")" ::: "memory")
__device__ __forceinline__ void block(const BlockRef& cur, A2_LAS unsigned char* lds) {
    int tid = threadIdx.x; asm volatile("" : "+v"(tid));
    const int wid = __builtin_amdgcn_readfirstlane(tid >> 6), lane = tid & 63, r32 = lane & 31, hi = lane >> 5;
    const int half = wid >> 2;
    const int W = cur.W, kp = cur.kp;
    const int j_lo = jlo(cur.P0, W);
    int j_hi = (cur.P0 + QB - 1) / KVBLK + 1; if (j_hi > cur.skv / KVBLK) j_hi = cur.skv / KVBLK;
    const int NT = j_hi - j_lo;
    const int qlo = cur.P0 + wid * QBLK;
    const char* Kg = (const char*)cur.K + (size_t)j_lo * KVBLK * kp * 2; const char* Vg = (const char*)cur.V + (size_t)j_lo * KVBLK * kp * 2;
    const size_t tstep = (size_t)KVBLK * kp * 2;
#define A2_DMA_K(t) do { const char* g_ = Kg + (size_t)(t) * tstep; A2_LAS unsigned char* d_ = lds + OFF_K + ((t) & 1) * KBUF + (2 * wid) * 1024;  \
        int l_ = lane; asm volatile("" : "+v"(l_));                                                                                          \
        _Pragma("unroll") for (int j = 0; j < 2; ++j) { const int row = 4 * (2 * wid + j) + (l_ >> 4), cc = (l_ & 15) ^ (row & 7); const unsigned of_ = (unsigned)(row * kp + cc * 8) * 2u; \
            __builtin_amdgcn_global_load_lds((const unsigned*)(g_ + of_), (A2_LAS unsigned*)(d_ + j * 1024), 16, 0, 0); } } while (0)
#define A2_DMA_V(t) do { const char* g_ = Vg + (size_t)(t) * tstep; A2_LAS unsigned char* d_ = lds + OFF_V + ((t) & 1) * VBUF + (4 * wid) * 1024;  \
        int l_ = lane; asm volatile("" : "+v"(l_));                                                                                          \
        _Pragma("unroll") for (int j = 0; j < 4; ++j) { const int q = 4 * wid + j, img = q >> 4, p = q & 15, st = 2 * p + (l_ >> 5), kk = (st >> 2) * 8 + ((l_ & 31) >> 2);   \
            const int k = (kk & ~0xC) | ((kk & 4) << 1) | ((kk & 8) >> 1), col = img * 128 + (st & 3) * 32 + (l_ & 3) * 8; const unsigned of_ = (unsigned)(k * kp + col) * 2u;   \
            __builtin_amdgcn_global_load_lds((const unsigned*)(g_ + of_), (A2_LAS unsigned*)(d_ + j * 1024), 16, 0, 0); } } while (0)
    A2_DMA_K(0); A2_DMA_V(0); if (NT > 1) A2_DMA_K(1);
    bf16x8 qr[8];
#define A2_LDQ() do { _Pragma("unroll") for (int d0 = 0; d0 < 8; ++d0) qr[d0] = *reinterpret_cast<const bf16x8*>(cur.Q + (size_t)(wid * QBLK + r32) * cur.qp + d0 * 16 + hi * 8); } while (0)
    A2_LDQ();
    float m_reg = -1e30f, l_reg = 0.f; f32x16 o[8] = {};
    const int vbl = (int)(unsigned)(size_t)(lds + OFF_V) + v_rd_base(lane);
    f32x16 s0, s1; float alpha;
    A2_LAS bf16x8* pw = (A2_LAS bf16x8*)(lds + OFF_P + wid * 4096) + lane;
    A2_WAITV(0); A2_BAR();
#define A2_QK(t) do { { int l_ = lane; asm volatile("" : "+v"(l_)); qkt(s0, s1, (const A2_LAS char*)(lds + OFF_K + ((t) & 1) * KBUF), l_ & 31, l_ >> 5, qr); }                                              \
        { const int kb_ = (j_lo + (t)) * KVBLK; if (kb_ + KVBLK - 1 > qlo || kb_ <= qlo + QBLK - 1 - W) { int l_ = lane; asm volatile("" : "+v"(l_));     \
            mask_tile(s0, s1, qlo + (l_ & 31) - 4 * (l_ >> 5) - kb_, (unsigned)W); } } } while (0)
#define A2_SM() do { { bf16x8 pa0, pa1, pa2, pa3; softmax_tile(s0, s1, m_reg, l_reg, alpha, pa0, pa1, pa2, pa3);                               \
          pw[0] = pa0; pw[64] = pa1; pw[128] = pa2; pw[192] = pa3; }              \
        if (__any(alpha < 1.f)) { int l_ = lane; asm volatile("" : "+v"(l_)); const int hi_ = l_ >> 5; A2_LAS float* wsf_ = (A2_LAS float*)(lds + OFF_WS) + wid * 64;   \
            if (hi_ == 0) wsf_[l_ & 31] = alpha; asm volatile("s_waitcnt lgkmcnt(0)" ::: "memory");                                         \
            _Pragma("unroll") for (int d_ = 0; d_ < 8; ++d_) _Pragma("unroll") for (int r = 0; r < 16; ++r) o[d_][r] *= wsf_[crow(r, hi_)]; } } while (0)
#define A2_PV(t) do { const int vb_ = vbl + ((t) & 1) * VBUF; bf16x8 pa0 = pw[0], pa1 = pw[64], pa2 = pw[128], pa3 = pw[192];                              \
        asm volatile("s_waitcnt lgkmcnt(0)" : "+v"(pa0), "+v"(pa1), "+v"(pa2), "+v"(pa3) :: "memory"); pv_all(o, vb_, pa0, pa1, pa2, pa3); } while (0)
    A2_QK(0);
    A2_BAR();
#ifdef A2_STATIC_PRIO
    if (half == 1) __builtin_amdgcn_s_setprio(1);
#endif
    for (int hs = 0; hs <= 2 * NT; ++hs) {
        const int t = hs >> 1, e = hs - half;
        const bool act = (e >= 0 && e < 2 * NT); const int te = e >> 1;
        if (hs & 1) { if (t + 2 < NT) A2_DMA_K(t + 2); if (t + 1 < NT) A2_DMA_V(t + 1); }
        if (act && !(e & 1)) { A2_SM(); }
        if (act && (e & 1)) { A2_PV(te); asm volatile("" ::: "memory"); A2_SBAR(); if (te + 1 < NT) { A2_QK(te + 1); } }
        if (!(hs & 1)) A2_WAITV(0);
        A2_BAR();
    }
#ifdef A2_STATIC_PRIO
    __builtin_amdgcn_s_setprio(0);
#endif
    { int tid2 = threadIdx.x; asm volatile("" : "+v"(tid2)); const int lane2 = tid2 & 63, r32e = lane2 & 31, hie = lane2 >> 5;
      A2_LAS float* wse = (A2_LAS float*)(lds + OFF_WS) + wid * 64;
      if (hie == 0) wse[32 + r32e] = l_reg; asm volatile("s_waitcnt lgkmcnt(0)" ::: "memory");
      float rli[16];
#pragma unroll
      for (int r = 0; r < 16; ++r) rli[r] = __builtin_amdgcn_rcpf(wse[32 + crow(r, hie)]);
      float* Ow = cur.O + (size_t)(wid * QBLK) * cur.op;
#pragma unroll
      for (int r = 0; r < 16; ++r) { const int orow = crow(r, hie);
#pragma unroll
          for (int d0 = 0; d0 < 4; ++d0) Ow[(size_t)orow * cur.op + d0 * 32 + r32e] = o[d0][r] * rli[r]; }
      if (cur.dvs > 128) {
#pragma unroll
          for (int r = 0; r < 16; ++r) { const int orow = crow(r, hie);
#pragma unroll
              for (int d0 = 4; d0 < 8; ++d0) Ow[(size_t)orow * cur.op + d0 * 32 + r32e] = o[d0][r] * rli[r]; } }
      if (cur.L != nullptr && hie == 0) cur.L[(size_t)(wid * QBLK + r32e) * cur.lp] = m_reg * SCALE + __logf(l_reg); }
    A2_WAITV(0); A2_BAR();
#undef A2_DMA_K
#undef A2_DMA_V
#undef A2_QK
#undef A2_LDQ
#undef A2_SM
#undef A2_PV
}
#undef A2_BAR
#undef A2_WAITV
#undef A2_KSWZ
#undef A2_SBAR
}
#define GAS __attribute__((address_space(1)))
#define LAS __attribute__((address_space(3)))
typedef unsigned short bf16;
typedef unsigned v4u __attribute__((ext_vector_type(4)));
typedef unsigned v2u __attribute__((ext_vector_type(2)));
typedef float f32x4 __attribute__((ext_vector_type(4)));
typedef GAS unsigned gu32;
#define RLX_AGENT __ATOMIC_RELAXED, __HIP_MEMORY_SCOPE_AGENT
#define LDS_WAIT() asm volatile("s_waitcnt lgkmcnt(0)" ::: "memory")
#define VM_WAIT() asm volatile("s_waitcnt vmcnt(0)" ::: "memory")
__device__ __forceinline__ unsigned f2bf(float f) { unsigned u = __builtin_bit_cast(unsigned, f); return (u + 0x7fffu + ((u >> 16) & 1u)) >> 16; }
__device__ __forceinline__ unsigned pk2(float lo, float hi) { return f2bf(lo) | (f2bf(hi) << 16); }
__device__ __forceinline__ float bflo(unsigned u) { return __uint_as_float(u << 16); }
__device__ __forceinline__ float bfhi(unsigned u) { return __uint_as_float(u & 0xffff0000u); }
__device__ __forceinline__ float wave_sum(float v) {
#pragma unroll
    for (int o = 1; o < 64; o <<= 1) v += __shfl_xor(v, o);
    return v;
}
__device__ __forceinline__ float wave_max(float v) {
#pragma unroll
    for (int o = 1; o < 64; o <<= 1) v = fmaxf(v, __shfl_xor(v, o));
    return v;
}
#define XB_TMO      128
#define XB_XCNT(j)  (256  + 64 * (j))
#define XB_XSUB(j)  (1280 + 64 * (j))
#define XB_XGEN(j)  (2304 + 64 * (j))
#define XB_TOP      3328
#define XB_TOPGEN   3392
#define XCD_BAR_WORDS 3456
#define XB_SPIN_CAP (1u << 23)

__device__ __forceinline__ unsigned xb_ld(unsigned* p)              { return __hip_atomic_load(p, __ATOMIC_RELAXED, __HIP_MEMORY_SCOPE_AGENT); }
__device__ __forceinline__ unsigned xb_add(unsigned* p, unsigned v) { return __hip_atomic_fetch_add(p, v, __ATOMIC_RELAXED, __HIP_MEMORY_SCOPE_AGENT); }
__device__ __forceinline__ unsigned xb_xcc_id() { return (unsigned)__builtin_amdgcn_s_getreg((3 << 11) | 20) & 0xFu; }
#define XB_SPIN(cond, bar) do { unsigned _sp = 0; while (cond) { __builtin_amdgcn_s_sleep(1); \
    if ((++_sp & 255u) == 0u) { if (xb_ld(&(bar)[XB_TMO])) break; if (_sp > XB_SPIN_CAP) { atomicAdd(&(bar)[XB_TMO], 1u); break; } } } } while (0)

struct XcdBarrier {
    unsigned* bar; unsigned x;
    volatile LAS unsigned* st;
};

__device__ __forceinline__ XcdBarrier xcd_barrier_post(unsigned* bar, volatile LAS unsigned* st) {
    XcdBarrier b; b.bar = bar; b.x = xb_xcc_id(); b.st = st;
    if (threadIdx.x == 0) (void)xb_add(&bar[XB_XCNT(b.x)], 1u);
    return b;
}
__device__ __forceinline__ void xcd_barrier_complete(unsigned* bar, unsigned x, unsigned& nloc, unsigned& nx) {
    const unsigned G = gridDim.x * gridDim.y * gridDim.z;
    unsigned sum, cnt, mine, sp = 0u;
    for (;;) {
        sum = 0u; cnt = 0u; mine = 0u;
#pragma unroll
        for (unsigned j = 0; j < 16; ++j) { const unsigned c = xb_ld(&bar[XB_XCNT(j)]); sum += c; cnt += (c > 0u) ? 1u : 0u; mine = (j == x) ? c : mine; }
        if (sum == G) break;
        __builtin_amdgcn_s_sleep(1);
        if ((++sp & 255u) == 0u) { if (xb_ld(&bar[XB_TMO])) break; if (sp > XB_SPIN_CAP) { atomicAdd(&bar[XB_TMO], 1u); break; } }
    }
    nloc = mine > 0u ? mine : 1u; nx = cnt > 0u ? cnt : 1u;
}

__device__ __forceinline__ void xcd_barrier(const XcdBarrier& b) {
    asm volatile("s_waitcnt vmcnt(0)" ::: "memory");
    __syncthreads();
    if (threadIdx.x == 0) {
        unsigned* bar = b.bar;
        __builtin_amdgcn_s_waitcnt(0);
        unsigned nloc = b.st[0], nx = b.st[1];
        if (nloc == 0u) { xcd_barrier_complete(bar, b.x, nloc, nx); b.st[0] = nloc; b.st[1] = nx; }
        const unsigned old = xb_add(&bar[XB_XSUB(b.x)], 1u);
        const unsigned gen = old / nloc;
        if (old + 1u == (gen + 1u) * nloc) {
            __builtin_amdgcn_fence(__ATOMIC_RELEASE, "agent");
            asm volatile("s_waitcnt vmcnt(0)" ::: "memory");
            const unsigned og = xb_add(&bar[XB_TOP], 1u);
            const unsigned tg = og / nx;
            if (og + 1u == (tg + 1u) * nx) xb_add(&bar[XB_TOPGEN], 1u);
            else XB_SPIN(xb_ld(&bar[XB_TOPGEN]) == tg, bar);
            __builtin_amdgcn_fence(__ATOMIC_ACQUIRE, "agent");
            xb_add(&bar[XB_XGEN(b.x)], 1u);
            asm volatile("s_waitcnt vmcnt(0)" ::: "memory");
        } else {
            XB_SPIN(xb_ld(&bar[XB_XGEN(b.x)]) == gen, bar);
            __builtin_amdgcn_fence(__ATOMIC_ACQUIRE, "agent");
            asm volatile("s_waitcnt vmcnt(0)" ::: "memory");
        }
    }
    __syncthreads();
}
struct Args { const float* in[16]; float* out; unsigned char* ws; int ph_lo, ph_hi; };

#ifdef SELFTEST
constexpr int CW_FLAG = 64, CW_FLAG2 = 128;
__device__ __forceinline__ void st_flag2(gu32* ctl, unsigned bits) { atomicOr((unsigned*)ctl + CW_FLAG2, bits); }
__device__ __forceinline__ void st_flag(gu32* ctl, int code) { atomicOr((unsigned*)ctl + CW_FLAG, 1u << code); }
__device__ __forceinline__ bool st_close(float got, float want, float rel, float ab) { return fabsf(got - want) <= rel * fabsf(want) + ab; }
__device__ __forceinline__ void scan_poison(const void* p, size_t nbytes, int code, gu32* ctl, size_t gtid, size_t nthreads) {
    const v4u* q = (const v4u*)p; bool bad = false;
    for (size_t i = gtid; i < nbytes / 16; i += nthreads) { const v4u w = q[i]; bad |= (w.x == 0xAAAAAAAAu) | (w.y == 0xAAAAAAAAu) | (w.z == 0xAAAAAAAAu) | (w.w == 0xAAAAAAAAu); }
    if (bad) st_flag(ctl, code);
}
__device__ __forceinline__ float dot_bf16(const bf16* a, const bf16* b, int K, int lane) {
    float s = 0.f;
    for (int k = lane * 8; k < K; k += 512) { const v4u x = *(const v4u*)(a + k), y = *(const v4u*)(b + k);
        s += bflo(x.x) * bflo(y.x) + bfhi(x.x) * bfhi(y.x) + bflo(x.y) * bflo(y.y) + bfhi(x.y) * bfhi(y.y) + bflo(x.z) * bflo(y.z) + bfhi(x.z) * bfhi(y.z) + bflo(x.w) * bflo(y.w) + bfhi(x.w) * bfhi(y.w); }
    return wave_sum(s);
}
__device__ __forceinline__ unsigned hash_u(unsigned x) { x ^= x >> 16; x *= 0x7feb352dU; x ^= x >> 15; x *= 0x846ca68bU; x ^= x >> 16; return x; }
__device__ __forceinline__ float ldbf(const bf16* p) { return __uint_as_float((unsigned)(*p) << 16); }
__device__ __forceinline__ void sincos_d(double x, double& s, double& c) {
    const double TWO_PI = 6.283185307179586; const double k = rint(x / TWO_PI); const double r = x - k * TWO_PI, r2 = r * r;
    double ts = 1.0, tc = 1.0;
    for (int i = 14; i >= 1; --i) { ts = 1.0 - r2 / (double)((2 * i) * (2 * i + 1)) * ts; tc = 1.0 - r2 / (double)((2 * i - 1) * (2 * i)) * tc; }
    s = r * ts; c = tc;
}

template <int NC> __device__ __forceinline__ void brute_row(const bf16* q, const bf16* Kb, const bf16* Vb, size_t kstride, int nkeys, float (&o)[NC], float& lse, int lane) {
    const unsigned qw = *(const unsigned*)(q + 2 * lane); const float q0 = bflo(qw), q1 = bfhi(qw);
    float mx = -1e30f;
    for (int j = 0; j < nkeys; ++j) { const unsigned kw = *(const unsigned*)(Kb + (size_t)j * kstride + 2 * lane); const float sc = wave_sum(q0 * bflo(kw) + q1 * bfhi(kw)) * ATT_SCALE; mx = fmaxf(mx, sc); }
    float l = 0.f;
#pragma unroll
    for (int c = 0; c < NC; ++c) o[c] = 0.f;
    for (int j = 0; j < nkeys; ++j) { const unsigned kw = *(const unsigned*)(Kb + (size_t)j * kstride + 2 * lane); const float sc = wave_sum(q0 * bflo(kw) + q1 * bfhi(kw)) * ATT_SCALE;
        const float p = expf(sc - mx); l += p;
#pragma unroll
        for (int c = 0; c < NC; ++c) o[c] += p * ldbf(Vb + (size_t)j * kstride + lane * NC + c); }
#pragma unroll
    for (int c = 0; c < NC; ++c) o[c] /= l;
    lse = mx + logf(l);
}
__device__ __forceinline__ void selftest(int k, const Args& a, int gw, int NGW, int lane) {
    unsigned char* ws = a.ws; gu32* ctl = (gu32*)(ws + WS_CTL);
    const size_t gtid = (size_t)gw * 64 + lane, nth = (size_t)NGW * 64;
    const bf16* H = (const bf16*)(ws + WS_H);
    if (k == 0) {
        scan_poison(ws + WS_WIN, WS_H + 64 * MiB - WS_WIN, 1, ctl, gtid, nth);
        for (unsigned s = (unsigned)gtid; s < 1u << 20; s += (unsigned)nth) {
            const unsigned h1 = hash_u(s * 2u + 1u), h2 = hash_u(s * 2u + 2u); const int mat = s % 6;
            const float* W; const bf16* WT; int K, N; const float* sc = nullptr;
            if (mat == 0) { W = a.in[2]; WT = (const bf16*)(ws + WS_WIN); K = DM; N = NIN; }
            else if (mat == 1) { W = a.in[4]; WT = (const bf16*)(ws + WS_WA); K = 512; N = DM; }
            else if (mat == 2) { W = a.in[5]; WT = (const bf16*)(ws + WS_WB); K = 2048; N = DM; }
            else if (mat == 3) { W = a.in[6]; WT = (const bf16*)(ws + WS_WOUT); K = DM; N = DM; }
            else if (mat == 4) { W = a.in[13]; WT = (const bf16*)(ws + WS_WFF1); K = DM; N = DFF; sc = a.in[12]; }
            else { W = a.in[14]; WT = (const bf16*)(ws + WS_WFF2); K = DFF; N = DM; }
            const int kk = h1 % K, n = h2 % N; float w = W[(size_t)kk * N + n]; if (sc) w *= sc[kk];
            if (WT[(size_t)n * K + kk] != (bf16)f2bf(w)) st_flag(ctl, 1);
        }
        for (int s = gw; s < 256; s += NGW) {
            const int row = hash_u(s + 777u) % SEQ; const float* xr = a.in[0] + (size_t)row * DM; float ss = 0.f;
            for (int c = lane; c < DM; c += 64) ss += xr[c] * xr[c];
            const float rstd = rsqrtf(wave_sum(ss) * (1.f / DM) + RMS_EPS); bool bad = false;
            for (int c = lane; c < DM; c += 64) bad |= !st_close(ldbf(H + (size_t)row * DM + c), xr[c] * rstd * a.in[1][c], 0.01f, 1e-3f);
            if (bad) st_flag(ctl, 1);
        }
    } else if (k == 1) {
        { const v4u* q = (const v4u*)(ws + WS_QA); bool bad = false;
          for (size_t i = gtid; i < 296 * MiB / 16; i += nth) { const v4u w = q[i]; bad |= (w.x == 0xAAAAAAAAu) | (w.y == 0xAAAAAAAAu) | (w.z == 0xAAAAAAAAu) | (w.w == 0xAAAAAAAAu); }
          if (bad) { st_flag(ctl, 2); st_flag2(ctl, 1u); } }
        for (int s = gw; s < 16384; s += NGW) {
            const int row = (s < 64) ? (s * 131) % SEQ : hash_u(s * 2u + 1u) % SEQ, col = hash_u(s * 2u + 2u) % NIN;
            const float acc = dot_bf16(H + (size_t)row * DM, (const bf16*)(ws + WS_WIN) + (size_t)col * DM, DM, lane);
            size_t off; int ld, c0, mode;
            if (col < 1536) { off = WS_QA; ld = 1536; c0 = col; mode = 1; }
            else if (col < 3072) { off = WS_KA; ld = 1536; c0 = col - 1536; mode = 1; }
            else if (col < 4608) { off = WS_VA; ld = 1536; c0 = col - 3072; mode = 0; }
            else if (col < 6656) { off = WS_QB; ld = 2048; c0 = col - 4608; mode = 1; }
            else if (col < 8704) { off = WS_KB; ld = 2048; c0 = col - 6656; mode = 1; }
            else if (col < 10752) { off = WS_VB; ld = 2048; c0 = col - 8704; mode = 0; }
            else if (col < 14848) { off = WS_GA; ld = 4096; c0 = col - 10752; mode = 2; }
            else { off = WS_GB; ld = 4096; c0 = col - 14848; mode = 2; }
            const float got = ldbf((const bf16*)(ws + off) + (size_t)row * ld + c0);
            float want = acc; int code = 2;
            if (mode == 2) want = 1.f / (1.f + expf(-(acc + a.in[3][col - 10752])));
            else if (mode == 1 && (c0 & 127) < 32) { code = 3; const int d = c0 & 127, j = d & 15;
                const float acc2 = dot_bf16(H + (size_t)row * DM, (const bf16*)(ws + WS_WIN) + (size_t)(col ^ 16) * DM, DM, lane);
                const float inv = (float)exp2(-(double)j * (18.931568569324174 / 16.0)); const float ang = (float)row * inv;
                double sn, cs; sincos_d((double)ang, sn, cs);
                want = (d < 16) ? acc * (float)cs - acc2 * (float)sn : acc * (float)cs + acc2 * (float)sn; }
            if (mode == 2 && lane == 0) atomicAdd((unsigned*)ctl + CW_FLAG2 + 2, 1u);
            if (!st_close(got, want, 0.02f, 0.03f)) { st_flag(ctl, code);
                if (mode == 2) { const int pn = col / 256; st_flag2(ctl, (pn < 58 ? 1u : 0u) | ((pn >= 58 && pn != 73) ? 2u : 0u) | (pn == 73 ? 4u : 0u) | (((row & 255) < 128) ? 8u : 16u)); if (lane == 0) atomicAdd((unsigned*)ctl + CW_FLAG2 + 1, 1u); } }
        }
    } else if (k == 2) {
        scan_poison(ws + WS_OA, 176 * MiB, 4, ctl, gtid, nth); scan_poison(ws + WS_LSE, 3 * SEQ * 4 * 4, 4, ctl, gtid, nth);
        const float* OA = (const float*)(ws + WS_OA); const float* OB = (const float*)(ws + WS_OB); const float* LSE = (const float*)(ws + WS_LSE);
        for (int s = gw; s < 1024; s += NGW) {
            const int t = (s < 200) ? s * 3 : hash_u(s * 2u + 1u) % SEQ, ah = hash_u(s * 2u + 2u) % 12, g = ah >> 2, r = (g == 0) ? 1 : (g == 1) ? 4 : 16;
            const int i = t / r, rho = t % r, i0 = (i > 128) ? i - 128 : 0;
            const bf16* KA = (const bf16*)(ws + WS_KA) + (size_t)(rho + r * i0) * 1536 + ah * 128; const bf16* VA = (const bf16*)(ws + WS_VA) + (size_t)(rho + r * i0) * 1536 + ah * 128;
            float o[2]; float lse; brute_row<2>((const bf16*)(ws + WS_QA) + (size_t)t * 1536 + ah * 128, KA, VA, (size_t)r * 1536, i - i0 + 1, o, lse, lane);
            const float* got = OA + ((size_t)g * SEQ + t) * 512 + (ah & 3) * 128 + lane * 2;
            if (!st_close(got[0], o[0], 2e-3f, 2e-3f) || !st_close(got[1], o[1], 2e-3f, 2e-3f) || !st_close(LSE[((size_t)g * SEQ + t) * 4 + (ah & 3)], lse, 1e-3f, 2e-3f)) st_flag(ctl, 10);
        }
        for (int s = gw; s < 512; s += NGW) {
            const int t = (s < 100) ? s * 2 : hash_u(s * 2u + 1u) % SEQ, hi = hash_u(s * 2u + 2u) % 16;
            float o[4]; float lse; brute_row<4>((const bf16*)(ws + WS_QB) + (size_t)t * 2048 + hi * 128, (const bf16*)(ws + WS_KB) + hi * 128, (const bf16*)(ws + WS_VB) + (hi >> 1) * 256, (size_t)2048, t + 1, o, lse, lane);
            const float* got = OB + (size_t)t * 4096 + hi * 256 + lane * 4; bool bad = false;
#pragma unroll
            for (int c = 0; c < 4; ++c) bad |= !st_close(got[c], o[c], 2e-3f, 2e-3f);
            if (bad) st_flag(ctl, 11);
        }
    } else if (k == 3) {
        scan_poison(ws + WS_YA, 40 * MiB, 5, ctl, gtid, nth);
        const float* OA = (const float*)(ws + WS_OA); const float* OB = (const float*)(ws + WS_OB); const float* LSE = (const float*)(ws + WS_LSE);
        float d1 = 0.f, d2 = 0.f; for (int e = 0; e < 128; ++e) { d1 += a.in[7][e] * a.in[8][e]; d2 += a.in[9][e] * a.in[10][e]; }
        const float lam = expf(d1) - expf(d2) + 0.2f;
        for (int s = gw; s < 256; s += NGW) { const int t = hash_u(s + 99u) % SEQ; bool bad = false;
            for (int c = lane; c < 512; c += 64) { const int hg = c >> 7; float l[3], mx = -1e30f; for (int g = 0; g < 3; ++g) { l[g] = LSE[((size_t)g * SEQ + t) * 4 + hg]; mx = fmaxf(mx, l[g]); }
                float den = 0.f, num = 0.f; for (int g = 0; g < 3; ++g) { const float e = expf(l[g] - mx); den += e; num += e * OA[((size_t)g * SEQ + t) * 512 + c]; }
                bad |= !st_close(ldbf((const bf16*)(ws + WS_YA) + (size_t)t * 512 + c), num / den, 0.01f, 1e-3f); }
            for (int h = 0; h < 8; ++h) { float dd[4]; float ss = 0.f;
                for (int e = 0; e < 4; ++e) { const int c = lane + 64 * e; dd[e] = OB[(size_t)t * 4096 + (2 * h) * 256 + c] - lam * OB[(size_t)t * 4096 + (2 * h + 1) * 256 + c]; ss += dd[e] * dd[e]; }
                ss = wave_sum(ss); const float rstd = 0.8f / sqrtf(ss / 256.f + RMS_EPS);
                for (int e = 0; e < 4; ++e) { const int c = lane + 64 * e; bad |= !st_close(ldbf((const bf16*)(ws + WS_YB) + (size_t)t * 2048 + h * 256 + c), dd[e] * rstd * a.in[11][c], 0.01f, 2e-3f); } }
            if (bad) st_flag(ctl, 12);
        }
    } else if (k == 4) {
        scan_poison(ws + WS_T, 128 * MiB, 6, ctl, gtid, nth);
        for (int s = gw; s < 8192; s += NGW) {
            const int row = (s < 64) ? (s * 131) % SEQ : hash_u(s * 2u + 1u) % SEQ, col = hash_u(s * 2u + 2u) % DM;
            const float pa = dot_bf16((const bf16*)(ws + WS_YA) + (size_t)row * 512, (const bf16*)(ws + WS_WA) + (size_t)col * 512, 512, lane);
            const float pb = dot_bf16((const bf16*)(ws + WS_YB) + (size_t)row * 2048, (const bf16*)(ws + WS_WB) + (size_t)col * 2048, 2048, lane);
            const size_t idx = (size_t)row * DM + col;
            const float want = ldbf((const bf16*)(ws + WS_GA) + idx) * pa + ldbf((const bf16*)(ws + WS_GB) + idx) * pb;
            if (!st_close(ldbf((const bf16*)(ws + WS_MG) + idx), want, 0.02f, 0.02f)) st_flag(ctl, 6);
        }
    } else if (k == 5) {
        scan_poison(ws + WS_H, 64 * MiB, 7, ctl, gtid, nth); scan_poison(ws + WS_RSS, 2 * MiB, 7, ctl, gtid, nth);
        for (int s = gw; s < 8192; s += NGW) {
            const int row = (s < 64) ? (s * 131) % SEQ : hash_u(s * 2u + 1u) % SEQ, col = hash_u(s * 2u + 2u) % DM; const size_t idx = (size_t)row * DM + col;
            const float acc = dot_bf16((const bf16*)(ws + WS_MG) + (size_t)row * DM, (const bf16*)(ws + WS_WOUT) + (size_t)col * DM, DM, lane);
            const float want = a.in[0][idx] + acc;
            if (!st_close(ldbf(H + idx), want, 0.01f, 0.005f)) st_flag(ctl, 7);
            if (s < 512) { float ss = 0.f; for (int c = lane; c < DM; c += 64) { const float v = ldbf(H + (size_t)row * DM + c); ss += v * v; }
                ss = wave_sum(ss); const float part = wave_sum(((const float*)(ws + WS_RSS))[(size_t)row * 64 + lane]);
                if (!st_close(part, ss, 5e-3f, 1e-3f)) st_flag(ctl, 13); }
        }
    } else if (k == 6) {
        scan_poison(ws + WS_U2, 256 * MiB, 8, ctl, gtid, nth);
        for (int s = gw; s < 8192; s += NGW) {
            const int row = (s < 64) ? (s * 131) % SEQ : hash_u(s * 2u + 1u) % SEQ, col = hash_u(s * 2u + 2u) % DFF;
            const float part = wave_sum(((const float*)(ws + WS_RSS))[(size_t)row * 64 + lane]);
            const float rstd = rsqrtf(part * (1.f / DM) + RMS_EPS);
            const float acc = dot_bf16(H + (size_t)row * DM, (const bf16*)(ws + WS_WFF1) + (size_t)col * DM, DM, lane);
            float u = fmaxf(acc * rstd, 0.f); u *= u;
            if (!st_close(ldbf((const bf16*)(ws + WS_U2) + (size_t)row * DFF + col), u, 0.02f, 0.01f)) st_flag(ctl, 8);
        }
    } else if (k == 7) {
        for (int s = gw; s < 8192; s += NGW) {
            const int row = (s < 64) ? (s * 131) % SEQ : hash_u(s * 2u + 1u) % SEQ, col = hash_u(s * 2u + 2u) % DM; const size_t idx = (size_t)row * DM + col;
            const float acc = dot_bf16((const bf16*)(ws + WS_U2) + (size_t)row * DFF, (const bf16*)(ws + WS_WFF2) + (size_t)col * DFF, DFF, lane);
            const float x1 = ldbf(H + idx);
            if (!st_close(a.out[idx], x1 + acc, 0.005f, 0.01f + 0.005f * fabsf(x1))) st_flag(ctl, 9);
        }
    }
}
#endif
__device__ __forceinline__ void p0_transpose_item(const float* W, int K, int N, bf16* WT, const float* kscale, LAS unsigned* scr, int item, int lane) {
    const int nblk = N / 64, kb = item / nblk, nb = item - kb * nblk, k0 = 64 * kb, n0 = 64 * nb;
    const GAS float* src = (const GAS float*)W + (size_t)k0 * N + n0 + lane;
    float v[64];
#pragma unroll
    for (int i = 0; i < 64; ++i) v[i] = src[(size_t)i * N];
    if (kscale) {
#pragma unroll
        for (int i = 0; i < 64; ++i) v[i] *= kscale[k0 + i]; }
#pragma unroll
    for (int i = 0; i < 32; ++i) scr[lane * 33 + i] = pk2(v[2 * i], v[2 * i + 1]);
    LDS_WAIT(); asm volatile("" ::: "memory");
    const int c = lane & 7;
#pragma unroll
    for (int j = 0; j < 8; ++j) { const int n = (lane >> 3) + 8 * j; const LAS unsigned* q = scr + n * 33 + 4 * c;
        v4u o; o.x = q[0]; o.y = q[1]; o.z = q[2]; o.w = q[3];
        *(GAS v4u*)(WT + (size_t)(n0 + n) * K + k0 + 8 * c) = o; }
    LDS_WAIT(); asm volatile("" ::: "memory");
}
template <bool OUT_BF16> __device__ __forceinline__ void rms_row(const float* xrow, const float* g, void* orow, int lane, float oscale = 1.f) {
    const GAS f32x4* xr = (const GAS f32x4*)xrow + lane; const GAS f32x4* gr = (const GAS f32x4*)g + lane;
    f32x4 v[16], gq[16]; float s = 0.f;
#pragma unroll
    for (int j = 0; j < 16; ++j) v[j] = xr[64 * j];
#pragma unroll
    for (int j = 0; j < 16; ++j) gq[j] = gr[64 * j];
#pragma unroll
    for (int j = 0; j < 16; ++j) s += (v[j].x * v[j].x + v[j].y * v[j].y) + (v[j].z * v[j].z + v[j].w * v[j].w);
    const float rstd = rsqrtf(wave_sum(s) * (1.f / DM) + RMS_EPS) * oscale;
#pragma unroll
    for (int j = 0; j < 16; ++j) { const f32x4 o = v[j] * rstd * gq[j];
        if (OUT_BF16) { v2u w; w.x = pk2(o.x, o.y); w.y = pk2(o.z, o.w); ((GAS v2u*)orow)[lane + 64 * j] = w; }
        else ((GAS f32x4*)orow)[lane + 64 * j] = o; }
}
__device__ __forceinline__ void p0_prologue(const Args& a, LAS unsigned char* L, int gw, int NGW, int wave, int lane) {
    LAS unsigned* scr = (LAS unsigned*)(L + wave * 16384);
    unsigned char* ws = a.ws;
    constexpr int I_IN = (DM / 64) * (NIN / 64), I_2 = (DFF / 64) * (DM / 64);
    for (int it = gw; it < I_IN + I_2; it += NGW) {
        if (it < I_IN) p0_transpose_item(a.in[2], DM, NIN, (bf16*)(ws + WS_WIN), nullptr, scr, it, lane);
        else p0_transpose_item(a.in[14], DFF, DM, (bf16*)(ws + WS_WFF2), nullptr, scr, it - I_IN, lane);
    }
    for (int m = gw; m < SEQ; m += NGW) rms_row<true>(a.in[0] + (size_t)m * DM, a.in[1], (bf16*)(ws + WS_H) + (size_t)m * DM, lane);
}
__device__ __forceinline__ void p0_convert_rest(const Args& a, LAS unsigned char* L, int cw, int NCW, int wave, int lane) {
    LAS unsigned* scr = (LAS unsigned*)(L + wave * 16384);
    unsigned char* ws = a.ws;
    constexpr int I_A = (512 / 64) * (DM / 64), I_B = (2048 / 64) * (DM / 64), I_O = (DM / 64) * (DM / 64), I_1 = (DM / 64) * (DFF / 64);
    constexpr int NITEMS = I_A + I_B + I_O + I_1;
    for (int it = cw; it < NITEMS; it += NCW) {
        int r = it;
        if (r < I_A) { p0_transpose_item(a.in[4], 512, DM, (bf16*)(ws + WS_WA), nullptr, scr, r, lane); continue; } r -= I_A;
        if (r < I_B) { p0_transpose_item(a.in[5], 2048, DM, (bf16*)(ws + WS_WB), nullptr, scr, r, lane); continue; } r -= I_B;
        if (r < I_O) { p0_transpose_item(a.in[6], DM, DM, (bf16*)(ws + WS_WOUT), nullptr, scr, r, lane); continue; } r -= I_O;
        p0_transpose_item(a.in[13], DM, DFF, (bf16*)(ws + WS_WFF1), a.in[12], scr, r, lane);
    }
}

template <int DV> __device__ __forceinline__ void naive_row(const bf16* q, const bf16* Kb, const bf16* Vb, size_t kstride, int nkeys, LAS float* qs, LAS float* ps, float (&o)[DV / 64], float& lse, int lane) {
    constexpr int NC = DV / 64;
    { const unsigned w = *(const unsigned*)(q + 2 * lane); qs[2 * lane] = bflo(w); qs[2 * lane + 1] = bfhi(w); }
    LDS_WAIT(); asm volatile("" ::: "memory");
    float m = -1e30f, l = 0.f;
#pragma unroll
    for (int c = 0; c < NC; ++c) o[c] = 0.f;
    for (int c0 = 0; c0 < nkeys; c0 += 64) {
        const int j = c0 + lane; const bool valid = j < nkeys;
        float s = -__builtin_inff();
        if (valid) { const v4u* kp = (const v4u*)(Kb + (size_t)j * kstride); float acc = 0.f;
#pragma unroll 4
            for (int d = 0; d < 16; ++d) { const v4u kv = kp[d]; const LAS float* qq = qs + 8 * d;
                acc += bflo(kv.x) * qq[0] + bfhi(kv.x) * qq[1] + bflo(kv.y) * qq[2] + bfhi(kv.y) * qq[3] + bflo(kv.z) * qq[4] + bfhi(kv.z) * qq[5] + bflo(kv.w) * qq[6] + bfhi(kv.w) * qq[7]; }
            s = acc * ATT_SCALE; }
        const float mn = fmaxf(m, wave_max(s));
        const float p = valid ? __expf(s - mn) : 0.f;
        const float alpha = __expf(m - mn);
        l = l * alpha + wave_sum(p); m = mn;
#pragma unroll
        for (int c = 0; c < NC; ++c) o[c] *= alpha;
        ps[lane] = p; LDS_WAIT(); asm volatile("" ::: "memory");
        const int cnt = (nkeys - c0) < 64 ? (nkeys - c0) : 64;
        const bf16* vp = Vb + (size_t)c0 * kstride + lane * NC;
#pragma unroll 4
        for (int kk = 0; kk < cnt; ++kk) { const float pj = ps[kk];
            if constexpr (NC == 2) { const unsigned w = *(const unsigned*)(vp + (size_t)kk * kstride); o[0] += pj * bflo(w); o[1] += pj * bfhi(w); }
            else { const v2u w = *(const v2u*)(vp + (size_t)kk * kstride); o[0] += pj * bflo(w.x); o[1] += pj * bfhi(w.x); o[NC - 2] += pj * bflo(w.y); o[NC - 1] += pj * bfhi(w.y); } }
        LDS_WAIT(); asm volatile("" ::: "memory");
    }
    const float inv = 1.f / l;
#pragma unroll
    for (int c = 0; c < NC; ++c) o[c] *= inv;
    lse = m + __logf(l);
}
__device__ __forceinline__ void p2_attention_naive(const Args& a, LAS unsigned char* L, int gw, int NGW, int wave, int lane) {
    unsigned char* ws = a.ws;
    LAS float* qs = (LAS float*)(L + wave * 1024); LAS float* ps = qs + 128;
    const bf16* QA = (const bf16*)(ws + WS_QA); const bf16* KA = (const bf16*)(ws + WS_KA); const bf16* VA = (const bf16*)(ws + WS_VA);
    const bf16* QB = (const bf16*)(ws + WS_QB); const bf16* KB = (const bf16*)(ws + WS_KB); const bf16* VB = (const bf16*)(ws + WS_VB);
    float* OA = (float*)(ws + WS_OA); float* OB = (float*)(ws + WS_OB); float* LSE = (float*)(ws + WS_LSE);
    for (int it = gw; it < SEQ * 12; it += NGW) {
        const int t = it / 12, ah = it - t * 12, g = ah >> 2, r = (g == 0) ? 1 : (g == 1) ? 4 : 16;
        const int i = t / r, rho = t - i * r, i0 = (i - 128) > 0 ? (i - 128) : 0, nkeys = i - i0 + 1;
        const size_t first = (size_t)(rho + r * i0) * 1536 + ah * 128;
        float o[2]; float lse;
        naive_row<128>(QA + (size_t)t * 1536 + ah * 128, KA + first, VA + first, (size_t)r * 1536, nkeys, qs, ps, o, lse, lane);
        float* op = OA + ((size_t)g * SEQ + t) * 512 + (ah & 3) * 128 + lane * 2; op[0] = o[0]; op[1] = o[1];
        if (lane == 0) LSE[((size_t)g * SEQ + t) * 4 + (ah & 3)] = lse;
    }
    for (int it = gw; it < SEQ * 16; it += NGW) {
        const int t = it >> 4, hi = it & 15;
        float o[4]; float lse;
        naive_row<256>(QB + (size_t)t * 2048 + hi * 128, KB + hi * 128, VB + (hi >> 1) * 256, (size_t)2048, t + 1, qs, ps, o, lse, lane);
        *(f32x4*)(OB + (size_t)t * 4096 + hi * 256 + lane * 4) = (f32x4){o[0], o[1], o[2], o[3]};
    }
}
__device__ __forceinline__ void p2_make_block(unsigned char* ws, int vcu, int k, swa::BlockRef& b) {
    if (k < 4) {
        const int item = vcu + 256 * (k >> 1), vh = item >> 4, x = item & 15, hi = vh >> 1, vhalf = vh & 1, qb = (k & 1) ? 31 - x : x;
        b.Q = (const swa::bf16*)(ws + WS_QB) + (size_t)(qb * 256) * 2048 + hi * 128; b.K = (const swa::bf16*)(ws + WS_KB) + hi * 128; b.V = (const swa::bf16*)(ws + WS_VB) + (hi >> 1) * 256 + vhalf * 128;
        b.O = (float*)(ws + WS_OB) + (size_t)(qb * 256) * 4096 + hi * 256 + vhalf * 128; b.L = nullptr;
        b.P0 = qb * 256; b.qp = 2048; b.kp = 2048; b.op = 4096; b.lp = 0; b.skv = SEQ; b.W = 1 << 20;
    } else {
        const int ab = vcu + 256 * (k - 4), g = ab >> 7, idx = ab & 127, hg = idx >> 5, rem = idx & 31;
        const int r = (g == 0) ? 1 : (g == 1) ? 4 : 16, rho = (g == 0) ? 0 : (g == 1) ? (rem >> 3) : (rem >> 1), qb = (g == 0) ? rem : (g == 1) ? (rem & 7) : (rem & 1), ah = g * 4 + hg;
        const size_t row0 = (size_t)rho + (size_t)r * (qb * 256);
        b.Q = (const swa::bf16*)(ws + WS_QA) + row0 * 1536 + ah * 128; b.K = (const swa::bf16*)(ws + WS_KA) + (size_t)rho * 1536 + ah * 128; b.V = (const swa::bf16*)(ws + WS_VA) + (size_t)rho * 1536 + ah * 128;
        b.O = (float*)(ws + WS_OA) + ((size_t)g * SEQ + row0) * 512 + hg * 128; b.L = (float*)(ws + WS_LSE) + ((size_t)g * SEQ + row0) * 4 + hg;
        b.P0 = qb * 256; b.qp = r * 1536; b.kp = r * 1536; b.op = r * 512; b.lp = r * 4; b.skv = SEQ / r; b.W = 129;
    }
}
__device__ __forceinline__ void p2_attention_mfma(unsigned char* ws, char* lds, int vcu, int reps) {
    swa::Seam S; swa::BlockRef cur, nxt;
    const int nb1 = (vcu < 128) ? 6 : 5, nblk = nb1 * reps;
    p2_make_block(ws, vcu, 0, cur);
    swa::causal_swa_prime(cur, lds, S);
    for (int k = 0; k < nblk; ++k) {
        if (k + 1 < nblk) p2_make_block(ws, vcu, (k + 1) % nb1, nxt); else nxt = cur;
        swa::causal_swa_block(cur, nxt, lds, S);
        cur = nxt;
    }
}
__device__ __forceinline__ void p2_make_block2(unsigned char* ws, int vcu, int k, att2::BlockRef& b) {
    if (k < 2) {
        const int hi = vcu >> 4, x = vcu & 15, qb = (k & 1) ? 31 - x : x;
        b.Q = (const att2::bf16*)(ws + WS_QB) + (size_t)(qb * 256) * 2048 + hi * 128; b.K = (const att2::bf16*)(ws + WS_KB) + hi * 128; b.V = (const att2::bf16*)(ws + WS_VB) + (hi >> 1) * 256;
        b.O = (float*)(ws + WS_OB) + (size_t)(qb * 256) * 4096 + hi * 256; b.L = nullptr;
        b.P0 = qb * 256; b.qp = 2048; b.kp = 2048; b.op = 4096; b.lp = 0; b.skv = SEQ; b.W = 1 << 20; b.dvs = 256;
    } else {
        const int ab = vcu + 256 * (k - 2), g = ab >> 7, idx = ab & 127, hg = idx >> 5, rem = idx & 31;
        const int r = (g == 0) ? 1 : (g == 1) ? 4 : 16, rho = (g == 0) ? 0 : (g == 1) ? (rem >> 3) : (rem >> 1), qb = (g == 0) ? rem : (g == 1) ? (rem & 7) : (rem & 1), ah = g * 4 + hg;
        const size_t row0 = (size_t)rho + (size_t)r * (qb * 256);
        b.Q = (const att2::bf16*)(ws + WS_QA) + row0 * 1536 + ah * 128; b.K = (const att2::bf16*)(ws + WS_KA) + (size_t)rho * 1536 + ah * 128; b.V = (const att2::bf16*)(ws + WS_VA) + (size_t)rho * 1536 + ah * 128;
        b.O = (float*)(ws + WS_OA) + ((size_t)g * SEQ + row0) * 512 + hg * 128; b.L = (float*)(ws + WS_LSE) + ((size_t)g * SEQ + row0) * 4 + hg;
        b.P0 = qb * 256; b.qp = r * 1536; b.kp = r * 1536; b.op = r * 512; b.lp = r * 4; b.skv = SEQ / r; b.W = 129; b.dvs = 128;
    }
}
__device__ __forceinline__ void p2_attention_att2(unsigned char* ws, LAS unsigned char* lds, int vcu, int reps) {
    const int nb1 = (vcu < 128) ? 4 : 3, nblk = nb1 * reps;
    for (int k = 0; k < nblk; ++k) { att2::BlockRef b; p2_make_block2(ws, vcu, k % nb1, b); att2::block(b, lds); }
}
__device__ __forceinline__ void p3_combine(const Args& a, int gw, int NGW, int lane) {
    unsigned char* ws = a.ws;
    const float* OA = (const float*)(ws + WS_OA); const float* OB = (const float*)(ws + WS_OB); const float* LSE = (const float*)(ws + WS_LSE);
    bf16* YA = (bf16*)(ws + WS_YA); bf16* YB = (bf16*)(ws + WS_YB);
    float d1 = a.in[7][lane] * a.in[8][lane] + a.in[7][lane + 64] * a.in[8][lane + 64];
    float d2 = a.in[9][lane] * a.in[10][lane] + a.in[9][lane + 64] * a.in[10][lane + 64];
    d1 = wave_sum(d1); d2 = wave_sum(d2);
    const float lam_init = 0.2f;
    const float lam = expf(d1) - expf(d2) + lam_init;
    const f32x4 sg = *(const f32x4*)(a.in[11] + lane * 4);
    for (int t = gw; t < SEQ; t += NGW) {
        const int hg = lane >> 4;
        const float l0 = LSE[((size_t)0 * SEQ + t) * 4 + hg], l1 = LSE[((size_t)1 * SEQ + t) * 4 + hg], l2 = LSE[((size_t)2 * SEQ + t) * 4 + hg];
        const f32x4* p0 = (const f32x4*)(OA + ((size_t)0 * SEQ + t) * 512 + lane * 8); const f32x4* p1 = (const f32x4*)(OA + ((size_t)1 * SEQ + t) * 512 + lane * 8); const f32x4* p2 = (const f32x4*)(OA + ((size_t)2 * SEQ + t) * 512 + lane * 8);
        const f32x4 a00 = p0[0], a01 = p0[1], a10 = p1[0], a11 = p1[1], a20 = p2[0], a21 = p2[1];
        f32x4 o1[8], o2[8];
#pragma unroll
        for (int h = 0; h < 8; ++h) { o1[h] = *(const f32x4*)(OB + (size_t)t * 4096 + (2 * h) * 256 + lane * 4); o2[h] = *(const f32x4*)(OB + (size_t)t * 4096 + (2 * h + 1) * 256 + lane * 4); }
        { const float mx = fmaxf(l0, fmaxf(l1, l2)); const float e0 = expf(l0 - mx), e1 = expf(l1 - mx), e2 = expf(l2 - mx); const float inv = 1.f / (e0 + e1 + e2);
          const float w0 = e0 * inv, w1 = e1 * inv, w2 = e2 * inv;
          const f32x4 x0 = a00 * w0 + a10 * w1 + a20 * w2, x1 = a01 * w0 + a11 * w1 + a21 * w2;
          v4u w; w.x = pk2(x0.x, x0.y); w.y = pk2(x0.z, x0.w); w.z = pk2(x1.x, x1.y); w.w = pk2(x1.z, x1.w);
          *(v4u*)(YA + (size_t)t * 512 + lane * 8) = w; }
#pragma unroll
        for (int h = 0; h < 8; ++h) {
            const f32x4 d = o1[h] - o2[h] * lam;
            const float ss = wave_sum((d.x * d.x + d.y * d.y) + (d.z * d.z + d.w * d.w));
            const float rstd = rsqrtf(ss * (1.f / 256.f) + RMS_EPS) * (1.f - lam_init);
            const f32x4 y = d * rstd * sg;
            v2u w; w.x = pk2(y.x, y.y); w.y = pk2(y.z, y.w);
            *(v2u*)(YB + (size_t)t * 2048 + h * 256 + lane * 4) = w;
        }
    }
}

__device__ __forceinline__ int lane_id() { return (int)__builtin_amdgcn_mbcnt_hi(~0u, __builtin_amdgcn_mbcnt_lo(~0u, 0u)); }
__device__ __forceinline__ const float* uload_ptr(const LAS unsigned long long* p) { const unsigned long long v = *p;
    const unsigned lo = __builtin_amdgcn_readfirstlane((unsigned)v), hi = __builtin_amdgcn_readfirstlane((unsigned)(v >> 32)); return (const float*)(const GAS float*)(((unsigned long long)hi << 32) | lo); }
__global__ void __launch_bounds__(NWAVES * 64, 2) fwd(Args args) {
    extern __shared__ __attribute__((aligned(16))) unsigned char lds[];
    LAS unsigned char* L = (LAS unsigned char*)lds;
    volatile LAS unsigned* MISC = (volatile LAS unsigned*)(L + MISC_OFF);
    const int tid = threadIdx.x, wave = __builtin_amdgcn_readfirstlane(tid >> 6);
#define lane lane_id()
    const int G = gridDim.x, bx = blockIdx.x;
    const int vcu = (G % 8 == 0) ? (bx % 8) * (G / 8) + bx / 8 : bx;
    const int gw = vcu * NWAVES + wave, NGW = G * NWAVES;
    unsigned char* ws = args.ws;
    gu32* ctl = (gu32*)(ws + WS_CTL);
    for (int u = tid; u < (LDS_BYTES - LDSCTL_OFF) / 4; u += NWAVES * 64) ((LAS unsigned*)(L + LDSCTL_OFF))[u] = 0u;
    __syncthreads();
    LAS unsigned long long* ptab = (LAS unsigned long long*)(L + PTAB_OFF);
    if (tid == 0) {
#pragma unroll
        for (int k = 0; k < 16; ++k) ptab[k] = (unsigned long long)args.in[k]; }
    __syncthreads();
#define PIN(k) uload_ptr(ptab + (k))
    const int lo = args.ph_lo, hi = args.ph_hi;
    const bool multi = (hi - lo) > 1;
    XcdBarrier bar; bar.bar = (unsigned*)(ctl + CW_BAR); bar.x = 0; bar.st = nullptr;
    if (multi) bar = xcd_barrier_post((unsigned*)(ctl + CW_BAR), MISC + 8);
#ifdef SELFTEST
    if (lo >= 16) { selftest(lo - 16, args, gw, NGW, lane); return; }
#endif
#define IN(k) (lo <= (k) && (k) < hi)
#ifdef SELFTEST
#define SEAM(k) do { if (IN(k) && IN((k) + 1)) { xcd_barrier(bar); selftest((k), args, gw, NGW, lane); xcd_barrier(bar); } } while (0)
#elif defined(DIAG_PHASE)
#define SEAM(k) do { if (IN(k) && IN((k) + 1)) { xcd_barrier(bar); if (blockIdx.x == 0 && threadIdx.x == 0) ((unsigned long long*)(args.ws + 2048))[(k) + 1] = __builtin_amdgcn_s_memrealtime(); } } while (0)
#else
#define SEAM(k) do { if (IN(k) && IN((k) + 1)) xcd_barrier(bar); } while (0)
#endif

#ifndef PROBE_REPEAT
#define PROBE_REPEAT -1
#endif
#define NREP(k) ((PROBE_REPEAT == (k)) ? 2 : 1)
#ifdef DIAG_PHASE
    if (blockIdx.x == 0 && threadIdx.x == 0) ((unsigned long long*)(args.ws + 2048))[0] = __builtin_amdgcn_s_memrealtime();
#endif
    if (IN(0)) { Args la; la.ws = ws; la.in[0] = PIN(0); la.in[1] = PIN(1); la.in[2] = PIN(2); la.in[14] = PIN(14);
        for (int rep_ = 0; rep_ < NREP(0); ++rep_) p0_prologue(la, L, gw, NGW, wave, lane); SEAM(0); }

    if (IN(1)) {
        pg8::Gemm g{(const bf16*)(ws + WS_H), (const bf16*)(ws + WS_WIN), SEQ, NIN, DM}; pg8::StaticOrder S; S.init(SEQ, NIN, G, bx); S.rep = NREP(1);
        pg8::EpiProj E{ws, PIN(3)};
        pg8::gemm_phase<pg8::EpiProj, pg8::StaticOrder, true, true>(L, g, S, E);
        { const int extra = ((SEQ / 256) * (NIN / 256)) % G;
          if (bx >= extra) { Args la; la.ws = ws; la.in[4] = PIN(4); la.in[5] = PIN(5); la.in[6] = PIN(6); la.in[12] = PIN(12); la.in[13] = PIN(13);
              p0_convert_rest(la, L, (bx - extra) * NWAVES + wave, (G - extra) * NWAVES, wave, lane); } }
        SEAM(1);
    }
#ifdef NAIVE_ATTN
    if (IN(2)) { p2_attention_naive(args, L, gw, NGW, wave, lane); SEAM(2); }
#elif defined(ATT_SWA)
    if (IN(2)) { p2_attention_mfma(ws, (char*)lds, vcu, NREP(2)); SEAM(2); }
#else
    if (IN(2)) { p2_attention_att2(ws, L, vcu, NREP(2)); SEAM(2); }
#endif
    if (IN(3)) { Args la; la.ws = ws; la.in[7] = PIN(7); la.in[8] = PIN(8); la.in[9] = PIN(9); la.in[10] = PIN(10); la.in[11] = PIN(11);
        for (int rep_ = 0; rep_ < NREP(3); ++rep_) p3_combine(la, gw, NGW, lane); SEAM(3); }
    if (IN(4)) {
        { pg8::Gemm g{(const bf16*)(ws + WS_YA), (const bf16*)(ws + WS_WA), SEQ, DM, 512}; pg8::StaticOrder S; S.init(SEQ, DM, G, bx);
          pg8::EpiGate<false> E{(const bf16*)(ws + WS_GA), nullptr, (bf16*)(ws + WS_T)};
          pg8::gemm_phase<pg8::EpiGate<false>, pg8::StaticOrder, true, true>(L, g, S, E); }
        VM_WAIT(); __syncthreads();
        { pg8::Gemm g{(const bf16*)(ws + WS_YB), (const bf16*)(ws + WS_WB), SEQ, DM, 2048}; pg8::StaticOrder S; S.init(SEQ, DM, G, bx);
          pg8::EpiGate<true> E{(const bf16*)(ws + WS_GB), (const bf16*)(ws + WS_T), (bf16*)(ws + WS_MG)};
          pg8::gemm_phase<pg8::EpiGate<true>, pg8::StaticOrder, true, true>(L, g, S, E); }
        SEAM(4);
    }
    if (IN(5)) {
        pg8::Gemm g{(const bf16*)(ws + WS_MG), (const bf16*)(ws + WS_WOUT), SEQ, DM, DM}; pg8::StaticOrder S; S.init(SEQ, DM, G, bx); S.rep = NREP(5);
        pg8::EpiResid<true> E{PIN(0), args.out, (bf16*)(ws + WS_H), (float*)(ws + WS_RSS)};
        pg8::gemm_phase<pg8::EpiResid<true>, pg8::StaticOrder, true, true>(L, g, S, E);
        SEAM(5);
    }
    if (IN(6)) {
        pg8::Gemm g{(const bf16*)(ws + WS_H), (const bf16*)(ws + WS_WFF1), SEQ, DFF, DM}; pg8::StaticOrder S; S.init(SEQ, DFF, G, bx); S.rep = NREP(6);
        pg8::Unit u0, ui; u0.pm = 0; u0.pn = 0; bool same = S.next(0, u0);
        for (int i = 1; S.next(i, ui); ++i) same = same && (ui.pm == u0.pm);
        if (same) {
            LAS float* rtab = (LAS float*)(L + RTAB_OFF);
            { const int tid6 = wave * 64 + lane; const int row = tid6 >> 1, half = tid6 & 1; const f32x4* rp = (const f32x4*)((const float*)(ws + WS_RSS) + ((size_t)u0.pm * 256 + row) * 64 + half * 32); float t = 0.f;
#pragma unroll
              for (int j = 0; j < 8; ++j) { const f32x4 v = rp[j]; t += (v.x + v.y) + (v.z + v.w); }
              t += __shfl_xor(t, 1);
              if (half == 0) rtab[row] = rsqrtf(t * (1.0f / DM) + RMS_EPS); }
            __syncthreads();
            pg8::EpiRelu2<true> E{(bf16*)(ws + WS_U2), nullptr, rtab};
            pg8::gemm_phase<pg8::EpiRelu2<true>, pg8::StaticOrder, true, true>(L, g, S, E);
        } else {
            pg8::EpiRelu2<false> E{(bf16*)(ws + WS_U2), (const float*)(ws + WS_RSS), nullptr};
            pg8::gemm_phase<pg8::EpiRelu2<false>, pg8::StaticOrder, true, true>(L, g, S, E);
        }
        SEAM(6);
    }
    if (IN(7)) {
        pg8::Gemm g{(const bf16*)(ws + WS_U2), (const bf16*)(ws + WS_WFF2), SEQ, DM, DFF}; pg8::StaticOrder S; S.init(SEQ, DM, G, bx);
        pg8::EpiResid<false> E{args.out, args.out, nullptr, nullptr};
        pg8::gemm_phase<pg8::EpiResid<false>, pg8::StaticOrder, true, true>(L, g, S, E);
        SEAM(7);
    }
    if (IN(8)) {
        if (NREP(8) > 1) { for (int m = gw; m < SEQ; m += NGW) rms_row<false>(args.out + (size_t)m * DM, PIN(15), (float*)(ws + WS_T) + (size_t)m * DM, lane); }
#ifdef DIAG_PHASE
        {
            const unsigned long long t0 = __hip_atomic_load((unsigned long long*)(args.ws + 2048) + DIAG_PHASE, RLX_AGENT), t1 = __hip_atomic_load((unsigned long long*)(args.ws + 2048) + DIAG_PHASE + 1, RLX_AGENT);
            const float cv = (float)(t1 - t0) * 0.001f;
            for (int m = gw; m < SEQ; m += NGW) for (int c = lane; c < DM; c += 64) args.out[(size_t)m * DM + c] = cv; }
        if (false)
#endif
#ifdef SELFTEST
        const unsigned f = __hip_atomic_load((unsigned*)ctl + CW_FLAG, RLX_AGENT) & ~(unsigned)(SELFTEST_IGNORE);
        if (f) { const unsigned f2 = __hip_atomic_load((unsigned*)ctl + CW_FLAG2, RLX_AGENT), nf = __hip_atomic_load((unsigned*)ctl + CW_FLAG2 + 1, RLX_AGENT), nt = __hip_atomic_load((unsigned*)ctl + CW_FLAG2 + 2, RLX_AGENT);
            const float cv1 = f2 ? (float)f2 : (float)__builtin_ctz(f), cv2 = nt ? 1.f + (float)((nf * 30u) / nt) : 0.f;
            for (int m = gw; m < SEQ; m += NGW) for (int c = lane; c < DM; c += 64) args.out[(size_t)m * DM + c] = (m < SEQ / 2) ? cv1 : cv2; }
        else
#endif
        for (int m = gw; m < SEQ; m += NGW) rms_row<false>(args.out + (size_t)m * DM, PIN(15), args.out + (size_t)m * DM, lane);
    }
#undef IN
#undef SEAM
#undef lane
#undef PIN
}

extern "C" void kernel_launch(void* const* d_in, const int* in_sizes, int n_in, void* d_out, int out_size, void* d_ws, size_t ws_size, hipStream_t stream) {
    static int grid = 0;
    if (grid == 0) {
        if (n_in != 16 || in_sizes[0] != SEQ * DM || out_size != SEQ * DM || ws_size < WS_END) { fprintf(stderr, "kernel_launch: shape/workspace mismatch (n_in %d, in0 %d, out %d, ws %zu, need %zu); nothing launched\n", n_in, n_in > 0 ? in_sizes[0] : -1, out_size, ws_size, (size_t)WS_END); grid = -1; return; }
        int dev = 0, cus = 0;
        if (hipGetDevice(&dev) != hipSuccess || hipDeviceGetAttribute(&cus, hipDeviceAttributeMultiprocessorCount, dev) != hipSuccess) { grid = -1; return; }
        if (hipFuncSetAttribute((const void*)fwd, hipFuncAttributeMaxDynamicSharedMemorySize, LDS_BYTES) != hipSuccess) { fprintf(stderr, "kernel_launch: hipFuncSetAttribute failed\n"); grid = -1; return; }
        (void)hipGetLastError();
        grid = cus;
    }
    if (grid < 0) return;
    if (hipMemsetAsync((char*)d_ws + WS_CTL, 0, CTL_ZERO_BYTES, stream) != hipSuccess) return;
    Args a{};
    for (int i = 0; i < 16; ++i) a.in[i] = (const float*)d_in[i];
    a.out = (float*)d_out; a.ws = (unsigned char*)d_ws;
    constexpr int NL = MK_N_LAUNCHES;
    static_assert(NL == 1 || NL == N_PHASES, "MK_N_LAUNCHES is 1 or N_PHASES");
    for (int li = 0; li < NL; ++li) {
        a.ph_lo = (NL == 1) ? 0 : li; a.ph_hi = (NL == 1) ? N_PHASES : li + 1;
        hipLaunchKernelGGL(fwd, dim3(grid), dim3(NWAVES * 64), LDS_BYTES, stream, a);
        const hipError_t le = hipPeekAtLastError();
        if (le != hipSuccess) { fprintf(stderr, "kernel_launch: launch %d failed: %s\n", li, hipGetErrorName(le)); break; }
#ifdef SELFTEST
        if (NL == N_PHASES && li < 8) { Args c = a; c.ph_lo = 16 + li; c.ph_hi = 17 + li; hipLaunchKernelGGL(fwd, dim3(grid), dim3(NWAVES * 64), LDS_BYTES, stream, c); }
#endif
    }
}
```

```cpp
#include <hip/hip_runtime.h>
#include <cstdio>
#include <cstdint>
constexpr int SEQ = 8192, DM = 4096, NIN = 18944, DFF = 16384;
constexpr int NWAVES = 8;
constexpr float RMS_EPS = 1e-6f;
constexpr float ATT_SCALE = 0.08838834764831845f;
constexpr int N_PHASES = 9;
#ifndef MK_N_LAUNCHES
#define MK_N_LAUNCHES 1
#endif
constexpr size_t MiB = 1u << 20;
constexpr size_t WS_CTL = 0, CTL_ZERO_BYTES = 1 * MiB;
constexpr size_t WS_WIN = 1 * MiB;
constexpr size_t WS_WA = 149 * MiB;
constexpr size_t WS_WB = 153 * MiB;
constexpr size_t WS_WOUT = 169 * MiB;
constexpr size_t WS_WFF1 = 201 * MiB;
constexpr size_t WS_WFF2 = 329 * MiB;
constexpr size_t WS_H = 457 * MiB;
constexpr size_t WS_YA = 521 * MiB;
constexpr size_t WS_YB = 529 * MiB;
constexpr size_t WS_T = 561 * MiB;
constexpr size_t WS_MG = 625 * MiB;
constexpr size_t WS_RSS = 689 * MiB;
constexpr size_t WS_LSE = 691 * MiB;
constexpr size_t WS_R1 = 692 * MiB;
constexpr size_t WS_QA = WS_R1, WS_KA = WS_R1 + 24 * MiB, WS_VA = WS_R1 + 48 * MiB;
constexpr size_t WS_QB = WS_R1 + 72 * MiB, WS_KB = WS_R1 + 104 * MiB, WS_VB = WS_R1 + 136 * MiB;
constexpr size_t WS_GA = WS_R1 + 168 * MiB, WS_GB = WS_R1 + 232 * MiB;
constexpr size_t WS_OA = WS_R1 + 296 * MiB;
constexpr size_t WS_OB = WS_R1 + 344 * MiB;
constexpr size_t WS_U2 = WS_R1;
constexpr size_t WS_END = WS_R1 + 472 * MiB;
constexpr int CW_BAR = 4096;
constexpr int RING_BYTES = 131072, LDSCTL_OFF = RING_BYTES, MISC_OFF = LDSCTL_OFF + 320, PTAB_OFF = LDSCTL_OFF + 512, RTAB_OFF = LDSCTL_OFF + 1024, LDS_BYTES = 147456;
namespace pg8 {
#define PG8_LAS __attribute__((address_space(3)))
typedef unsigned short bf16_t;
typedef short bf16x8 __attribute__((ext_vector_type(8)));
typedef float f32x4 __attribute__((ext_vector_type(4)));
typedef unsigned u32x4 __attribute__((ext_vector_type(4)));
constexpr int BM = 256, BK = 64, HALF = 128, HTB = HALF * BK * 2  , STAGE_BYTES = 8 * HTB, NXCD = 8, WGM = 8;

__host__ __device__ __forceinline__ int lds_byte(int r, int c) { const int st = (r >> 4) * 2 + (c >> 5), rr = r & 15, cc = c & 31, ob = rr * 64 + cc * 2; return st * 1024 + (ob ^ (((ob >> 9) & 1) << 5)); }
__host__ __device__ __forceinline__ void stage_rc(int b, int& R, int& C) { const int st = b / 1024, sb = b % 1024, swz = sb ^ (((sb >> 9) & 1) << 5); R = (st >> 1) * 16 + swz / 64; C = (st & 1) * 32 + (swz % 64) / 2; }
__host__ __device__ __forceinline__ int perm32(int rho) { const int n = rho >> 4, i = rho & 15; return 8 * (i >> 2) + 4 * n + (i & 3); }

struct Unit { int pm, pn; };
struct Gemm { const bf16_t* A; const bf16_t* Bt; int M, N, K; };

struct StaticOrder {
    int nM, nN, nwg, G, c, rep;
    __host__ __device__ void init(int M, int N, int G_, int c_) { nM = M / BM; nN = N / BM; nwg = nM * nN; G = G_; c = c_; rep = 1; }
    __host__ __device__ bool next(int i, Unit& u) const {
        if (rep > 1) { const int per = (nwg - c + G - 1) / G; if (i >= per * rep) return false; i = i % per; }
        const long L = (long)i * G + c; if (L >= nwg) return false;
        int wgid = (int)L; { const int q = nwg / NXCD, r = nwg % NXCD, xcd = wgid % NXCD, off = wgid / NXCD; wgid = (xcd < r ? xcd * (q + 1) : r * (q + 1) + (xcd - r) * q) + off; }
        const int nig = WGM * nN, gid = wgid / nig, fm = gid * WGM, gsz = (nM - fm) < WGM ? (nM - fm) : WGM;
        u.pm = fm + ((wgid % nig) % gsz); u.pn = (wgid % nig) / gsz; return true;
    }
    __device__ __forceinline__ void a_ready(const Unit&) const {}
    __device__ __forceinline__ void done(const Unit&) const {}
};

typedef float f32x2c_t __attribute__((ext_vector_type(2))); typedef __bf16 bf16x2c_t __attribute__((ext_vector_type(2)));
__device__ __forceinline__ unsigned cvt_pk_bf16(float lo, float hi) { const f32x2c_t v = {lo, hi}; const bf16x2c_t b = __builtin_convertvector(v, bf16x2c_t); return __builtin_bit_cast(unsigned, b); }
typedef float f32x2 __attribute__((ext_vector_type(2)));
template <class Epi, class Sched, bool ALIGN_EPI = false, bool SP2 = false>
__device__ __forceinline__ void gemm_phase(PG8_LAS unsigned char* lds, const Gemm g, const Sched& S, const Epi& E) {
    const int tid = threadIdx.x, wid = __builtin_amdgcn_readfirstlane(tid >> 6), lane = tid & 63, wr = wid >> 2, wc = wid & 3, fr = lane & 15, fq = lane >> 4;
    const int K = g.K, nt = K / BK;
    unsigned voffA[2], voffB[2];
#pragma unroll
    for (int i = 0; i < 2; ++i) { int R, C; stage_rc(tid * 16 + i * 8192, R, C); const int Rb = Epi::PERM ? ((R & ~31) + perm32(R & 31)) : R;
        voffA[i] = (unsigned)(R * K + C) * 2u; voffB[i] = (unsigned)(Rb * K + C) * 2u; }
    const size_t kstep = (size_t)(BK * 2);
    const size_t hstep = (size_t)HALF * K * 2;
    const size_t tstep = 2 * hstep;
    const unsigned ldsw = (unsigned)wid * 1024u;
    const int aoff = lds_byte(wr * 64 + fr, fq * 8), boff = lds_byte(wc * 32 + fr, fq * 8);
#define PG8_SA(b, h) (((b) * 2 + (h)) * HTB)
#define PG8_SB(b, h) ((4 + (b) * 2 + (h)) * HTB)
#define PG8_STAGE(bufoff, gbase, voff) do { _Pragma("unroll") for (int _i = 0; _i < 2; ++_i) \
        __builtin_amdgcn_global_load_lds((const unsigned*)((const char*)(gbase) + (voff)[_i]), (PG8_LAS unsigned*)(lds + (bufoff) + ldsw + _i * 8192), 16, 0, 0); } while (0)
#define PG8_LDA(dst, b, h) do { _Pragma("unroll") for (int m = 0; m < 4; ++m) _Pragma("unroll") for (int k = 0; k < 2; ++k) dst[m][k] = *(const PG8_LAS bf16x8*)(lds + PG8_SA(b, h) + aoff + m * 2048 + k * 1024); } while (0)
#define PG8_LDB(dst, b, h) do { _Pragma("unroll") for (int n = 0; n < 2; ++n) _Pragma("unroll") for (int k = 0; k < 2; ++k) dst[n][k] = *(const PG8_LAS bf16x8*)(lds + PG8_SB(b, h) + boff + n * 2048 + k * 1024); } while (0)
#define PG8_MMA(ai, bj, At, Bt) do { __builtin_amdgcn_s_setprio(1); _Pragma("unroll") for (int m = 0; m < 4; ++m) _Pragma("unroll") for (int n = 0; n < 2; ++n) _Pragma("unroll") for (int k = 0; k < 2; ++k) \
        acc[ai][bj][m][n] = __builtin_amdgcn_mfma_f32_16x16x32_bf16(Bt[n][k], At[m][k], acc[ai][bj][m][n], 0, 0, 0); __builtin_amdgcn_s_setprio(0); } while (0)
#define PG8_WAIT_V(n) asm volatile("s_waitcnt vmcnt(" #n ")" ::: "memory")
#define PG8_WAIT_L(n) asm volatile("s_waitcnt lgkmcnt(" #n ")" ::: "memory")
#define PG8_BAR __builtin_amdgcn_s_barrier()
#define PG8_SCHED __builtin_amdgcn_sched_barrier(0)
    Unit cur, nxt; int ui = 0;
    if (!S.next(0, cur)) return;
    f32x4 acc[2][2][4][2];
#pragma unroll
    for (int a = 0; a < 2; ++a)
#pragma unroll
        for (int b = 0; b < 2; ++b)
#pragma unroll
            for (int m = 0; m < 4; ++m)
#pragma unroll
                for (int n = 0; n < 2; ++n) acc[a][b][m][n] = (f32x4){0.f, 0.f, 0.f, 0.f};
    bf16x8 At[4][2], B0[2][2], B1[2][2];
    const char* cA = (const char*)g.A + (size_t)cur.pm * tstep; const char* cB = (const char*)g.Bt + (size_t)cur.pn * tstep;
    S.a_ready(cur);
    if constexpr (SP2) {
        PG8_STAGE(PG8_SB(0, 0), cB, voffB); PG8_STAGE(PG8_SB(0, 1), cB + hstep, voffB); PG8_STAGE(PG8_SA(0, 0), cA, voffA); PG8_STAGE(PG8_SA(0, 1), cA + hstep, voffA);
        if (wr == 1) PG8_BAR;
        PG8_WAIT_V(2); PG8_BAR;
        PG8_STAGE(PG8_SB(1, 0), cB + kstep, voffB); PG8_STAGE(PG8_SA(1, 0), cA + kstep, voffA); PG8_STAGE(PG8_SB(1, 1), cB + hstep + kstep, voffB);
        PG8_WAIT_V(6); PG8_BAR;
    } else {
        PG8_STAGE(PG8_SB(0, 0), cB, voffB); PG8_STAGE(PG8_SA(0, 0), cA, voffA); PG8_STAGE(PG8_SB(0, 1), cB + hstep, voffB); PG8_STAGE(PG8_SA(0, 1), cA + hstep, voffA);
        if (wr == 1) PG8_BAR;
        PG8_WAIT_V(4); PG8_BAR;
        PG8_STAGE(PG8_SB(1, 0), cB + kstep, voffB); PG8_STAGE(PG8_SA(1, 0), cA + kstep, voffA); PG8_STAGE(PG8_SB(1, 1), cB + hstep + kstep, voffB);
        PG8_WAIT_V(6); PG8_BAR;
    }
    for (;;) {
        const bool has_next = S.next(ui + 1, nxt);
        const char* nA = has_next ? (const char*)g.A + (size_t)nxt.pm * tstep : cA; const char* nB = has_next ? (const char*)g.Bt + (size_t)nxt.pn * tstep : cB;
        for (int t = 0; t < nt; t += 2) {
            const bool last = (t == nt - 2);
            const char* a1 = cA + (size_t)(t + 1) * kstep;
            const char* a2 = last ? nA : cA + (size_t)(t + 2) * kstep; const char* b2 = last ? nB : cB + (size_t)(t + 2) * kstep;
            const char* a3 = a2 + kstep; const char* b3 = b2 + kstep;
            if (last && has_next) S.a_ready(nxt);
            if constexpr (SP2) {
            PG8_LDB(B0, 0, 0); PG8_LDB(B1, 0, 1); PG8_SCHED; PG8_LDA(At, 0, 0); PG8_STAGE(PG8_SA(1, 1), a1 + hstep, voffA);
            PG8_WAIT_V(8); PG8_WAIT_L(0); PG8_BAR; PG8_MMA(0, 0, At, B0); PG8_MMA(0, 1, At, B1); PG8_BAR; PG8_SCHED;
            PG8_LDA(At, 0, 1); PG8_STAGE(PG8_SB(0, 0), b2, voffB); PG8_STAGE(PG8_SB(0, 1), b2 + hstep, voffB); PG8_STAGE(PG8_SA(0, 0), a2, voffA);
            PG8_WAIT_V(8); PG8_WAIT_L(0); PG8_BAR; PG8_MMA(1, 0, At, B0); PG8_MMA(1, 1, At, B1); PG8_BAR; PG8_SCHED;
            PG8_LDB(B0, 1, 0); PG8_LDB(B1, 1, 1); PG8_SCHED; PG8_LDA(At, 1, 0); PG8_STAGE(PG8_SA(0, 1), a2 + hstep, voffA);
            PG8_WAIT_V(8); PG8_WAIT_L(0); PG8_BAR; PG8_MMA(0, 0, At, B0); PG8_MMA(0, 1, At, B1); PG8_BAR; PG8_SCHED;
            PG8_LDA(At, 1, 1); PG8_STAGE(PG8_SB(1, 0), b3, voffB); PG8_STAGE(PG8_SB(1, 1), b3 + hstep, voffB); PG8_STAGE(PG8_SA(1, 0), a3, voffA);
            PG8_WAIT_V(8); PG8_WAIT_L(0); PG8_BAR; PG8_MMA(1, 0, At, B0); PG8_MMA(1, 1, At, B1); PG8_BAR; PG8_SCHED;
            } else {
            PG8_LDB(B0, 0, 0); PG8_SCHED; PG8_LDA(At, 0, 0); PG8_STAGE(PG8_SA(1, 1), a1 + hstep, voffA);
            PG8_WAIT_L(8); PG8_BAR; PG8_WAIT_L(0); PG8_MMA(0, 0, At, B0); PG8_BAR; PG8_SCHED;
            PG8_LDB(B1, 0, 1); PG8_STAGE(PG8_SB(0, 0), b2, voffB);
            PG8_BAR; PG8_WAIT_L(0); PG8_MMA(0, 1, At, B1); PG8_BAR;
            PG8_LDA(At, 0, 1); PG8_STAGE(PG8_SA(0, 0), a2, voffA);
            PG8_BAR; PG8_WAIT_L(0); PG8_MMA(1, 0, At, B0); PG8_BAR; PG8_SCHED;
            PG8_STAGE(PG8_SB(0, 1), b2 + hstep, voffB);
            PG8_WAIT_V(6); PG8_BAR; PG8_MMA(1, 1, At, B1); PG8_BAR;
            PG8_LDB(B0, 1, 0); PG8_SCHED; PG8_LDA(At, 1, 0); PG8_STAGE(PG8_SA(0, 1), a2 + hstep, voffA);
            PG8_WAIT_L(8); PG8_BAR; PG8_WAIT_L(0); PG8_MMA(0, 0, At, B0); PG8_BAR; PG8_SCHED;
            PG8_LDB(B1, 1, 1); PG8_STAGE(PG8_SB(1, 0), b3, voffB);
            PG8_BAR; PG8_WAIT_L(0); PG8_MMA(0, 1, At, B1); PG8_BAR;
            PG8_LDA(At, 1, 1); PG8_STAGE(PG8_SA(1, 0), a3, voffA);
            PG8_BAR; PG8_WAIT_L(0); PG8_MMA(1, 0, At, B0); PG8_BAR; PG8_SCHED;
            PG8_STAGE(PG8_SB(1, 1), b3 + hstep, voffB);
            PG8_WAIT_V(6); PG8_BAR; PG8_MMA(1, 1, At, B1); PG8_BAR;
            }
        }
        if constexpr (ALIGN_EPI) { if (wr == 0) PG8_BAR; }
        if constexpr (!Epi::AFTER_DRAIN) { E(acc, cur, wr, wc, fr, fq); S.done(cur); }
        if (!has_next) break;
#pragma unroll
        for (int a = 0; a < 2; ++a)
#pragma unroll
            for (int b = 0; b < 2; ++b)
#pragma unroll
                for (int m = 0; m < 4; ++m)
#pragma unroll
                    for (int n = 0; n < 2; ++n) acc[a][b][m][n] = (f32x4){0.f, 0.f, 0.f, 0.f};
        cur = nxt; cA = nA; cB = nB; ++ui;
        if constexpr (ALIGN_EPI) { if (wr == 1) PG8_BAR; }
    }
    PG8_WAIT_V(0);
    if constexpr (!ALIGN_EPI) { if (wr == 0) PG8_BAR; }
    PG8_BAR;
    if constexpr (Epi::AFTER_DRAIN) { E.fused(acc, cur, wr, wc, fr, fq, lds, wid, lane); S.done(cur); }
#undef PG8_SA
#undef PG8_SB
#undef PG8_STAGE
#undef PG8_LDA
#undef PG8_LDB
#undef PG8_MMA
#undef PG8_WAIT_V
#undef PG8_WAIT_L
#undef PG8_BAR
#undef PG8_SCHED
}
}
namespace pg8 {
__device__ __forceinline__ float bf_lo(unsigned u) { return __uint_as_float(u << 16); }
__device__ __forceinline__ float bf_hi(unsigned u) { return __uint_as_float(u & 0xffff0000u); }
__device__ __forceinline__ u32x4 pack8bf(const f32x4 v0, const f32x4 v1) { u32x4 w; w.x = cvt_pk_bf16(v0[0], v0[1]); w.y = cvt_pk_bf16(v0[2], v0[3]); w.z = cvt_pk_bf16(v1[0], v1[1]); w.w = cvt_pk_bf16(v1[2], v1[3]); return w; }
__device__ __forceinline__ float sigmoidf_(float x) { return __builtin_amdgcn_rcpf(1.0f + __builtin_amdgcn_exp2f(-1.4426950408889634f * x)); }

struct EpiProj {
    static constexpr bool PERM = true, AFTER_DRAIN = false;
    unsigned char* ws; const float* bgate;
    __device__ __forceinline__ void operator()(const f32x4 (&acc)[2][2][4][2], const Unit& u, int wr, int wc, int fr, int fq) const {
        const int pn = u.pn;
        size_t off; int ld, ct, mode, boff = 0;
        if (pn < 6)       { off = WS_QA; ld = 1536; ct = pn;      mode = 1; }
        else if (pn < 12) { off = WS_KA; ld = 1536; ct = pn - 6;  mode = 1; }
        else if (pn < 18) { off = WS_VA; ld = 1536; ct = pn - 12; mode = 0; }
        else if (pn < 26) { off = WS_QB; ld = 2048; ct = pn - 18; mode = 1; }
        else if (pn < 34) { off = WS_KB; ld = 2048; ct = pn - 26; mode = 1; }
        else if (pn < 42) { off = WS_VB; ld = 2048; ct = pn - 34; mode = 0; }
        else if (pn < 58) { off = WS_GA; ld = 4096; ct = pn - 42; mode = 2; boff = (pn - 42) * 256; }
        else              { off = WS_GB; ld = 4096; ct = pn - 58; mode = 2; boff = 4096 + (pn - 58) * 256; }
        bf16_t* dst = (bf16_t*)(ws + off);
        const int row0 = u.pm * BM + wr * 64 + fr, col0 = ct * 256 + wc * 32 + 8 * fq;
        if (mode == 2) {
            f32x4 bv[2][2];
#pragma unroll
            for (int bj = 0; bj < 2; ++bj)
#pragma unroll
                for (int n = 0; n < 2; ++n) bv[bj][n] = *(const f32x4*)(bgate + boff + wc * 32 + 8 * fq + bj * HALF + 4 * n);
#pragma unroll
            for (int ai = 0; ai < 2; ++ai)
#pragma unroll
                for (int m = 0; m < 4; ++m) { bf16_t* rowp = dst + (size_t)(row0 + ai * HALF + m * 16) * ld + col0;
#pragma unroll
                    for (int bj = 0; bj < 2; ++bj) { f32x4 v0 = acc[ai][bj][m][0] + bv[bj][0], v1 = acc[ai][bj][m][1] + bv[bj][1];
#pragma unroll
                        for (int i = 0; i < 4; ++i) { v0[i] = sigmoidf_(v0[i]); v1[i] = sigmoidf_(v1[i]); }
                        *(u32x4*)(rowp + bj * HALF) = pack8bf(v0, v1); } }
        } else if (mode == 1 && wc == 0) {
            const bool odd = (fq & 1) != 0, lo = fq < 2;
            float invf[2][4];
            invf[0][0] = odd ? 0.00141421356f : 1.0f;            invf[0][1] = odd ? 0.000622772437f : 0.440366596f;
            invf[0][2] = odd ? 0.000274248188f : 0.193922743f;   invf[0][3] = odd ? 0.000120769735f : 0.0853971019f;
            invf[1][0] = odd ? 5.31829573e-05f : 0.0376060307f;  invf[1][1] = odd ? 2.34199997e-05f : 0.0165604409f;
            invf[1][2] = odd ? 1.03133852e-05f : 0.00729266461f; invf[1][3] = odd ? 4.54167048e-06f : 0.00321144611f;
#pragma unroll
            for (int ai = 0; ai < 2; ++ai)
#pragma unroll
                for (int m = 0; m < 4; ++m) { const int row = row0 + ai * HALF + m * 16; const float pos = (float)row; bf16_t* rowp = dst + (size_t)row * ld + col0;
                    float cs[2][4], sn[2][4];
#pragma unroll
                    for (int n = 0; n < 2; ++n)
#pragma unroll
                        for (int i = 0; i < 4; ++i) { const float ang = pos * invf[n][i]; const float k = rintf(ang * 0.15915494309189535f);
                            float r = fmaf(-k, 6.2831855f, ang); r = fmaf(-k, -1.7484555e-07f, r); const float rev = r * 0.15915494309189535f;
                            cs[n][i] = __builtin_amdgcn_cosf(rev); sn[n][i] = lo ? -__builtin_amdgcn_sinf(rev) : __builtin_amdgcn_sinf(rev); }
#pragma unroll
                    for (int bj = 0; bj < 2; ++bj) { f32x4 v0 = acc[ai][bj][m][0], v1 = acc[ai][bj][m][1], o0, o1;
#pragma unroll
                        for (int i = 0; i < 4; ++i) { const float p0 = __shfl_xor(v0[i], 32), p1 = __shfl_xor(v1[i], 32);
                            o0[i] = v0[i] * cs[0][i] + p0 * sn[0][i]; o1[i] = v1[i] * cs[1][i] + p1 * sn[1][i]; }
                        *(u32x4*)(rowp + bj * HALF) = pack8bf(o0, o1); } }
        } else {
#pragma unroll
            for (int ai = 0; ai < 2; ++ai)
#pragma unroll
                for (int m = 0; m < 4; ++m) { bf16_t* rowp = dst + (size_t)(row0 + ai * HALF + m * 16) * ld + col0;
#pragma unroll
                    for (int bj = 0; bj < 2; ++bj) *(u32x4*)(rowp + bj * HALF) = pack8bf(acc[ai][bj][m][0], acc[ai][bj][m][1]); }
        }
    }
};
template <bool ADD> struct EpiGate {
    static constexpr bool PERM = true, AFTER_DRAIN = false;
    const bf16_t* G; const bf16_t* Tin; bf16_t* O;
    __device__ __forceinline__ void operator()(const f32x4 (&acc)[2][2][4][2], const Unit& u, int wr, int wc, int fr, int fq) const {
        const int row0 = u.pm * BM + wr * 64 + fr, col0 = u.pn * BM + wc * 32 + 8 * fq;
#pragma unroll
        for (int ai = 0; ai < 2; ++ai) {
            u32x4 gw[4][2], tw[4][2];
#pragma unroll
            for (int m = 0; m < 4; ++m)
#pragma unroll
                for (int bj = 0; bj < 2; ++bj) { const size_t idx = (size_t)(row0 + ai * HALF + m * 16) * DM + col0 + bj * HALF;
                    gw[m][bj] = *(const u32x4*)(G + idx); if (ADD) tw[m][bj] = *(const u32x4*)(Tin + idx); }
#pragma unroll
            for (int m = 0; m < 4; ++m)
#pragma unroll
                for (int bj = 0; bj < 2; ++bj) { const size_t idx = (size_t)(row0 + ai * HALF + m * 16) * DM + col0 + bj * HALF;
                    const u32x4 g = gw[m][bj];
                    f32x4 v0 = acc[ai][bj][m][0], v1 = acc[ai][bj][m][1];
                    v0[0] *= bf_lo(g.x); v0[1] *= bf_hi(g.x); v0[2] *= bf_lo(g.y); v0[3] *= bf_hi(g.y);
                    v1[0] *= bf_lo(g.z); v1[1] *= bf_hi(g.z); v1[2] *= bf_lo(g.w); v1[3] *= bf_hi(g.w);
                    if (ADD) { const u32x4 t = tw[m][bj];
                        v0[0] += bf_lo(t.x); v0[1] += bf_hi(t.x); v0[2] += bf_lo(t.y); v0[3] += bf_hi(t.y);
                        v1[0] += bf_lo(t.z); v1[1] += bf_hi(t.z); v1[2] += bf_lo(t.w); v1[3] += bf_hi(t.w); }
                    *(u32x4*)(O + idx) = pack8bf(v0, v1); }
            asm volatile("" ::: "memory"); }
    }
};
struct EpiResidStats {
    static constexpr bool PERM = false, AFTER_DRAIN = false;
    const float* base; bf16_t* xb; float* rss;
    __device__ __forceinline__ void operator()(const f32x4 (&acc)[2][2][4][2], const Unit& u, int wr, int wc, int fr, int fq) const {
        typedef unsigned u32x2v __attribute__((ext_vector_type(2)));
        const int col0 = u.pn * BM + wc * 32 + 4 * fq;
#pragma unroll
        for (int ai = 0; ai < 2; ++ai) {
            f32x4 bs[4][2][2];
#pragma unroll
            for (int m = 0; m < 4; ++m) { const size_t off = (size_t)(u.pm * BM + ai * HALF + wr * 64 + m * 16 + fr) * DM + col0;
#pragma unroll
                for (int bj = 0; bj < 2; ++bj)
#pragma unroll
                    for (int n = 0; n < 2; ++n) bs[m][bj][n] = *(const f32x4*)(base + off + bj * HALF + n * 16); }
#pragma unroll
            for (int m = 0; m < 4; ++m) { const int row = u.pm * BM + ai * HALF + wr * 64 + m * 16 + fr; const size_t off = (size_t)row * DM + col0; float ss = 0.f;
#pragma unroll
                for (int bj = 0; bj < 2; ++bj)
#pragma unroll
                    for (int n = 0; n < 2; ++n) { const f32x4 o = bs[m][bj][n] + acc[ai][bj][m][n];
                        ss += (o[0] * o[0] + o[1] * o[1]) + (o[2] * o[2] + o[3] * o[3]);
                        u32x2v w; w.x = cvt_pk_bf16(o[0], o[1]); w.y = cvt_pk_bf16(o[2], o[3]); *(u32x2v*)(xb + off + bj * HALF + n * 16) = w; }
                ss += __shfl_xor(ss, 16); ss += __shfl_xor(ss, 32); if (fq == 0) rss[(size_t)row * 64 + u.pn * 4 + wc] = ss; }
            asm volatile("" ::: "memory"); }
    }
};
struct EpiResidOut {
    static constexpr bool PERM = false, AFTER_DRAIN = false;
    const bf16_t* xb; float* out;
    __device__ __forceinline__ void operator()(const f32x4 (&acc)[2][2][4][2], const Unit& u, int wr, int wc, int fr, int fq) const {
        typedef unsigned u32x2v __attribute__((ext_vector_type(2)));
        const int col0 = u.pn * BM + wc * 32 + 4 * fq;
#pragma unroll
        for (int ai = 0; ai < 2; ++ai) {
            u32x2v bs[4][2][2];
#pragma unroll
            for (int m = 0; m < 4; ++m) { const size_t off = (size_t)(u.pm * BM + ai * HALF + wr * 64 + m * 16 + fr) * DM + col0;
#pragma unroll
                for (int bj = 0; bj < 2; ++bj)
#pragma unroll
                    for (int n = 0; n < 2; ++n) bs[m][bj][n] = *(const u32x2v*)(xb + off + bj * HALF + n * 16); }
#pragma unroll
            for (int m = 0; m < 4; ++m) { const size_t off = (size_t)(u.pm * BM + ai * HALF + wr * 64 + m * 16 + fr) * DM + col0;
#pragma unroll
                for (int bj = 0; bj < 2; ++bj)
#pragma unroll
                    for (int n = 0; n < 2; ++n) { const u32x2v b = bs[m][bj][n]; f32x4 o = acc[ai][bj][m][n];
                        o[0] += bf_lo(b.x); o[1] += bf_hi(b.x); o[2] += bf_lo(b.y); o[3] += bf_hi(b.y);
                        *(f32x4*)(out + off + bj * HALF + n * 16) = o; } }
            asm volatile("" ::: "memory"); }
    }
};
template <bool TAB> struct EpiRelu2 {
    static constexpr bool PERM = true, AFTER_DRAIN = false;
    bf16_t* O; const float* rss; const PG8_LAS float* rtab;
    __device__ __forceinline__ void operator()(const f32x4 (&acc)[2][2][4][2], const Unit& u, int wr, int wc, int fr, int fq) const {
        const int row0 = u.pm * BM + wr * 64 + fr, col0 = u.pn * BM + wc * 32 + 8 * fq;
#pragma unroll
        for (int ai = 0; ai < 2; ++ai)
#pragma unroll
            for (int m = 0; m < 4; ++m) { const int row = row0 + ai * HALF + m * 16; float rstd;
                if (TAB) rstd = rtab[ai * HALF + wr * 64 + m * 16 + fr];
                else { const f32x4* rp = (const f32x4*)(rss + (size_t)row * 64 + fq * 16);
                    const f32x4 a = rp[0], b = rp[1], c = rp[2], d = rp[3];
                    float t = ((a[0] + a[1]) + (a[2] + a[3])) + ((b[0] + b[1]) + (b[2] + b[3])) + ((c[0] + c[1]) + (c[2] + c[3])) + ((d[0] + d[1]) + (d[2] + d[3]));
                    t += __shfl_xor(t, 16); t += __shfl_xor(t, 32);
                    rstd = rsqrtf(t * (1.0f / DM) + RMS_EPS); }
                bf16_t* rowp = O + (size_t)row * DFF + col0;
#pragma unroll
                for (int bj = 0; bj < 2; ++bj) { f32x4 v0 = acc[ai][bj][m][0] * rstd, v1 = acc[ai][bj][m][1] * rstd;
#pragma unroll
                    for (int i = 0; i < 4; ++i) { v0[i] = fmaxf(v0[i], 0.f); v0[i] *= v0[i]; v1[i] = fmaxf(v1[i], 0.f); v1[i] *= v1[i]; }
                    *(u32x4*)(rowp + bj * HALF) = pack8bf(v0, v1); } }
    }
};
}
namespace swa {
typedef short bf16x8 __attribute__((ext_vector_type(8)));
typedef short s16x4 __attribute__((ext_vector_type(4)));
typedef float f32x16 __attribute__((ext_vector_type(16)));
typedef float f32x4 __attribute__((ext_vector_type(4)));
typedef unsigned u32x4 __attribute__((ext_vector_type(4)));
typedef unsigned short bf16;
constexpr int D = 128, NW = 8, QBLK = 32, KVBLK = 64, QB = NW * QBLK;
constexpr int SHM_V = KVBLK * D * 2, SHM_K = KVBLK * D * 2;
constexpr int LDS_BYTES = 2 * SHM_V + 2 * SHM_K + NW * 64 * 4;
constexpr float SCALE = 0.08838834764831845f, THR = 8.f;
#define KSWZ(row, colB) ((row) * 256 + ((colB) ^ (((row) & 7) << 4)))
#define SBAR() __builtin_amdgcn_sched_barrier(0)
__device__ __forceinline__ int v_st(int k, int c) { const int kk = (k & ~0xC) | ((k & 4) << 1) | ((k & 8) >> 1); return ((kk >> 3) * 4 + (c >> 5)) * 512 + ((kk & 7) * 32 + (c & 31)) * 2; }
__device__ __forceinline__ int v_rd_base(int lane) { return ((lane & 3) << 3) | (((lane >> 2) & 3) << 6) | (((lane >> 4) & 1) << 5) | (((lane >> 5) & 1) << 8); }
constexpr int v_rd_off(int d0, int ks, int half) { return d0 * 512 + ks * 4096 + half * 2048; }
__device__ __forceinline__ int crow(int r, int hi) { return (r & 3) + 8 * (r >> 2) + 4 * hi; }
typedef float f32x2_t __attribute__((ext_vector_type(2))); typedef __bf16 bf16x2_t __attribute__((ext_vector_type(2)));
__device__ __forceinline__ unsigned cvtpk(float lo, float hi) { const f32x2_t v = {lo, hi}; const bf16x2_t b = __builtin_convertvector(v, bf16x2_t); return __builtin_bit_cast(unsigned, b); }
__device__ __forceinline__ bf16x8 load8(const bf16* p) { return *reinterpret_cast<const bf16x8*>(p); }
__device__ __forceinline__ void mask_tile(f32x16& p0, f32x16& p1, int dq, unsigned W) {
    const float NEG = -__builtin_inff();
#pragma unroll
    for (int r = 0; r < 16; ++r) {
        const int c = (r & 3) + 8 * (r >> 2);
        if ((unsigned)(dq - c) >= W) p0[r] = NEG;
        if ((unsigned)(dq - c - 32) >= W) p1[r] = NEG;
    }
}
__device__ __forceinline__ void partialSM(f32x16& p0, f32x16& p1, float& m_reg, float& mn, float& alpha) {
    float pmax = p0[0]; for (int r = 1; r < 16; ++r) pmax = fmaxf(pmax, p0[r]); for (int r = 0; r < 16; ++r) pmax = fmaxf(pmax, p1[r]);
    { auto rr = __builtin_amdgcn_permlane32_swap(__float_as_uint(pmax), __float_as_uint(pmax), false, false);
      pmax = fmaxf(__uint_as_float(rr[0]), __uint_as_float(rr[1])); }
    constexpr float C2 = 1.4426950408889634f * SCALE;
    if (__builtin_expect(__all((pmax - m_reg) * SCALE <= THR), 1)) { mn = m_reg; alpha = 1.f; }
    else { mn = fmaxf(m_reg, pmax); alpha = __builtin_amdgcn_exp2f((m_reg - mn) * C2); m_reg = mn; }
    const float mnL = -mn * C2;
    for (int r = 0; r < 16; ++r) p0[r] = fmaf(p0[r], C2, mnL); for (int r = 0; r < 16; ++r) p1[r] = fmaf(p1[r], C2, mnL);
    for (int r = 0; r < 16; ++r) p0[r] = __builtin_amdgcn_exp2f(p0[r]);
}
__device__ __forceinline__ void finishSM(f32x16& p0, f32x16& p1, float alpha, float& l_reg, bf16x8& pa0, bf16x8& pa1, bf16x8& pa2, bf16x8& pa3) {
    for (int r = 0; r < 16; ++r) p1[r] = __builtin_amdgcn_exp2f(p1[r]);
    float ps = 0; for (int r = 0; r < 16; ++r) ps += p0[r]; for (int r = 0; r < 16; ++r) ps += p1[r];
    { auto rr = __builtin_amdgcn_permlane32_swap(__float_as_uint(ps), __float_as_uint(ps), false, false);
      ps = __uint_as_float(rr[0]) + __uint_as_float(rr[1]); }
    l_reg = l_reg * alpha + ps;
#define PK4(P, B_, OUT) do { unsigned a0 = cvtpk(P[B_+0], P[B_+1]), a1 = cvtpk(P[B_+2], P[B_+3]);                          \
        unsigned b0 = cvtpk(P[B_+4], P[B_+5]), b1 = cvtpk(P[B_+6], P[B_+7]);                                             \
        auto r0 = __builtin_amdgcn_permlane32_swap(a0, b0, false, false); auto r1 = __builtin_amdgcn_permlane32_swap(a1, b1, false, false); \
        u32x4 w = {r0[0], r1[0], r0[1], r1[1]}; OUT = *reinterpret_cast<bf16x8*>(&w); } while (0)
    PK4(p0, 0, pa0); PK4(p0, 8, pa1); PK4(p1, 0, pa2); PK4(p1, 8, pa3);
#undef PK4
}
template <int KB>
__device__ __forceinline__ void qkt(f32x16& p0, f32x16& p1, const char* K_lds, int r32, int hi, const bf16x8* qr) {
    p0 = f32x16{}; p1 = f32x16{};
    const char* kb[4];
#pragma unroll
    for (int dd = 0; dd < 4; ++dd) kb[dd] = K_lds + KB * SHM_K + KSWZ(r32, (dd * 16 + hi * 8) * 2);
#pragma unroll
    for (int d0 = 0; d0 < 8; ++d0) { const char* a = kb[d0 & 3] + (d0 >> 2) * 128;
        bf16x8 b0 = *reinterpret_cast<const bf16x8*>(a);
        bf16x8 b1 = *reinterpret_cast<const bf16x8*>(a + 32 * 256);
        p0 = __builtin_amdgcn_mfma_f32_32x32x16_bf16(b0, qr[d0], p0, 0, 0, 0);
        p1 = __builtin_amdgcn_mfma_f32_32x32x16_bf16(b1, qr[d0], p1, 0, 0, 0); }
}
template <int VB>
__device__ __forceinline__ void pv_tile(f32x16* o, int vb0, bf16x8 pa0, bf16x8 pa1, bf16x8 pa2, bf16x8 pa3) {
#define TRRD(dst, off) asm volatile("ds_read_b64_tr_b16 %0, %1 offset:%2" : "=&v"(dst) : "v"(vb0), "i"(off) : "memory")
#define PV_D0(d0) do { s16x4 l0, l1, l2, l3, h0, h1, h2, h3; constexpr int b_ = VB * SHM_V + v_rd_off(d0, 0, 0);     \
        TRRD(l0, b_); TRRD(h0, b_ + 2048); TRRD(l1, b_ + 4096); TRRD(h1, b_ + 6144); TRRD(l2, b_ + 8192); TRRD(h2, b_ + 10240); TRRD(l3, b_ + 12288); TRRD(h3, b_ + 14336); \
        asm volatile("s_waitcnt lgkmcnt(0)" ::: "memory"); SBAR();                                                             \
        o[d0] = __builtin_amdgcn_mfma_f32_32x32x16_bf16(pa0, (bf16x8){l0[0], l0[1], l0[2], l0[3], h0[0], h0[1], h0[2], h0[3]}, o[d0], 0, 0, 0);   \
        o[d0] = __builtin_amdgcn_mfma_f32_32x32x16_bf16(pa1, (bf16x8){l1[0], l1[1], l1[2], l1[3], h1[0], h1[1], h1[2], h1[3]}, o[d0], 0, 0, 0);   \
        o[d0] = __builtin_amdgcn_mfma_f32_32x32x16_bf16(pa2, (bf16x8){l2[0], l2[1], l2[2], l2[3], h2[0], h2[1], h2[2], h2[3]}, o[d0], 0, 0, 0);   \
        o[d0] = __builtin_amdgcn_mfma_f32_32x32x16_bf16(pa3, (bf16x8){l3[0], l3[1], l3[2], l3[3], h3[0], h3[1], h3[2], h3[3]}, o[d0], 0, 0, 0); } while (0)
    PV_D0(0); PV_D0(1); PV_D0(2); PV_D0(3);
#undef PV_D0
#undef TRRD
}
struct BlockRef { const bf16* Q; const bf16* K; const bf16* V; float* O; float* L; int P0, qp, kp, op, lp, skv, W; };
struct Seam { bf16x8 qr[8]; bf16x8 st_v0, st_v1, st_k0, st_k1; };
__device__ __forceinline__ int swa_jlo(int P0, int W) { const int lowk = P0 - W + 1; return lowk > 0 ? lowk / KVBLK : 0; }
#define ROW(p, k0, rr, pitch) ((p) + (size_t)((k0) + (rr)) * (pitch) + sc)
#define VMW() asm volatile("s_waitcnt vmcnt(0)" ::: "memory")
#define VMWN(n) asm volatile("s_waitcnt vmcnt(%0)" :: "i"(n) : "memory")
#define SLOAD_H(Kp, Vp, k0, pitch) do { S.st_v0 = load8(ROW(Vp, k0, sr, pitch)); S.st_v1 = load8(ROW(Vp, k0, 32 + sr, pitch));              \
                         S.st_k0 = load8(ROW(Kp, k0, sr, pitch)); S.st_k1 = load8(ROW(Kp, k0, 32 + sr, pitch)); } while (0)
#define SWRITE_HK(bf) do { *(bf16x8*)(K_lds + (bf) * SHM_K + kws) = S.st_k0; *(bf16x8*)(K_lds + (bf) * SHM_K + kws + 32 * 256) = S.st_k1; } while (0)
#define SWRITE_HV(bf) do { *(bf16x8*)(V_lds + (bf) * SHM_V + vst0) = S.st_v0; *(bf16x8*)(V_lds + (bf) * SHM_V + vst1) = S.st_v1; } while (0)
#define SWRITE_H(bf) do { SWRITE_HV(bf); SWRITE_HK(bf); } while (0)
__device__ __forceinline__ void causal_swa_prime(const BlockRef& cur, char* lds, Seam& S) {
    const int tid = threadIdx.x, wid = __builtin_amdgcn_readfirstlane(tid >> 6), lane = tid & 63, r32 = lane & 31, hi = lane >> 5;
    const int sr = tid >> 4, sc = (tid & 15) * 8, kws = KSWZ(sr, sc * 2); char* K_lds = lds + 2 * SHM_V;
    const int kb0 = swa_jlo(cur.P0, cur.W) * KVBLK;
#pragma unroll
    for (int d0 = 0; d0 < 8; ++d0) S.qr[d0] = load8(cur.Q + (size_t)(wid * QBLK + r32) * cur.qp + d0 * 16 + hi * 8);
    SLOAD_H(cur.K, cur.V, kb0, cur.kp); VMW(); SWRITE_HK(0);
    __syncthreads();
}
__device__ __forceinline__ void causal_swa_block(const BlockRef& cur, const BlockRef& nxt, char* lds, Seam& S) {
    const int tid = threadIdx.x, wid = __builtin_amdgcn_readfirstlane(tid >> 6), lane = tid & 63, r32 = lane & 31, hi = lane >> 5;
    const int W = cur.W, kp = cur.kp;
    const int j_lo = swa_jlo(cur.P0, W);
    int j_hi = (cur.P0 + QB - 1) / KVBLK + 1; if (j_hi > cur.skv / KVBLK) j_hi = cur.skv / KVBLK;
    const int NT = j_hi - j_lo;
    const int kbn = swa_jlo(nxt.P0, nxt.W) * KVBLK;
    const int qlo = cur.P0 + wid * QBLK, qm = qlo + r32 - 4 * hi;
    char* V_lds = lds; char* K_lds = lds + 2 * SHM_V;
    float* ws = (float*)(lds + 2 * SHM_V + 2 * SHM_K) + wid * 64; float* li_l = ws, * al_l = ws + 32;
    float m_reg = -1e30f, l_reg = 0; f32x16 o[4] = {};
    const int sr = tid >> 4, sc = (tid & 15) * 8, vst0 = v_st(sr, sc), vst1 = v_st(32 + sr, sc), kws = KSWZ(sr, sc * 2);
    const int vb0 = (int)(uintptr_t)V_lds + v_rd_base(lane);
    const bf16* Kh = cur.K; const bf16* Vh = cur.V;
#define RESC(a) do { if (__any((a) < 1.f)) { if (hi == 0) al_l[r32] = (a); asm volatile("s_waitcnt lgkmcnt(0)" ::: "memory");              \
                     for (int d_ = 0; d_ < 4; ++d_) for (int r = 0; r < 16; ++r) o[d_][r] *= al_l[crow(r, hi)]; } } while (0)
#define KBASE(t) ((j_lo + (t)) * KVBLK)
#define MASKT(P0_, P1_, t) do { const int kb_ = KBASE(t); if (kb_ + KVBLK - 1 > qlo || kb_ <= qlo + QBLK - 1 - W) mask_tile(P0_, P1_, qm - kb_, (unsigned)W); } while (0)
    constexpr int NQL = 8;
#define SEAM_K0() do { VMWN(NQL); SWRITE_HK(0); SBAR(); } while (0)
    f32x16 pA0, pA1, pB0, pB1; float mnA, mnB, alA, alB; bf16x8 pa0, pa1, pa2, pa3;
    SWRITE_HV(0); SBAR();
    if (NT > 1) SLOAD_H(Kh, Vh, KBASE(1), kp);
    SBAR(); qkt<0>(pA0, pA1, K_lds, r32, hi, S.qr);
    MASKT(pA0, pA1, 0); partialSM(pA0, pA1, m_reg, mnA, alA);
    if (NT > 1) { VMW(); SWRITE_H(1); }
    __syncthreads();
#define HALF_STEP(PX0, PX1, mnX, alX, PY0, PY1, alY, t, KB, VB, SB) do {                                                      \
        SBAR(); qkt<KB>(PX0, PX1, K_lds, r32, hi, S.qr);                                                                      \
        finishSM(PY0, PY1, alY, l_reg, pa0, pa1, pa2, pa3); SBAR();                                                           \
        if ((t) + 1 < NT) { SLOAD_H(Kh, Vh, KBASE((t) + 1), kp); SBAR(); }                                                    \
        pv_tile<VB>(o, vb0, pa0, pa1, pa2, pa3); MASKT(PX0, PX1, (t)); partialSM(PX0, PX1, m_reg, mnX, alX);                  \
        __syncthreads();                                                                                                      \
        if ((t) + 1 < NT) { VMW(); SWRITE_H(SB); }                                                                            \
        RESC(alX); __syncthreads(); } while (0)
    for (int t = 1; t + 1 < NT; t += 2) {
        HALF_STEP(pB0, pB1, mnB, alB, pA0, pA1, alA, t, 1, 0, 0);
        HALF_STEP(pA0, pA1, mnA, alA, pB0, pB1, alB, t + 1, 0, 1, 1);
    }
    const bool even = (NT & 1) == 0;
    if (even) { SBAR(); qkt<1>(pB0, pB1, K_lds, r32, hi, S.qr); SBAR(); }
    SLOAD_H(nxt.K, nxt.V, kbn, nxt.kp); SBAR();
#pragma unroll
    for (int d0 = 0; d0 < 8; ++d0) S.qr[d0] = load8(nxt.Q + (size_t)(wid * QBLK + r32) * nxt.qp + d0 * 16 + hi * 8);
    SBAR();
    finishSM(pA0, pA1, alA, l_reg, pa0, pa1, pa2, pa3); SBAR();
    pv_tile<0>(o, vb0, pa0, pa1, pa2, pa3);
    if (even) { MASKT(pB0, pB1, NT - 1); partialSM(pB0, pB1, m_reg, mnB, alB); __syncthreads(); RESC(alB);
        finishSM(pB0, pB1, alB, l_reg, pa0, pa1, pa2, pa3); SBAR(); pv_tile<1>(o, vb0, pa0, pa1, pa2, pa3); }
    SBAR(); SEAM_K0();
    if (hi == 0) li_l[r32] = l_reg; asm volatile("s_waitcnt lgkmcnt(0)" ::: "memory");
    float rli[16];
#pragma unroll
    for (int r = 0; r < 16; ++r) rli[r] = __builtin_amdgcn_rcpf(li_l[crow(r, hi)]);
    float* Ow = cur.O + (size_t)(wid * QBLK) * cur.op;
#pragma unroll
    for (int r = 0; r < 16; ++r) { const int orow = crow(r, hi);
#pragma unroll
        for (int d0 = 0; d0 < 4; ++d0) Ow[(size_t)orow * cur.op + d0 * 32 + r32] = o[d0][r] * rli[r]; }
    if (cur.L != nullptr && hi == 0) cur.L[(size_t)(wid * QBLK + r32) * cur.lp] = m_reg * SCALE + __logf(l_reg);
    __syncthreads();
#undef RESC
#undef KBASE
#undef MASKT
#undef SEAM_K0
#undef HALF_STEP
}
#undef ROW
#undef VMW
#undef VMWN
#undef SLOAD_H
#undef SWRITE_HK
#undef SWRITE_HV
#undef SWRITE_H
#undef KSWZ
#undef SBAR
}

namespace att2 {
typedef short bf16x8 __attribute__((ext_vector_type(8)));
typedef short s16x4 __attribute__((ext_vector_type(4)));
typedef float f32x16 __attribute__((ext_vector_type(16)));
typedef unsigned u32x4 __attribute__((ext_vector_type(4)));
typedef unsigned short bf16;
#define A2_LAS __attribute__((address_space(3)))
constexpr int D = 128, NW = 8, QBLK = 32, KVBLK = 64, QB = NW * QBLK;
constexpr int KBUF = KVBLK * D * 2, VIMG = KVBLK * 128 * 2, VBUF = 2 * VIMG;
constexpr int OFF_K = 0, OFF_V = 2 * KBUF, OFF_P = OFF_V + 2 * VBUF, OFF_WS = 131072 + 2048, LDS_END = OFF_WS + NW * 64 * 4;
constexpr float SCALE = 0.08838834764831845f, THR = 8.f;
#define A2_KSWZ(row, colB) ((row) * 256 + ((colB) ^ (((row) & 7) << 4)))
#define A2_SBAR() __builtin_amdgcn_sched_barrier(0)
__device__ __forceinline__ int v_rd_base(int lane) { return ((lane & 3) << 3) | (((lane >> 2) & 3) << 6) | (((lane >> 4) & 1) << 5) | (((lane >> 5) & 1) << 8); }
constexpr int v_rd_off(int d0, int ks, int half) { return d0 * 512 + ks * 4096 + half * 2048; }
__device__ __forceinline__ int crow(int r, int hi) { return (r & 3) + 8 * (r >> 2) + 4 * hi; }
typedef float f32x2_t __attribute__((ext_vector_type(2))); typedef __bf16 bf16x2_t __attribute__((ext_vector_type(2)));
__device__ __forceinline__ unsigned cvtpk(float lo, float hi) { const f32x2_t v = {lo, hi}; const bf16x2_t b = __builtin_convertvector(v, bf16x2_t); return __builtin_bit_cast(unsigned, b); }
__device__ __forceinline__ void mask_tile(f32x16& p0, f32x16& p1, int dq, unsigned W) {
    const float NEG = -__builtin_inff();
#pragma unroll
    for (int r = 0; r < 16; ++r) { const int c = (r & 3) + 8 * (r >> 2);
        if ((unsigned)(dq - c) >= W) p0[r] = NEG;
        if ((unsigned)(dq - c - 32) >= W) p1[r] = NEG; }
}
__device__ __forceinline__ void qkt(f32x16& p0, f32x16& p1, const A2_LAS char* Kb, int r32, int hi, const bf16x8* qr) {
    p0 = f32x16{}; p1 = f32x16{};
    const A2_LAS char* kb[4];
#pragma unroll
    for (int dd = 0; dd < 4; ++dd) kb[dd] = Kb + A2_KSWZ(r32, (dd * 16 + hi * 8) * 2);
    bf16x8 b0 = *reinterpret_cast<const A2_LAS bf16x8*>(kb[0]), b1 = *reinterpret_cast<const A2_LAS bf16x8*>(kb[0] + 32 * 256);
#pragma unroll
    for (int d0 = 0; d0 < 8; ++d0) { bf16x8 n0 = b0, n1 = b1;
        if (d0 < 7) { const A2_LAS char* a = kb[(d0 + 1) & 3] + ((d0 + 1) >> 2) * 128; n0 = *reinterpret_cast<const A2_LAS bf16x8*>(a); n1 = *reinterpret_cast<const A2_LAS bf16x8*>(a + 32 * 256); }
        asm volatile("" ::: "memory");
        p0 = __builtin_amdgcn_mfma_f32_32x32x16_bf16(b0, qr[d0], p0, 0, 0, 0);
        p1 = __builtin_amdgcn_mfma_f32_32x32x16_bf16(b1, qr[d0], p1, 0, 0, 0);
        b0 = n0; b1 = n1; }
}
__device__ __forceinline__ void softmax_tile(f32x16& p0, f32x16& p1, float& m_reg, float& l_reg, float& alpha, bf16x8& pa0, bf16x8& pa1, bf16x8& pa2, bf16x8& pa3) {
    float pmax = p0[0];
#pragma unroll
    for (int r = 1; r < 16; ++r) pmax = fmaxf(pmax, p0[r]);
#pragma unroll
    for (int r = 0; r < 16; ++r) pmax = fmaxf(pmax, p1[r]);
    { auto rr = __builtin_amdgcn_permlane32_swap(__float_as_uint(pmax), __float_as_uint(pmax), false, false);
      pmax = fmaxf(__uint_as_float(rr[0]), __uint_as_float(rr[1])); }
    constexpr float C2 = 1.4426950408889634f * SCALE;
    float mn;
    if (__builtin_expect(__all((pmax - m_reg) * SCALE <= THR), 1)) { mn = m_reg; alpha = 1.f; }
    else { mn = fmaxf(m_reg, pmax); alpha = __builtin_amdgcn_exp2f((m_reg - mn) * C2); m_reg = mn; }
    const float mnL = -mn * C2;
#pragma unroll
    for (int r = 0; r < 16; ++r) { p0[r] = __builtin_amdgcn_exp2f(fmaf(p0[r], C2, mnL)); p1[r] = __builtin_amdgcn_exp2f(fmaf(p1[r], C2, mnL)); }
    float ps = 0.f;
#pragma unroll
    for (int r = 0; r < 16; ++r) ps += p0[r] + p1[r];
    { auto rr = __builtin_amdgcn_permlane32_swap(__float_as_uint(ps), __float_as_uint(ps), false, false);
      ps = __uint_as_float(rr[0]) + __uint_as_float(rr[1]); }
    l_reg = l_reg * alpha + ps;
#define A2_PK4(P, B_, OUT) do { const unsigned a0 = cvtpk(P[B_+0], P[B_+1]), a1 = cvtpk(P[B_+2], P[B_+3]);                 \
        const unsigned b0 = cvtpk(P[B_+4], P[B_+5]), b1 = cvtpk(P[B_+6], P[B_+7]);                                       \
        auto r0 = __builtin_amdgcn_permlane32_swap(a0, b0, false, false); auto r1 = __builtin_amdgcn_permlane32_swap(a1, b1, false, false); \
        u32x4 w = {r0[0], r1[0], r0[1], r1[1]}; OUT = *reinterpret_cast<bf16x8*>(&w); } while (0)
    A2_PK4(p0, 0, pa0); A2_PK4(p0, 8, pa1); A2_PK4(p1, 0, pa2); A2_PK4(p1, 8, pa3);
#undef A2_PK4
}
__device__ __forceinline__ void pv_img(f32x16* o, int vb, bf16x8 pa0, bf16x8 pa1, bf16x8 pa2, bf16x8 pa3) {
#define A2_TRRD(dst, off) asm volatile("ds_read_b64_tr_b16 %0, %1 offset:%2" : "=&v"(dst) : "v"(vb), "i"(off) : "memory")
#define A2_PV_D0(d0) do { s16x4 l0, l1, l2, l3, h0, h1, h2, h3; constexpr int b_ = v_rd_off(d0, 0, 0);                          \
        A2_TRRD(l0, b_); A2_TRRD(h0, b_ + 2048); A2_TRRD(l1, b_ + 4096); A2_TRRD(h1, b_ + 6144); A2_TRRD(l2, b_ + 8192); A2_TRRD(h2, b_ + 10240); A2_TRRD(l3, b_ + 12288); A2_TRRD(h3, b_ + 14336); \
        asm volatile("s_waitcnt lgkmcnt(0)" ::: "memory"); A2_SBAR();                                                        \
        o[d0] = __builtin_amdgcn_mfma_f32_32x32x16_bf16(pa0, (bf16x8){l0[0], l0[1], l0[2], l0[3], h0[0], h0[1], h0[2], h0[3]}, o[d0], 0, 0, 0);   \
        o[d0] = __builtin_amdgcn_mfma_f32_32x32x16_bf16(pa1, (bf16x8){l1[0], l1[1], l1[2], l1[3], h1[0], h1[1], h1[2], h1[3]}, o[d0], 0, 0, 0);   \
        o[d0] = __builtin_amdgcn_mfma_f32_32x32x16_bf16(pa2, (bf16x8){l2[0], l2[1], l2[2], l2[3], h2[0], h2[1], h2[2], h2[3]}, o[d0], 0, 0, 0);   \
        o[d0] = __builtin_amdgcn_mfma_f32_32x32x16_bf16(pa3, (bf16x8){l3[0], l3[1], l3[2], l3[3], h3[0], h3[1], h3[2], h3[3]}, o[d0], 0, 0, 0); } while (0)
    A2_PV_D0(0); A2_PV_D0(1); A2_PV_D0(2); A2_PV_D0(3);
#undef A2_PV_D0
#undef A2_TRRD
}
struct BlockRef { const bf16* Q; const bf16* K; const bf16* V; float* O; float* L; int P0, qp, kp, op, lp, skv, W, dvs; };
__device__ __forceinline__ int jlo(int P0, int W) { const int lowk = P0 - W + 1; return lowk > 0 ? lowk / KVBLK : 0; }
#define A2_BAR() do { asm volatile("" ::: "memory"); __builtin_amdgcn_s_barrier(); asm volatile("" ::: "memory"); } while (0)
#define A2_WAITV(n) asm volatile("s_waitcnt vmcnt(" #n ")" ::: "memory")
__device__ __forceinline__ void block(const BlockRef& cur, A2_LAS unsigned char* lds) {
    int tid = threadIdx.x; asm volatile("" : "+v"(tid));
    const int wid = __builtin_amdgcn_readfirstlane(tid >> 6), lane = tid & 63, r32 = lane & 31, hi = lane >> 5;
    const int half = wid >> 2;
    const int W = cur.W, kp = cur.kp;
    const int j_lo = jlo(cur.P0, W);
    int j_hi = (cur.P0 + QB - 1) / KVBLK + 1; if (j_hi > cur.skv / KVBLK) j_hi = cur.skv / KVBLK;
    const int NT = j_hi - j_lo;
    const int qlo = cur.P0 + wid * QBLK, qm = qlo + r32 - 4 * hi;
    A2_LAS float* wsf = (A2_LAS float*)(lds + OFF_WS) + wid * 64;
    unsigned kof[2], vof[4];
#pragma unroll
    for (int j = 0; j < 2; ++j) { const int row = 4 * (2 * wid + j) + (lane >> 4), cc = (lane & 15) ^ (row & 7); kof[j] = (unsigned)(row * kp + cc * 8) * 2u; }
#pragma unroll
    for (int j = 0; j < 4; ++j) { const int q = 4 * wid + j, img = q >> 4, p = q & 15, st = 2 * p + (lane >> 5), kk = (st >> 2) * 8 + ((lane & 31) >> 2);
        const int k = (kk & ~0xC) | ((kk & 4) << 1) | ((kk & 8) >> 1), col = img * 128 + (st & 3) * 32 + (lane & 3) * 8; vof[j] = (unsigned)(k * kp + col) * 2u; }
    const char* Kg = (const char*)cur.K + (size_t)j_lo * KVBLK * kp * 2; const char* Vg = (const char*)cur.V + (size_t)j_lo * KVBLK * kp * 2;
    const size_t tstep = (size_t)KVBLK * kp * 2;
#define A2_DMA_K(t) do { const char* g_ = Kg + (size_t)(t) * tstep; A2_LAS unsigned char* d_ = lds + OFF_K + ((t) & 1) * KBUF + (2 * wid) * 1024;  \
        __builtin_amdgcn_global_load_lds((const unsigned*)(g_ + kof[0]), (A2_LAS unsigned*)(d_), 16, 0, 0);                                  \
        __builtin_amdgcn_global_load_lds((const unsigned*)(g_ + kof[1]), (A2_LAS unsigned*)(d_ + 1024), 16, 0, 0); } while (0)
#define A2_DMA_V(t) do { const char* g_ = Vg + (size_t)(t) * tstep; A2_LAS unsigned char* d_ = lds + OFF_V + ((t) & 1) * VBUF + (4 * wid) * 1024;  \
        __builtin_amdgcn_global_load_lds((const unsigned*)(g_ + vof[0]), (A2_LAS unsigned*)(d_), 16, 0, 0);                                  \
        __builtin_amdgcn_global_load_lds((const unsigned*)(g_ + vof[1]), (A2_LAS unsigned*)(d_ + 1024), 16, 0, 0);                           \
        __builtin_amdgcn_global_load_lds((const unsigned*)(g_ + vof[2]), (A2_LAS unsigned*)(d_ + 2048), 16, 0, 0);                           \
        __builtin_amdgcn_global_load_lds((const unsigned*)(g_ + vof[3]), (A2_LAS unsigned*)(d_ + 3072), 16, 0, 0); } while (0)
    A2_DMA_K(0); A2_DMA_V(0); if (NT > 1) A2_DMA_K(1);
    bf16x8 qr[8];
#pragma unroll
    for (int d0 = 0; d0 < 8; ++d0) qr[d0] = *reinterpret_cast<const bf16x8*>(cur.Q + (size_t)(wid * QBLK + r32) * cur.qp + d0 * 16 + hi * 8);
    float m_reg = -1e30f, l_reg = 0.f; f32x16 o[8] = {};
    const int vbl = (int)(unsigned)(size_t)(lds + OFF_V) + v_rd_base(lane);
    f32x16 s0, s1; float alpha;
    A2_LAS bf16x8* pw = (A2_LAS bf16x8*)(lds + OFF_P + wid * 4096) + lane;
    A2_WAITV(0); A2_BAR();
#define A2_QK(t) do { qkt(s0, s1, (const A2_LAS char*)(lds + OFF_K + ((t) & 1) * KBUF), r32, hi, qr);                                          \
        { const int kb_ = (j_lo + (t)) * KVBLK; if (kb_ + KVBLK - 1 > qlo || kb_ <= qlo + QBLK - 1 - W) mask_tile(s0, s1, qm - kb_, (unsigned)W); } } while (0)
#define A2_SM() do { { bf16x8 pa0, pa1, pa2, pa3; softmax_tile(s0, s1, m_reg, l_reg, alpha, pa0, pa1, pa2, pa3);                               \
          pw[0] = pa0; pw[64] = pa1; pw[128] = pa2; pw[192] = pa3; }              \
        if (__any(alpha < 1.f)) { if (hi == 0) wsf[r32] = alpha; asm volatile("s_waitcnt lgkmcnt(0)" ::: "memory");                        \
            _Pragma("unroll") for (int d_ = 0; d_ < 8; ++d_) _Pragma("unroll") for (int r = 0; r < 16; ++r) o[d_][r] *= wsf[crow(r, hi)]; } } while (0)
#define A2_PV(t) do { const int vb_ = vbl + ((t) & 1) * VBUF; const bf16x8 pa0 = pw[0], pa1 = pw[64], pa2 = pw[128], pa3 = pw[192]; pv_img(o, vb_, pa0, pa1, pa2, pa3); pv_img(o + 4, vb_ + VIMG, pa0, pa1, pa2, pa3); } while (0)
    A2_QK(0);
    A2_BAR();
    for (int hs = 0; hs <= 2 * NT; ++hs) {
        const int t = hs >> 1, e = hs - half;
        const bool issued = (hs & 1) ? (t + 1 < NT) : (t + 2 < NT);
        if (hs & 1) { if (issued) A2_DMA_V(t + 1); } else { if (issued) A2_DMA_K(t + 2); }
        const bool act = (e >= 0 && e < 2 * NT); const int te = e >> 1;
        if (act && !(e & 1)) { A2_SM(); if (te + 1 < NT) { A2_QK(te + 1); } }
        if (act && (e & 1)) { A2_PV(te); }
        if (hs & 1) { if (issued) A2_WAITV(4); else A2_WAITV(0); }
        else        { if (issued) A2_WAITV(2); else A2_WAITV(0); }
        A2_BAR();
    }
    { int tid2 = threadIdx.x; asm volatile("" : "+v"(tid2)); const int lane2 = tid2 & 63, r32e = lane2 & 31, hie = lane2 >> 5;
      A2_LAS float* wse = (A2_LAS float*)(lds + OFF_WS) + wid * 64;
      if (hie == 0) wse[32 + r32e] = l_reg; asm volatile("s_waitcnt lgkmcnt(0)" ::: "memory");
      float rli[16];
#pragma unroll
      for (int r = 0; r < 16; ++r) rli[r] = __builtin_amdgcn_rcpf(wse[32 + crow(r, hie)]);
      float* Ow = cur.O + (size_t)(wid * QBLK) * cur.op;
#pragma unroll
      for (int r = 0; r < 16; ++r) { const int orow = crow(r, hie);
#pragma unroll
          for (int d0 = 0; d0 < 4; ++d0) Ow[(size_t)orow * cur.op + d0 * 32 + r32e] = o[d0][r] * rli[r]; }
      if (cur.dvs > 128) {
#pragma unroll
          for (int r = 0; r < 16; ++r) { const int orow = crow(r, hie);
#pragma unroll
              for (int d0 = 4; d0 < 8; ++d0) Ow[(size_t)orow * cur.op + d0 * 32 + r32e] = o[d0][r] * rli[r]; } }
      if (cur.L != nullptr && hie == 0) cur.L[(size_t)(wid * QBLK + r32e) * cur.lp] = m_reg * SCALE + __logf(l_reg); }
    A2_WAITV(0); A2_BAR();
#undef A2_DMA_K
#undef A2_DMA_V
#undef A2_QK
#undef A2_SM
#undef A2_PV
}
#undef A2_BAR
#undef A2_WAITV
#undef A2_KSWZ
#undef A2_SBAR
}
#define GAS __attribute__((address_space(1)))
#define LAS __attribute__((address_space(3)))
typedef unsigned short bf16;
typedef unsigned v4u __attribute__((ext_vector_type(4)));
typedef unsigned v2u __attribute__((ext_vector_type(2)));
typedef float f32x4 __attribute__((ext_vector_type(4)));
typedef GAS unsigned gu32;
#define RLX_AGENT __ATOMIC_RELAXED, __HIP_MEMORY_SCOPE_AGENT
#define LDS_WAIT() asm volatile("s_waitcnt lgkmcnt(0)" ::: "memory")
#define VM_WAIT() asm volatile("s_waitcnt vmcnt(0)" ::: "memory")
__device__ __forceinline__ unsigned f2bf(float f) { unsigned u = __builtin_bit_cast(unsigned, f); return (u + 0x7fffu + ((u >> 16) & 1u)) >> 16; }
__device__ __forceinline__ unsigned pk2(float lo, float hi) { return f2bf(lo) | (f2bf(hi) << 16); }
__device__ __forceinline__ float bflo(unsigned u) { return __uint_as_float(u << 16); }
__device__ __forceinline__ float bfhi(unsigned u) { return __uint_as_float(u & 0xffff0000u); }
__device__ __forceinline__ float wave_sum(float v) {
#pragma unroll
    for (int o = 1; o < 64; o <<= 1) v += __shfl_xor(v, o);
    return v;
}
__device__ __forceinline__ float wave_max(float v) {
#pragma unroll
    for (int o = 1; o < 64; o <<= 1) v = fmaxf(v, __shfl_xor(v, o));
    return v;
}
#define XB_TMO      128
#define XB_XCNT(j)  (256  + 64 * (j))
#define XB_XSUB(j)  (1280 + 64 * (j))
#define XB_XGEN(j)  (2304 + 64 * (j))
#define XB_TOP      3328
#define XB_TOPGEN   3392
#define XCD_BAR_WORDS 3456
#define XB_SPIN_CAP (1u << 23)

__device__ __forceinline__ unsigned xb_ld(unsigned* p)              { return __hip_atomic_load(p, __ATOMIC_RELAXED, __HIP_MEMORY_SCOPE_AGENT); }
__device__ __forceinline__ unsigned xb_add(unsigned* p, unsigned v) { return __hip_atomic_fetch_add(p, v, __ATOMIC_RELAXED, __HIP_MEMORY_SCOPE_AGENT); }
__device__ __forceinline__ unsigned xb_xcc_id() { return (unsigned)__builtin_amdgcn_s_getreg((3 << 11) | 20) & 0xFu; }
#define XB_SPIN(cond, bar) do { unsigned _sp = 0; while (cond) { __builtin_amdgcn_s_sleep(1); \
    if ((++_sp & 255u) == 0u) { if (xb_ld(&(bar)[XB_TMO])) break; if (_sp > XB_SPIN_CAP) { atomicAdd(&(bar)[XB_TMO], 1u); break; } } } } while (0)

struct XcdBarrier {
    unsigned* bar; unsigned x;
    volatile LAS unsigned* st;
};

__device__ __forceinline__ XcdBarrier xcd_barrier_post(unsigned* bar, volatile LAS unsigned* st) {
    XcdBarrier b; b.bar = bar; b.x = xb_xcc_id(); b.st = st;
    if (threadIdx.x == 0) (void)xb_add(&bar[XB_XCNT(b.x)], 1u);
    return b;
}
__device__ __forceinline__ void xcd_barrier_complete(unsigned* bar, unsigned x, unsigned& nloc, unsigned& nx) {
    const unsigned G = gridDim.x * gridDim.y * gridDim.z;
    unsigned sum, cnt, mine, sp = 0u;
    for (;;) {
        sum = 0u; cnt = 0u; mine = 0u;
#pragma unroll
        for (unsigned j = 0; j < 16; ++j) { const unsigned c = xb_ld(&bar[XB_XCNT(j)]); sum += c; cnt += (c > 0u) ? 1u : 0u; mine = (j == x) ? c : mine; }
        if (sum == G) break;
        __builtin_amdgcn_s_sleep(1);
        if ((++sp & 255u) == 0u) { if (xb_ld(&bar[XB_TMO])) break; if (sp > XB_SPIN_CAP) { atomicAdd(&bar[XB_TMO], 1u); break; } }
    }
    nloc = mine > 0u ? mine : 1u; nx = cnt > 0u ? cnt : 1u;
}

__device__ __forceinline__ void xcd_barrier(const XcdBarrier& b) {
    asm volatile("s_waitcnt vmcnt(0)" ::: "memory");
    __syncthreads();
    if (threadIdx.x == 0) {
        unsigned* bar = b.bar;
        __builtin_amdgcn_s_waitcnt(0);
        unsigned nloc = b.st[0], nx = b.st[1];
        if (nloc == 0u) { xcd_barrier_complete(bar, b.x, nloc, nx); b.st[0] = nloc; b.st[1] = nx; }
        const unsigned old = xb_add(&bar[XB_XSUB(b.x)], 1u);
        const unsigned gen = old / nloc;
        if (old + 1u == (gen + 1u) * nloc) {
            __builtin_amdgcn_fence(__ATOMIC_RELEASE, "agent");
            asm volatile("s_waitcnt vmcnt(0)" ::: "memory");
            const unsigned og = xb_add(&bar[XB_TOP], 1u);
            const unsigned tg = og / nx;
            if (og + 1u == (tg + 1u) * nx) xb_add(&bar[XB_TOPGEN], 1u);
            else XB_SPIN(xb_ld(&bar[XB_TOPGEN]) == tg, bar);
            __builtin_amdgcn_fence(__ATOMIC_ACQUIRE, "agent");
            xb_add(&bar[XB_XGEN(b.x)], 1u);
            asm volatile("s_waitcnt vmcnt(0)" ::: "memory");
        } else {
            XB_SPIN(xb_ld(&bar[XB_XGEN(b.x)]) == gen, bar);
            __builtin_amdgcn_fence(__ATOMIC_ACQUIRE, "agent");
            asm volatile("s_waitcnt vmcnt(0)" ::: "memory");
        }
    }
    __syncthreads();
}
struct Args { const float* in[16]; float* out; unsigned char* ws; int ph_lo, ph_hi; };

#ifdef SELFTEST
constexpr int CW_FLAG = 64, CW_FLAG2 = 128;
__device__ __forceinline__ void st_flag2(gu32* ctl, unsigned bits) { atomicOr((unsigned*)ctl + CW_FLAG2, bits); }
__device__ __forceinline__ void st_flag(gu32* ctl, int code) { atomicOr((unsigned*)ctl + CW_FLAG, 1u << code); }
__device__ __forceinline__ bool st_close(float got, float want, float rel, float ab) { return fabsf(got - want) <= rel * fabsf(want) + ab; }
__device__ __forceinline__ void scan_poison(const void* p, size_t nbytes, int code, gu32* ctl, size_t gtid, size_t nthreads) {
    const v4u* q = (const v4u*)p; bool bad = false;
    for (size_t i = gtid; i < nbytes / 16; i += nthreads) { const v4u w = q[i]; bad |= (w.x == 0xAAAAAAAAu) | (w.y == 0xAAAAAAAAu) | (w.z == 0xAAAAAAAAu) | (w.w == 0xAAAAAAAAu); }
    if (bad) st_flag(ctl, code);
}
__device__ __forceinline__ float dot_bf16(const bf16* a, const bf16* b, int K, int lane) {
    float s = 0.f;
    for (int k = lane * 8; k < K; k += 512) { const v4u x = *(const v4u*)(a + k), y = *(const v4u*)(b + k);
        s += bflo(x.x) * bflo(y.x) + bfhi(x.x) * bfhi(y.x) + bflo(x.y) * bflo(y.y) + bfhi(x.y) * bfhi(y.y) + bflo(x.z) * bflo(y.z) + bfhi(x.z) * bfhi(y.z) + bflo(x.w) * bflo(y.w) + bfhi(x.w) * bfhi(y.w); }
    return wave_sum(s);
}
__device__ __forceinline__ unsigned hash_u(unsigned x) { x ^= x >> 16; x *= 0x7feb352dU; x ^= x >> 15; x *= 0x846ca68bU; x ^= x >> 16; return x; }
__device__ __forceinline__ float ldbf(const bf16* p) { return __uint_as_float((unsigned)(*p) << 16); }
__device__ __forceinline__ void sincos_d(double x, double& s, double& c) {
    const double TWO_PI = 6.283185307179586; const double k = rint(x / TWO_PI); const double r = x - k * TWO_PI, r2 = r * r;
    double ts = 1.0, tc = 1.0;
    for (int i = 14; i >= 1; --i) { ts = 1.0 - r2 / (double)((2 * i) * (2 * i + 1)) * ts; tc = 1.0 - r2 / (double)((2 * i - 1) * (2 * i)) * tc; }
    s = r * ts; c = tc;
}

template <int NC> __device__ __forceinline__ void brute_row(const bf16* q, const bf16* Kb, const bf16* Vb, size_t kstride, int nkeys, float (&o)[NC], float& lse, int lane) {
    const unsigned qw = *(const unsigned*)(q + 2 * lane); const float q0 = bflo(qw), q1 = bfhi(qw);
    float mx = -1e30f;
    for (int j = 0; j < nkeys; ++j) { const unsigned kw = *(const unsigned*)(Kb + (size_t)j * kstride + 2 * lane); const float sc = wave_sum(q0 * bflo(kw) + q1 * bfhi(kw)) * ATT_SCALE; mx = fmaxf(mx, sc); }
    float l = 0.f;
#pragma unroll
    for (int c = 0; c < NC; ++c) o[c] = 0.f;
    for (int j = 0; j < nkeys; ++j) { const unsigned kw = *(const unsigned*)(Kb + (size_t)j * kstride + 2 * lane); const float sc = wave_sum(q0 * bflo(kw) + q1 * bfhi(kw)) * ATT_SCALE;
        const float p = expf(sc - mx); l += p;
#pragma unroll
        for (int c = 0; c < NC; ++c) o[c] += p * ldbf(Vb + (size_t)j * kstride + lane * NC + c); }
#pragma unroll
    for (int c = 0; c < NC; ++c) o[c] /= l;
    lse = mx + logf(l);
}
__device__ __forceinline__ void selftest(int k, const Args& a, int gw, int NGW, int lane) {
    unsigned char* ws = a.ws; gu32* ctl = (gu32*)(ws + WS_CTL);
    const size_t gtid = (size_t)gw * 64 + lane, nth = (size_t)NGW * 64;
    const bf16* H = (const bf16*)(ws + WS_H);
    if (k == 0) {
        scan_poison(ws + WS_WIN, WS_H + 64 * MiB - WS_WIN, 1, ctl, gtid, nth);
        for (unsigned s = (unsigned)gtid; s < 1u << 20; s += (unsigned)nth) {
            const unsigned h1 = hash_u(s * 2u + 1u), h2 = hash_u(s * 2u + 2u); const int mat = s % 6;
            const float* W; const bf16* WT; int K, N; const float* sc = nullptr;
            if (mat == 0) { W = a.in[2]; WT = (const bf16*)(ws + WS_WIN); K = DM; N = NIN; }
            else if (mat == 1) { W = a.in[4]; WT = (const bf16*)(ws + WS_WA); K = 512; N = DM; }
            else if (mat == 2) { W = a.in[5]; WT = (const bf16*)(ws + WS_WB); K = 2048; N = DM; }
            else if (mat == 3) { W = a.in[6]; WT = (const bf16*)(ws + WS_WOUT); K = DM; N = DM; }
            else if (mat == 4) { W = a.in[13]; WT = (const bf16*)(ws + WS_WFF1); K = DM; N = DFF; sc = a.in[12]; }
            else { W = a.in[14]; WT = (const bf16*)(ws + WS_WFF2); K = DFF; N = DM; }
            const int kk = h1 % K, n = h2 % N; float w = W[(size_t)kk * N + n]; if (sc) w *= sc[kk];
            if (WT[(size_t)n * K + kk] != (bf16)f2bf(w)) st_flag(ctl, 1);
        }
        for (int s = gw; s < 256; s += NGW) {
            const int row = hash_u(s + 777u) % SEQ; const float* xr = a.in[0] + (size_t)row * DM; float ss = 0.f;
            for (int c = lane; c < DM; c += 64) ss += xr[c] * xr[c];
            const float rstd = rsqrtf(wave_sum(ss) * (1.f / DM) + RMS_EPS); bool bad = false;
            for (int c = lane; c < DM; c += 64) bad |= !st_close(ldbf(H + (size_t)row * DM + c), xr[c] * rstd * a.in[1][c], 0.01f, 1e-3f);
            if (bad) st_flag(ctl, 1);
        }
    } else if (k == 1) {
        { const v4u* q = (const v4u*)(ws + WS_QA); bool bad = false;
          for (size_t i = gtid; i < 296 * MiB / 16; i += nth) { const v4u w = q[i]; bad |= (w.x == 0xAAAAAAAAu) | (w.y == 0xAAAAAAAAu) | (w.z == 0xAAAAAAAAu) | (w.w == 0xAAAAAAAAu); }
          if (bad) { st_flag(ctl, 2); st_flag2(ctl, 1u); } }
        for (int s = gw; s < 16384; s += NGW) {
            const int row = (s < 64) ? (s * 131) % SEQ : hash_u(s * 2u + 1u) % SEQ, col = hash_u(s * 2u + 2u) % NIN;
            const float acc = dot_bf16(H + (size_t)row * DM, (const bf16*)(ws + WS_WIN) + (size_t)col * DM, DM, lane);
            size_t off; int ld, c0, mode;
            if (col < 1536) { off = WS_QA; ld = 1536; c0 = col; mode = 1; }
            else if (col < 3072) { off = WS_KA; ld = 1536; c0 = col - 1536; mode = 1; }
            else if (col < 4608) { off = WS_VA; ld = 1536; c0 = col - 3072; mode = 0; }
            else if (col < 6656) { off = WS_QB; ld = 2048; c0 = col - 4608; mode = 1; }
            else if (col < 8704) { off = WS_KB; ld = 2048; c0 = col - 6656; mode = 1; }
            else if (col < 10752) { off = WS_VB; ld = 2048; c0 = col - 8704; mode = 0; }
            else if (col < 14848) { off = WS_GA; ld = 4096; c0 = col - 10752; mode = 2; }
            else { off = WS_GB; ld = 4096; c0 = col - 14848; mode = 2; }
            const float got = ldbf((const bf16*)(ws + off) + (size_t)row * ld + c0);
            float want = acc; int code = 2;
            if (mode == 2) want = 1.f / (1.f + expf(-(acc + a.in[3][col - 10752])));
            else if (mode == 1 && (c0 & 127) < 32) { code = 3; const int d = c0 & 127, j = d & 15;
                const float acc2 = dot_bf16(H + (size_t)row * DM, (const bf16*)(ws + WS_WIN) + (size_t)(col ^ 16) * DM, DM, lane);
                const float inv = (float)exp2(-(double)j * (18.931568569324174 / 16.0)); const float ang = (float)row * inv;
                double sn, cs; sincos_d((double)ang, sn, cs);
                want = (d < 16) ? acc * (float)cs - acc2 * (float)sn : acc * (float)cs + acc2 * (float)sn; }
            if (mode == 2 && lane == 0) atomicAdd((unsigned*)ctl + CW_FLAG2 + 2, 1u);
            if (!st_close(got, want, 0.02f, 0.03f)) { st_flag(ctl, code);
                if (mode == 2) { const int pn = col / 256; st_flag2(ctl, (pn < 58 ? 1u : 0u) | ((pn >= 58 && pn != 73) ? 2u : 0u) | (pn == 73 ? 4u : 0u) | (((row & 255) < 128) ? 8u : 16u)); if (lane == 0) atomicAdd((unsigned*)ctl + CW_FLAG2 + 1, 1u); } }
        }
    } else if (k == 2) {
        scan_poison(ws + WS_OA, 176 * MiB, 4, ctl, gtid, nth); scan_poison(ws + WS_LSE, 3 * SEQ * 4 * 4, 4, ctl, gtid, nth);
        const float* OA = (const float*)(ws + WS_OA); const float* OB = (const float*)(ws + WS_OB); const float* LSE = (const float*)(ws + WS_LSE);
        for (int s = gw; s < 1024; s += NGW) {
            const int t = (s < 200) ? s * 3 : hash_u(s * 2u + 1u) % SEQ, ah = hash_u(s * 2u + 2u) % 12, g = ah >> 2, r = (g == 0) ? 1 : (g == 1) ? 4 : 16;
            const int i = t / r, rho = t % r, i0 = (i > 128) ? i - 128 : 0;
            const bf16* KA = (const bf16*)(ws + WS_KA) + (size_t)(rho + r * i0) * 1536 + ah * 128; const bf16* VA = (const bf16*)(ws + WS_VA) + (size_t)(rho + r * i0) * 1536 + ah * 128;
            float o[2]; float lse; brute_row<2>((const bf16*)(ws + WS_QA) + (size_t)t * 1536 + ah * 128, KA, VA, (size_t)r * 1536, i - i0 + 1, o, lse, lane);
            const float* got = OA + ((size_t)g * SEQ + t) * 512 + (ah & 3) * 128 + lane * 2;
            if (!st_close(got[0], o[0], 2e-3f, 2e-3f) || !st_close(got[1], o[1], 2e-3f, 2e-3f) || !st_close(LSE[((size_t)g * SEQ + t) * 4 + (ah & 3)], lse, 1e-3f, 2e-3f)) st_flag(ctl, 10);
        }
        for (int s = gw; s < 512; s += NGW) {
            const int t = (s < 100) ? s * 2 : hash_u(s * 2u + 1u) % SEQ, hi = hash_u(s * 2u + 2u) % 16;
            float o[4]; float lse; brute_row<4>((const bf16*)(ws + WS_QB) + (size_t)t * 2048 + hi * 128, (const bf16*)(ws + WS_KB) + hi * 128, (const bf16*)(ws + WS_VB) + (hi >> 1) * 256, (size_t)2048, t + 1, o, lse, lane);
            const float* got = OB + (size_t)t * 4096 + hi * 256 + lane * 4; bool bad = false;
#pragma unroll
            for (int c = 0; c < 4; ++c) bad |= !st_close(got[c], o[c], 2e-3f, 2e-3f);
            if (bad) st_flag(ctl, 11);
        }
    } else if (k == 3) {
        scan_poison(ws + WS_YA, 40 * MiB, 5, ctl, gtid, nth);
        const float* OA = (const float*)(ws + WS_OA); const float* OB = (const float*)(ws + WS_OB); const float* LSE = (const float*)(ws + WS_LSE);
        float d1 = 0.f, d2 = 0.f; for (int e = 0; e < 128; ++e) { d1 += a.in[7][e] * a.in[8][e]; d2 += a.in[9][e] * a.in[10][e]; }
        const float lam = expf(d1) - expf(d2) + 0.2f;
        for (int s = gw; s < 256; s += NGW) { const int t = hash_u(s + 99u) % SEQ; bool bad = false;
            for (int c = lane; c < 512; c += 64) { const int hg = c >> 7; float l[3], mx = -1e30f; for (int g = 0; g < 3; ++g) { l[g] = LSE[((size_t)g * SEQ + t) * 4 + hg]; mx = fmaxf(mx, l[g]); }
                float den = 0.f, num = 0.f; for (int g = 0; g < 3; ++g) { const float e = expf(l[g] - mx); den += e; num += e * OA[((size_t)g * SEQ + t) * 512 + c]; }
                bad |= !st_close(ldbf((const bf16*)(ws + WS_YA) + (size_t)t * 512 + c), num / den, 0.01f, 1e-3f); }
            for (int h = 0; h < 8; ++h) { float dd[4]; float ss = 0.f;
                for (int e = 0; e < 4; ++e) { const int c = lane + 64 * e; dd[e] = OB[(size_t)t * 4096 + (2 * h) * 256 + c] - lam * OB[(size_t)t * 4096 + (2 * h + 1) * 256 + c]; ss += dd[e] * dd[e]; }
                ss = wave_sum(ss); const float rstd = 0.8f / sqrtf(ss / 256.f + RMS_EPS);
                for (int e = 0; e < 4; ++e) { const int c = lane + 64 * e; bad |= !st_close(ldbf((const bf16*)(ws + WS_YB) + (size_t)t * 2048 + h * 256 + c), dd[e] * rstd * a.in[11][c], 0.01f, 2e-3f); } }
            if (bad) st_flag(ctl, 12);
        }
    } else if (k == 4) {
        scan_poison(ws + WS_T, 128 * MiB, 6, ctl, gtid, nth);
        for (int s = gw; s < 8192; s += NGW) {
            const int row = (s < 64) ? (s * 131) % SEQ : hash_u(s * 2u + 1u) % SEQ, col = hash_u(s * 2u + 2u) % DM;
            const float pa = dot_bf16((const bf16*)(ws + WS_YA) + (size_t)row * 512, (const bf16*)(ws + WS_WA) + (size_t)col * 512, 512, lane);
            const float pb = dot_bf16((const bf16*)(ws + WS_YB) + (size_t)row * 2048, (const bf16*)(ws + WS_WB) + (size_t)col * 2048, 2048, lane);
            const size_t idx = (size_t)row * DM + col;
            const float want = ldbf((const bf16*)(ws + WS_GA) + idx) * pa + ldbf((const bf16*)(ws + WS_GB) + idx) * pb;
            if (!st_close(ldbf((const bf16*)(ws + WS_MG) + idx), want, 0.02f, 0.02f)) st_flag(ctl, 6);
        }
    } else if (k == 5) {
        scan_poison(ws + WS_H, 64 * MiB, 7, ctl, gtid, nth); scan_poison(ws + WS_RSS, 2 * MiB, 7, ctl, gtid, nth);
        for (int s = gw; s < 8192; s += NGW) {
            const int row = (s < 64) ? (s * 131) % SEQ : hash_u(s * 2u + 1u) % SEQ, col = hash_u(s * 2u + 2u) % DM; const size_t idx = (size_t)row * DM + col;
            const float acc = dot_bf16((const bf16*)(ws + WS_MG) + (size_t)row * DM, (const bf16*)(ws + WS_WOUT) + (size_t)col * DM, DM, lane);
            const float want = a.in[0][idx] + acc;
            if (!st_close(ldbf(H + idx), want, 0.01f, 0.005f)) st_flag(ctl, 7);
            if (s < 512) { float ss = 0.f; for (int c = lane; c < DM; c += 64) { const float v = ldbf(H + (size_t)row * DM + c); ss += v * v; }
                ss = wave_sum(ss); const float part = wave_sum(((const float*)(ws + WS_RSS))[(size_t)row * 64 + lane]);
                if (!st_close(part, ss, 5e-3f, 1e-3f)) st_flag(ctl, 13); }
        }
    } else if (k == 6) {
        scan_poison(ws + WS_U2, 256 * MiB, 8, ctl, gtid, nth);
        for (int s = gw; s < 8192; s += NGW) {
            const int row = (s < 64) ? (s * 131) % SEQ : hash_u(s * 2u + 1u) % SEQ, col = hash_u(s * 2u + 2u) % DFF;
            const float part = wave_sum(((const float*)(ws + WS_RSS))[(size_t)row * 64 + lane]);
            const float rstd = rsqrtf(part * (1.f / DM) + RMS_EPS);
            const float acc = dot_bf16(H + (size_t)row * DM, (const bf16*)(ws + WS_WFF1) + (size_t)col * DM, DM, lane);
            float u = fmaxf(acc * rstd, 0.f); u *= u;
            if (!st_close(ldbf((const bf16*)(ws + WS_U2) + (size_t)row * DFF + col), u, 0.02f, 0.01f)) st_flag(ctl, 8);
        }
    } else if (k == 7) {
        for (int s = gw; s < 8192; s += NGW) {
            const int row = (s < 64) ? (s * 131) % SEQ : hash_u(s * 2u + 1u) % SEQ, col = hash_u(s * 2u + 2u) % DM; const size_t idx = (size_t)row * DM + col;
            const float acc = dot_bf16((const bf16*)(ws + WS_U2) + (size_t)row * DFF, (const bf16*)(ws + WS_WFF2) + (size_t)col * DFF, DFF, lane);
            const float x1 = ldbf(H + idx);
            if (!st_close(a.out[idx], x1 + acc, 0.005f, 0.01f + 0.005f * fabsf(x1))) st_flag(ctl, 9);
        }
    }
}
#endif
__device__ __forceinline__ void p0_transpose_item(const float* W, int K, int N, bf16* WT, const float* kscale, LAS unsigned* scr, int item, int lane) {
    const int nblk = N / 64, kb = item / nblk, nb = item - kb * nblk, k0 = 64 * kb, n0 = 64 * nb;
    const GAS float* src = (const GAS float*)W + (size_t)k0 * N + n0 + lane;
    float v[64];
#pragma unroll
    for (int i = 0; i < 64; ++i) v[i] = src[(size_t)i * N];
    if (kscale) {
#pragma unroll
        for (int i = 0; i < 64; ++i) v[i] *= kscale[k0 + i]; }
#pragma unroll
    for (int i = 0; i < 32; ++i) scr[lane * 33 + i] = pk2(v[2 * i], v[2 * i + 1]);
    LDS_WAIT(); asm volatile("" ::: "memory");
    const int c = lane & 7;
#pragma unroll
    for (int j = 0; j < 8; ++j) { const int n = (lane >> 3) + 8 * j; const LAS unsigned* q = scr + n * 33 + 4 * c;
        v4u o; o.x = q[0]; o.y = q[1]; o.z = q[2]; o.w = q[3];
        *(GAS v4u*)(WT + (size_t)(n0 + n) * K + k0 + 8 * c) = o; }
    LDS_WAIT(); asm volatile("" ::: "memory");
}
template <bool OUT_BF16> __device__ __forceinline__ void rms_row(const float* xrow, const float* g, void* orow, int lane, float oscale = 1.f) {
    const GAS f32x4* xr = (const GAS f32x4*)xrow + lane; const GAS f32x4* gr = (const GAS f32x4*)g + lane;
    f32x4 v[16], gq[16]; float s = 0.f;
#pragma unroll
    for (int j = 0; j < 16; ++j) v[j] = xr[64 * j];
#pragma unroll
    for (int j = 0; j < 16; ++j) gq[j] = gr[64 * j];
#pragma unroll
    for (int j = 0; j < 16; ++j) s += (v[j].x * v[j].x + v[j].y * v[j].y) + (v[j].z * v[j].z + v[j].w * v[j].w);
    const float rstd = rsqrtf(wave_sum(s) * (1.f / DM) + RMS_EPS) * oscale;
#pragma unroll
    for (int j = 0; j < 16; ++j) { const f32x4 o = v[j] * rstd * gq[j];
        if (OUT_BF16) { v2u w; w.x = pk2(o.x, o.y); w.y = pk2(o.z, o.w); ((GAS v2u*)orow)[lane + 64 * j] = w; }
        else ((GAS f32x4*)orow)[lane + 64 * j] = o; }
}
__device__ __forceinline__ void p0_prologue(const Args& a, LAS unsigned char* L, int gw, int NGW, int wave, int lane) {
    LAS unsigned* scr = (LAS unsigned*)(L + wave * 16384);
    unsigned char* ws = a.ws;
    constexpr int I_IN = (DM / 64) * (NIN / 64), I_2 = (DFF / 64) * (DM / 64);
    for (int it = gw; it < I_IN + I_2; it += NGW) {
        if (it < I_IN) p0_transpose_item(a.in[2], DM, NIN, (bf16*)(ws + WS_WIN), nullptr, scr, it, lane);
        else p0_transpose_item(a.in[14], DFF, DM, (bf16*)(ws + WS_WFF2), nullptr, scr, it - I_IN, lane);
    }
    for (int m = gw; m < SEQ; m += NGW) rms_row<true>(a.in[0] + (size_t)m * DM, a.in[1], (bf16*)(ws + WS_H) + (size_t)m * DM, lane);
}
__device__ __forceinline__ void p0_convert_rest(const Args& a, LAS unsigned char* L, int cw, int NCW, int wave, int lane) {
    LAS unsigned* scr = (LAS unsigned*)(L + wave * 16384);
    unsigned char* ws = a.ws;
    constexpr int I_A = (512 / 64) * (DM / 64), I_B = (2048 / 64) * (DM / 64), I_O = (DM / 64) * (DM / 64), I_1 = (DM / 64) * (DFF / 64);
    constexpr int NITEMS = I_A + I_B + I_O + I_1;
    for (int it = cw; it < NITEMS; it += NCW) {
        int r = it;
        if (r < I_A) { p0_transpose_item(a.in[4], 512, DM, (bf16*)(ws + WS_WA), nullptr, scr, r, lane); continue; } r -= I_A;
        if (r < I_B) { p0_transpose_item(a.in[5], 2048, DM, (bf16*)(ws + WS_WB), nullptr, scr, r, lane); continue; } r -= I_B;
        if (r < I_O) { p0_transpose_item(a.in[6], DM, DM, (bf16*)(ws + WS_WOUT), nullptr, scr, r, lane); continue; } r -= I_O;
        p0_transpose_item(a.in[13], DM, DFF, (bf16*)(ws + WS_WFF1), a.in[12], scr, r, lane);
    }
}

template <int DV> __device__ __forceinline__ void naive_row(const bf16* q, const bf16* Kb, const bf16* Vb, size_t kstride, int nkeys, LAS float* qs, LAS float* ps, float (&o)[DV / 64], float& lse, int lane) {
    constexpr int NC = DV / 64;
    { const unsigned w = *(const unsigned*)(q + 2 * lane); qs[2 * lane] = bflo(w); qs[2 * lane + 1] = bfhi(w); }
    LDS_WAIT(); asm volatile("" ::: "memory");
    float m = -1e30f, l = 0.f;
#pragma unroll
    for (int c = 0; c < NC; ++c) o[c] = 0.f;
    for (int c0 = 0; c0 < nkeys; c0 += 64) {
        const int j = c0 + lane; const bool valid = j < nkeys;
        float s = -__builtin_inff();
        if (valid) { const v4u* kp = (const v4u*)(Kb + (size_t)j * kstride); float acc = 0.f;
#pragma unroll 4
            for (int d = 0; d < 16; ++d) { const v4u kv = kp[d]; const LAS float* qq = qs + 8 * d;
                acc += bflo(kv.x) * qq[0] + bfhi(kv.x) * qq[1] + bflo(kv.y) * qq[2] + bfhi(kv.y) * qq[3] + bflo(kv.z) * qq[4] + bfhi(kv.z) * qq[5] + bflo(kv.w) * qq[6] + bfhi(kv.w) * qq[7]; }
            s = acc * ATT_SCALE; }
        const float mn = fmaxf(m, wave_max(s));
        const float p = valid ? __expf(s - mn) : 0.f;
        const float alpha = __expf(m - mn);
        l = l * alpha + wave_sum(p); m = mn;
#pragma unroll
        for (int c = 0; c < NC; ++c) o[c] *= alpha;
        ps[lane] = p; LDS_WAIT(); asm volatile("" ::: "memory");
        const int cnt = (nkeys - c0) < 64 ? (nkeys - c0) : 64;
        const bf16* vp = Vb + (size_t)c0 * kstride + lane * NC;
#pragma unroll 4
        for (int kk = 0; kk < cnt; ++kk) { const float pj = ps[kk];
            if constexpr (NC == 2) { const unsigned w = *(const unsigned*)(vp + (size_t)kk * kstride); o[0] += pj * bflo(w); o[1] += pj * bfhi(w); }
            else { const v2u w = *(const v2u*)(vp + (size_t)kk * kstride); o[0] += pj * bflo(w.x); o[1] += pj * bfhi(w.x); o[NC - 2] += pj * bflo(w.y); o[NC - 1] += pj * bfhi(w.y); } }
        LDS_WAIT(); asm volatile("" ::: "memory");
    }
    const float inv = 1.f / l;
#pragma unroll
    for (int c = 0; c < NC; ++c) o[c] *= inv;
    lse = m + __logf(l);
}
__device__ __forceinline__ void p2_attention_naive(const Args& a, LAS unsigned char* L, int gw, int NGW, int wave, int lane) {
    unsigned char* ws = a.ws;
    LAS float* qs = (LAS float*)(L + wave * 1024); LAS float* ps = qs + 128;
    const bf16* QA = (const bf16*)(ws + WS_QA); const bf16* KA = (const bf16*)(ws + WS_KA); const bf16* VA = (const bf16*)(ws + WS_VA);
    const bf16* QB = (const bf16*)(ws + WS_QB); const bf16* KB = (const bf16*)(ws + WS_KB); const bf16* VB = (const bf16*)(ws + WS_VB);
    float* OA = (float*)(ws + WS_OA); float* OB = (float*)(ws + WS_OB); float* LSE = (float*)(ws + WS_LSE);
    for (int it = gw; it < SEQ * 12; it += NGW) {
        const int t = it / 12, ah = it - t * 12, g = ah >> 2, r = (g == 0) ? 1 : (g == 1) ? 4 : 16;
        const int i = t / r, rho = t - i * r, i0 = (i - 128) > 0 ? (i - 128) : 0, nkeys = i - i0 + 1;
        const size_t first = (size_t)(rho + r * i0) * 1536 + ah * 128;
        float o[2]; float lse;
        naive_row<128>(QA + (size_t)t * 1536 + ah * 128, KA + first, VA + first, (size_t)r * 1536, nkeys, qs, ps, o, lse, lane);
        float* op = OA + ((size_t)g * SEQ + t) * 512 + (ah & 3) * 128 + lane * 2; op[0] = o[0]; op[1] = o[1];
        if (lane == 0) LSE[((size_t)g * SEQ + t) * 4 + (ah & 3)] = lse;
    }
    for (int it = gw; it < SEQ * 16; it += NGW) {
        const int t = it >> 4, hi = it & 15;
        float o[4]; float lse;
        naive_row<256>(QB + (size_t)t * 2048 + hi * 128, KB + hi * 128, VB + (hi >> 1) * 256, (size_t)2048, t + 1, qs, ps, o, lse, lane);
        *(f32x4*)(OB + (size_t)t * 4096 + hi * 256 + lane * 4) = (f32x4){o[0], o[1], o[2], o[3]};
    }
}
__device__ __forceinline__ void p2_make_block(unsigned char* ws, int vcu, int k, swa::BlockRef& b) {
    if (k < 4) {
        const int item = vcu + 256 * (k >> 1), vh = item >> 4, x = item & 15, hi = vh >> 1, vhalf = vh & 1, qb = (k & 1) ? 31 - x : x;
        b.Q = (const swa::bf16*)(ws + WS_QB) + (size_t)(qb * 256) * 2048 + hi * 128; b.K = (const swa::bf16*)(ws + WS_KB) + hi * 128; b.V = (const swa::bf16*)(ws + WS_VB) + (hi >> 1) * 256 + vhalf * 128;
        b.O = (float*)(ws + WS_OB) + (size_t)(qb * 256) * 4096 + hi * 256 + vhalf * 128; b.L = nullptr;
        b.P0 = qb * 256; b.qp = 2048; b.kp = 2048; b.op = 4096; b.lp = 0; b.skv = SEQ; b.W = 1 << 20;
    } else {
        const int ab = vcu + 256 * (k - 4), g = ab >> 7, idx = ab & 127, hg = idx >> 5, rem = idx & 31;
        const int r = (g == 0) ? 1 : (g == 1) ? 4 : 16, rho = (g == 0) ? 0 : (g == 1) ? (rem >> 3) : (rem >> 1), qb = (g == 0) ? rem : (g == 1) ? (rem & 7) : (rem & 1), ah = g * 4 + hg;
        const size_t row0 = (size_t)rho + (size_t)r * (qb * 256);
        b.Q = (const swa::bf16*)(ws + WS_QA) + row0 * 1536 + ah * 128; b.K = (const swa::bf16*)(ws + WS_KA) + (size_t)rho * 1536 + ah * 128; b.V = (const swa::bf16*)(ws + WS_VA) + (size_t)rho * 1536 + ah * 128;
        b.O = (float*)(ws + WS_OA) + ((size_t)g * SEQ + row0) * 512 + hg * 128; b.L = (float*)(ws + WS_LSE) + ((size_t)g * SEQ + row0) * 4 + hg;
        b.P0 = qb * 256; b.qp = r * 1536; b.kp = r * 1536; b.op = r * 512; b.lp = r * 4; b.skv = SEQ / r; b.W = 129;
    }
}
__device__ __forceinline__ void p2_attention_mfma(unsigned char* ws, char* lds, int vcu, int reps) {
    swa::Seam S; swa::BlockRef cur, nxt;
    const int nb1 = (vcu < 128) ? 6 : 5, nblk = nb1 * reps;
    p2_make_block(ws, vcu, 0, cur);
    swa::causal_swa_prime(cur, lds, S);
    for (int k = 0; k < nblk; ++k) {
        if (k + 1 < nblk) p2_make_block(ws, vcu, (k + 1) % nb1, nxt); else nxt = cur;
        swa::causal_swa_block(cur, nxt, lds, S);
        cur = nxt;
    }
}
__device__ __forceinline__ void p2_make_block2(unsigned char* ws, int vcu, int k, att2::BlockRef& b) {
    if (k < 2) {
        const int hi = vcu >> 4, x = vcu & 15, qb = (k & 1) ? 31 - x : x;
        b.Q = (const att2::bf16*)(ws + WS_QB) + (size_t)(qb * 256) * 2048 + hi * 128; b.K = (const att2::bf16*)(ws + WS_KB) + hi * 128; b.V = (const att2::bf16*)(ws + WS_VB) + (hi >> 1) * 256;
        b.O = (float*)(ws + WS_OB) + (size_t)(qb * 256) * 4096 + hi * 256; b.L = nullptr;
        b.P0 = qb * 256; b.qp = 2048; b.kp = 2048; b.op = 4096; b.lp = 0; b.skv = SEQ; b.W = 1 << 20; b.dvs = 256;
    } else {
        const int ab = vcu + 256 * (k - 2), g = ab >> 7, idx = ab & 127, hg = idx >> 5, rem = idx & 31;
        const int r = (g == 0) ? 1 : (g == 1) ? 4 : 16, rho = (g == 0) ? 0 : (g == 1) ? (rem >> 3) : (rem >> 1), qb = (g == 0) ? rem : (g == 1) ? (rem & 7) : (rem & 1), ah = g * 4 + hg;
        const size_t row0 = (size_t)rho + (size_t)r * (qb * 256);
        b.Q = (const att2::bf16*)(ws + WS_QA) + row0 * 1536 + ah * 128; b.K = (const att2::bf16*)(ws + WS_KA) + (size_t)rho * 1536 + ah * 128; b.V = (const att2::bf16*)(ws + WS_VA) + (size_t)rho * 1536 + ah * 128;
        b.O = (float*)(ws + WS_OA) + ((size_t)g * SEQ + row0) * 512 + hg * 128; b.L = (float*)(ws + WS_LSE) + ((size_t)g * SEQ + row0) * 4 + hg;
        b.P0 = qb * 256; b.qp = r * 1536; b.kp = r * 1536; b.op = r * 512; b.lp = r * 4; b.skv = SEQ / r; b.W = 129; b.dvs = 128;
    }
}
__device__ __forceinline__ void p2_attention_att2(unsigned char* ws, LAS unsigned char* lds, int vcu, int reps) {
    const int nb1 = (vcu < 128) ? 4 : 3, nblk = nb1 * reps;
    for (int k = 0; k < nblk; ++k) { att2::BlockRef b; p2_make_block2(ws, vcu, k % nb1, b); att2::block(b, lds); }
}
__device__ __forceinline__ void p3_combine(const Args& a, int gw, int NGW, int lane) {
    unsigned char* ws = a.ws;
    const float* OA = (const float*)(ws + WS_OA); const float* OB = (const float*)(ws + WS_OB); const float* LSE = (const float*)(ws + WS_LSE);
    bf16* YA = (bf16*)(ws + WS_YA); bf16* YB = (bf16*)(ws + WS_YB);
    float d1 = a.in[7][lane] * a.in[8][lane] + a.in[7][lane + 64] * a.in[8][lane + 64];
    float d2 = a.in[9][lane] * a.in[10][lane] + a.in[9][lane + 64] * a.in[10][lane + 64];
    d1 = wave_sum(d1); d2 = wave_sum(d2);
    const float lam_init = 0.2f;
    const float lam = expf(d1) - expf(d2) + lam_init;
    const f32x4 sg = *(const f32x4*)(a.in[11] + lane * 4);
    for (int t = gw; t < SEQ; t += NGW) {
        const int hg = lane >> 4;
        const float l0 = LSE[((size_t)0 * SEQ + t) * 4 + hg], l1 = LSE[((size_t)1 * SEQ + t) * 4 + hg], l2 = LSE[((size_t)2 * SEQ + t) * 4 + hg];
        const f32x4* p0 = (const f32x4*)(OA + ((size_t)0 * SEQ + t) * 512 + lane * 8); const f32x4* p1 = (const f32x4*)(OA + ((size_t)1 * SEQ + t) * 512 + lane * 8); const f32x4* p2 = (const f32x4*)(OA + ((size_t)2 * SEQ + t) * 512 + lane * 8);
        const f32x4 a00 = p0[0], a01 = p0[1], a10 = p1[0], a11 = p1[1], a20 = p2[0], a21 = p2[1];
        f32x4 o1[8], o2[8];
#pragma unroll
        for (int h = 0; h < 8; ++h) { o1[h] = *(const f32x4*)(OB + (size_t)t * 4096 + (2 * h) * 256 + lane * 4); o2[h] = *(const f32x4*)(OB + (size_t)t * 4096 + (2 * h + 1) * 256 + lane * 4); }
        { const float mx = fmaxf(l0, fmaxf(l1, l2)); const float e0 = expf(l0 - mx), e1 = expf(l1 - mx), e2 = expf(l2 - mx); const float inv = 1.f / (e0 + e1 + e2);
          const float w0 = e0 * inv, w1 = e1 * inv, w2 = e2 * inv;
          const f32x4 x0 = a00 * w0 + a10 * w1 + a20 * w2, x1 = a01 * w0 + a11 * w1 + a21 * w2;
          v4u w; w.x = pk2(x0.x, x0.y); w.y = pk2(x0.z, x0.w); w.z = pk2(x1.x, x1.y); w.w = pk2(x1.z, x1.w);
          *(v4u*)(YA + (size_t)t * 512 + lane * 8) = w; }
#pragma unroll
        for (int h = 0; h < 8; ++h) {
            const f32x4 d = o1[h] - o2[h] * lam;
            const float ss = wave_sum((d.x * d.x + d.y * d.y) + (d.z * d.z + d.w * d.w));
            const float rstd = rsqrtf(ss * (1.f / 256.f) + RMS_EPS) * (1.f - lam_init);
            const f32x4 y = d * rstd * sg;
            v2u w; w.x = pk2(y.x, y.y); w.y = pk2(y.z, y.w);
            *(v2u*)(YB + (size_t)t * 2048 + h * 256 + lane * 4) = w;
        }
    }
}

__device__ __forceinline__ int lane_id() { return (int)__builtin_amdgcn_mbcnt_hi(~0u, __builtin_amdgcn_mbcnt_lo(~0u, 0u)); }
__device__ __forceinline__ const float* uload_ptr(const LAS unsigned long long* p) { const unsigned long long v = *p;
    const unsigned lo = __builtin_amdgcn_readfirstlane((unsigned)v), hi = __builtin_amdgcn_readfirstlane((unsigned)(v >> 32)); return (const float*)(const GAS float*)(((unsigned long long)hi << 32) | lo); }
__global__ void __launch_bounds__(NWAVES * 64, 2) fwd(Args args) {
    extern __shared__ __attribute__((aligned(16))) unsigned char lds[];
    LAS unsigned char* L = (LAS unsigned char*)lds;
    volatile LAS unsigned* MISC = (volatile LAS unsigned*)(L + MISC_OFF);
    const int tid = threadIdx.x, wave = __builtin_amdgcn_readfirstlane(tid >> 6);
#define lane lane_id()
    const int G = gridDim.x, bx = blockIdx.x;
    const int vcu = (G % 8 == 0) ? (bx % 8) * (G / 8) + bx / 8 : bx;
    const int gw = vcu * NWAVES + wave, NGW = G * NWAVES;
    unsigned char* ws = args.ws;
    gu32* ctl = (gu32*)(ws + WS_CTL);
    for (int u = tid; u < (LDS_BYTES - LDSCTL_OFF) / 4; u += NWAVES * 64) ((LAS unsigned*)(L + LDSCTL_OFF))[u] = 0u;
    __syncthreads();
    LAS unsigned long long* ptab = (LAS unsigned long long*)(L + PTAB_OFF);
    if (tid == 0) {
#pragma unroll
        for (int k = 0; k < 16; ++k) ptab[k] = (unsigned long long)args.in[k]; }
    __syncthreads();
#define PIN(k) uload_ptr(ptab + (k))
    const int lo = args.ph_lo, hi = args.ph_hi;
    const bool multi = (hi - lo) > 1;
    XcdBarrier bar; bar.bar = (unsigned*)(ctl + CW_BAR); bar.x = 0; bar.st = nullptr;
    if (multi) bar = xcd_barrier_post((unsigned*)(ctl + CW_BAR), MISC + 8);
#ifdef SELFTEST
    if (lo >= 16) { selftest(lo - 16, args, gw, NGW, lane); return; }
#endif
#define IN(k) (lo <= (k) && (k) < hi)
#ifdef SELFTEST
#define SEAM(k) do { if (IN(k) && IN((k) + 1)) { xcd_barrier(bar); selftest((k), args, gw, NGW, lane); xcd_barrier(bar); } } while (0)
#elif defined(DIAG_PHASE)
#define SEAM(k) do { if (IN(k) && IN((k) + 1)) { xcd_barrier(bar); if (blockIdx.x == 0 && threadIdx.x == 0) ((unsigned long long*)(args.ws + 2048))[(k) + 1] = __builtin_amdgcn_s_memrealtime(); } } while (0)
#else
#define SEAM(k) do { if (IN(k) && IN((k) + 1)) xcd_barrier(bar); } while (0)
#endif

#ifndef PROBE_REPEAT
#define PROBE_REPEAT -1
#endif
#define NREP(k) ((PROBE_REPEAT == (k)) ? 2 : 1)
#ifdef DIAG_PHASE
    if (blockIdx.x == 0 && threadIdx.x == 0) ((unsigned long long*)(args.ws + 2048))[0] = __builtin_amdgcn_s_memrealtime();
#endif
    if (IN(0)) { Args la; la.ws = ws; la.in[0] = PIN(0); la.in[1] = PIN(1); la.in[2] = PIN(2); la.in[14] = PIN(14);
        for (int rep_ = 0; rep_ < NREP(0); ++rep_) p0_prologue(la, L, gw, NGW, wave, lane); SEAM(0); }

    if (IN(1)) {
        pg8::Gemm g{(const bf16*)(ws + WS_H), (const bf16*)(ws + WS_WIN), SEQ, NIN, DM}; pg8::StaticOrder S; S.init(SEQ, NIN, G, bx); S.rep = NREP(1);
        pg8::EpiProj E{ws, PIN(3)};
        pg8::gemm_phase<pg8::EpiProj, pg8::StaticOrder, true, true>(L, g, S, E);
        { const int extra = ((SEQ / 256) * (NIN / 256)) % G;
          if (bx >= extra) { Args la; la.ws = ws; la.in[4] = PIN(4); la.in[5] = PIN(5); la.in[6] = PIN(6); la.in[12] = PIN(12); la.in[13] = PIN(13);
              p0_convert_rest(la, L, (bx - extra) * NWAVES + wave, (G - extra) * NWAVES, wave, lane); } }
        SEAM(1);
    }
#ifdef NAIVE_ATTN
    if (IN(2)) { p2_attention_naive(args, L, gw, NGW, wave, lane); SEAM(2); }
#elif defined(ATT_SWA)
    if (IN(2)) { p2_attention_mfma(ws, (char*)lds, vcu, NREP(2)); SEAM(2); }
#else
    if (IN(2)) { p2_attention_att2(ws, L, vcu, NREP(2)); SEAM(2); }
#endif
    if (IN(3)) { Args la; la.ws = ws; la.in[7] = PIN(7); la.in[8] = PIN(8); la.in[9] = PIN(9); la.in[10] = PIN(10); la.in[11] = PIN(11);
        for (int rep_ = 0; rep_ < NREP(3); ++rep_) p3_combine(la, gw, NGW, lane); SEAM(3); }
    if (IN(4)) {
        { pg8::Gemm g{(const bf16*)(ws + WS_YA), (const bf16*)(ws + WS_WA), SEQ, DM, 512}; pg8::StaticOrder S; S.init(SEQ, DM, G, bx); S.rep = NREP(4);
          pg8::EpiGate<false> E{(const bf16*)(ws + WS_GA), nullptr, (bf16*)(ws + WS_T)};
          pg8::gemm_phase<pg8::EpiGate<false>, pg8::StaticOrder, true, true>(L, g, S, E); }
        VM_WAIT(); __syncthreads();
        { pg8::Gemm g{(const bf16*)(ws + WS_YB), (const bf16*)(ws + WS_WB), SEQ, DM, 2048}; pg8::StaticOrder S; S.init(SEQ, DM, G, bx); S.rep = NREP(4);
          pg8::EpiGate<true> E{(const bf16*)(ws + WS_GB), (const bf16*)(ws + WS_T), (bf16*)(ws + WS_MG)};
          pg8::gemm_phase<pg8::EpiGate<true>, pg8::StaticOrder, true, true>(L, g, S, E); }
        SEAM(4);
    }
    if (IN(5)) {
        pg8::Gemm g{(const bf16*)(ws + WS_MG), (const bf16*)(ws + WS_WOUT), SEQ, DM, DM}; pg8::StaticOrder S; S.init(SEQ, DM, G, bx); S.rep = NREP(5);
        pg8::EpiResidStats E{PIN(0), (bf16*)(ws + WS_H), (float*)(ws + WS_RSS)};
        pg8::gemm_phase<pg8::EpiResidStats, pg8::StaticOrder, true, true>(L, g, S, E);
        SEAM(5);
    }
    if (IN(6)) {
        pg8::Gemm g{(const bf16*)(ws + WS_H), (const bf16*)(ws + WS_WFF1), SEQ, DFF, DM}; pg8::StaticOrder S; S.init(SEQ, DFF, G, bx); S.rep = NREP(6);
        pg8::Unit u0, ui; u0.pm = 0; u0.pn = 0; bool same = S.next(0, u0);
        for (int i = 1; S.next(i, ui); ++i) same = same && (ui.pm == u0.pm);
        if (same) {
            LAS float* rtab = (LAS float*)(L + RTAB_OFF);
            { const int tid6 = wave * 64 + lane; const int row = tid6 >> 1, half = tid6 & 1; const f32x4* rp = (const f32x4*)((const float*)(ws + WS_RSS) + ((size_t)u0.pm * 256 + row) * 64 + half * 32); float t = 0.f;
#pragma unroll
              for (int j = 0; j < 8; ++j) { const f32x4 v = rp[j]; t += (v.x + v.y) + (v.z + v.w); }
              t += __shfl_xor(t, 1);
              if (half == 0) rtab[row] = rsqrtf(t * (1.0f / DM) + RMS_EPS); }
            __syncthreads();
            pg8::EpiRelu2<true> E{(bf16*)(ws + WS_U2), nullptr, rtab};
            pg8::gemm_phase<pg8::EpiRelu2<true>, pg8::StaticOrder, true, true>(L, g, S, E);
        } else {
            pg8::EpiRelu2<false> E{(bf16*)(ws + WS_U2), (const float*)(ws + WS_RSS), nullptr};
            pg8::gemm_phase<pg8::EpiRelu2<false>, pg8::StaticOrder, true, true>(L, g, S, E);
        }
        SEAM(6);
    }
    if (IN(7)) {
        pg8::Gemm g{(const bf16*)(ws + WS_U2), (const bf16*)(ws + WS_WFF2), SEQ, DM, DFF}; pg8::StaticOrder S; S.init(SEQ, DM, G, bx);
        pg8::EpiResidOut E{(const bf16*)(ws + WS_H), args.out};
        pg8::gemm_phase<pg8::EpiResidOut, pg8::StaticOrder, true, true>(L, g, S, E);
        SEAM(7);
    }
    if (IN(8)) {
        if (NREP(8) > 1) { for (int m = gw; m < SEQ; m += NGW) rms_row<false>(args.out + (size_t)m * DM, PIN(15), (float*)(ws + WS_T) + (size_t)m * DM, lane); }
#ifdef DIAG_PHASE
        {
            const unsigned long long t0 = __hip_atomic_load((unsigned long long*)(args.ws + 2048) + DIAG_PHASE, RLX_AGENT), t1 = __hip_atomic_load((unsigned long long*)(args.ws + 2048) + DIAG_PHASE + 1, RLX_AGENT);
            const float cv = (float)(t1 - t0) * 0.001f;
            for (int m = gw; m < SEQ; m += NGW) for (int c = lane; c < DM; c += 64) args.out[(size_t)m * DM + c] = cv; }
        if (false)
#endif
#ifdef SELFTEST
        const unsigned f = __hip_atomic_load((unsigned*)ctl + CW_FLAG, RLX_AGENT) & ~(unsigned)(SELFTEST_IGNORE);
        if (f) { const unsigned f2 = __hip_atomic_load((unsigned*)ctl + CW_FLAG2, RLX_AGENT), nf = __hip_atomic_load((unsigned*)ctl + CW_FLAG2 + 1, RLX_AGENT), nt = __hip_atomic_load((unsigned*)ctl + CW_FLAG2 + 2, RLX_AGENT);
            const float cv1 = f2 ? (float)f2 : (float)__builtin_ctz(f), cv2 = nt ? 1.f + (float)((nf * 30u) / nt) : 0.f;
            for (int m = gw; m < SEQ; m += NGW) for (int c = lane; c < DM; c += 64) args.out[(size_t)m * DM + c] = (m < SEQ / 2) ? cv1 : cv2; }
        else
#endif
        for (int m = gw; m < SEQ; m += NGW) rms_row<false>(args.out + (size_t)m * DM, PIN(15), args.out + (size_t)m * DM, lane);
    }
#undef IN
#undef SEAM
#undef lane
#undef PIN
}

extern "C" void kernel_launch(void* const* d_in, const int* in_sizes, int n_in, void* d_out, int out_size, void* d_ws, size_t ws_size, hipStream_t stream) {
    static int grid = 0;
    if (grid == 0) {
        if (n_in != 16 || in_sizes[0] != SEQ * DM || out_size != SEQ * DM || ws_size < WS_END) { fprintf(stderr, "kernel_launch: shape/workspace mismatch (n_in %d, in0 %d, out %d, ws %zu, need %zu); nothing launched\n", n_in, n_in > 0 ? in_sizes[0] : -1, out_size, ws_size, (size_t)WS_END); grid = -1; return; }
        int dev = 0, cus = 0;
        if (hipGetDevice(&dev) != hipSuccess || hipDeviceGetAttribute(&cus, hipDeviceAttributeMultiprocessorCount, dev) != hipSuccess) { grid = -1; return; }
        if (hipFuncSetAttribute((const void*)fwd, hipFuncAttributeMaxDynamicSharedMemorySize, LDS_BYTES) != hipSuccess) { fprintf(stderr, "kernel_launch: hipFuncSetAttribute failed\n"); grid = -1; return; }
        (void)hipGetLastError();
        grid = cus;
    }
    if (grid < 0) return;
    if (hipMemsetAsync((char*)d_ws + WS_CTL, 0, CTL_ZERO_BYTES, stream) != hipSuccess) return;
    Args a{};
    for (int i = 0; i < 16; ++i) a.in[i] = (const float*)d_in[i];
    a.out = (float*)d_out; a.ws = (unsigned char*)d_ws;
    constexpr int NL = MK_N_LAUNCHES;
    static_assert(NL == 1 || NL == N_PHASES, "MK_N_LAUNCHES is 1 or N_PHASES");
    for (int li = 0; li < NL; ++li) {
        a.ph_lo = (NL == 1) ? 0 : li; a.ph_hi = (NL == 1) ? N_PHASES : li + 1;
        hipLaunchKernelGGL(fwd, dim3(grid), dim3(NWAVES * 64), LDS_BYTES, stream, a);
        const hipError_t le = hipPeekAtLastError();
        if (le != hipSuccess) { fprintf(stderr, "kernel_launch: launch %d failed: %s\n", li, hipGetErrorName(le)); break; }
#ifdef SELFTEST
        if (NL == N_PHASES && li < 8) { Args c = a; c.ph_lo = 16 + li; c.ph_hi = 17 + li; hipLaunchKernelGGL(fwd, dim3(grid), dim3(NWAVES * 64), LDS_BYTES, stream, c); }
#endif
    }
}
```
